# Optimizing an MI355X kernel written in HIP

```python
import jax, jax.numpy as jnp
from jax import lax
import numpy as np

D_MODEL = 1024
BATCH = 8
SEQ = 2048
DEPTH = 1
DEC_BATCH = 32
DEC_SEQ = 1
PAST_LEN = 16384
PAGE_SIZE = 128

HEAD_DIM = 64
ATTN_GROUPS = ((128, 1), (512, 4), (2048, 16))
N_GROUPS = 3
HG = 4
N_ATTN_HEADS = N_GROUPS * HG
ATTN_WIDTH = N_ATTN_HEADS * HEAD_DIM
ATTN_OUT_WIDTH = HG * HEAD_DIM
BAND = 128
RWKV_N = 64
RWKV_WIDTH = D_MODEL // 2
RWKV_HEADS = RWKV_WIDTH // RWKV_N
DECAY_LORA = 64
AAA_LORA = 64
GATE_LORA = 128
SHIFT_WIDTH = 3 * RWKV_WIDTH + DECAY_LORA + AAA_LORA + GATE_LORA
D_FF = 4 * D_MODEL
IN_WIDTH = 3 * ATTN_WIDTH + SHIFT_WIDTH + 2 * D_MODEL
NORM_EPS = 1e-6
GN_EPS = 64e-5
NEG_INF = -1e30

kernel_name = "hybrid_dilated_attn_rwkv7_step"


def rms_norm(x, g):
    xf = x.astype(jnp.float32)
    y = xf * lax.rsqrt(jnp.mean(xf * xf, axis=-1, keepdims=True) + NORM_EPS)
    return (y * g.astype(jnp.float32)).astype(x.dtype)


def alibi_slopes():
    h = jnp.arange(1, N_ATTN_HEADS + 1, dtype=jnp.float32)
    return jnp.exp2(-8.0 * h / N_ATTN_HEADS)


def dilated_attn_prompt(q, k, v, dil, slopes):
    B, S, H, Dh = q.shape
    f32 = jnp.float32
    span = dil * BAND
    Sp = -(-S // span) * span
    L = Sp // dil
    nb = L // BAND

    def to_blocks(t):
        t = jnp.pad(t.astype(f32), ((0, 0), (0, Sp - S), (0, 0), (0, 0)))
        t = t.reshape(B, L, dil, H, Dh).transpose(0, 2, 1, 3, 4)
        return t.reshape(B, dil, nb, BAND, H, Dh)

    def with_prev(t):
        prev = jnp.concatenate([jnp.zeros_like(t[:, :, :1]), t[:, :, :-1]], axis=2)
        return jnp.concatenate([prev, t], axis=3)

    qb, kb, vb = to_blocks(q), to_blocks(k), to_blocks(v)
    k2, v2 = with_prev(kb), with_prev(vb)
    s = jnp.einsum('brnqhd,brnkhd->brnhqk', qb, k2) * (HEAD_DIM ** -0.5)
    qi = jnp.arange(BAND)[:, None]
    kj = jnp.arange(2 * BAND)[None, :]
    delta = BAND + qi - kj
    band = (delta >= 0) & (delta <= BAND)
    valid = band[None] & ((jnp.arange(nb)[:, None, None] > 0) | (kj[None] >= BAND))
    bias = -slopes[:, None, None] * (delta * dil).astype(f32)[None]
    s = jnp.where(valid[None, None, :, None], s + bias, NEG_INF)
    lse = jax.nn.logsumexp(s, axis=-1)
    p = jnp.exp(s - lse[..., None])
    o = jnp.einsum('brnhqk,brnkhd->brnqhd', p, v2)
    o = o.reshape(B, dil, L, H, Dh).transpose(0, 2, 1, 3, 4).reshape(B, Sp, H, Dh)[:, :S]
    lse = lse.transpose(0, 1, 2, 4, 3).reshape(B, dil, L, H).transpose(0, 2, 1, 3).reshape(B, Sp, H)[:, :S]
    return o, lse


def dilated_attn_sample(q, k_new, v_new, kv_buf, dil, slopes):
    B, T, H, Dh = q.shape
    f32 = jnp.float32
    Lb = kv_buf.shape[1]
    k_all = jnp.concatenate([kv_buf[:, :, 0].astype(f32), k_new.astype(f32)], axis=1)
    v_all = jnp.concatenate([kv_buf[:, :, 1].astype(f32), v_new.astype(f32)], axis=1)
    m = jnp.arange(BAND + 1)
    idx = Lb + jnp.arange(T)[:, None] - dil * m[None, :]
    valid = idx >= 0
    idx = jnp.maximum(idx, 0)
    kg = k_all[:, idx]
    vg = v_all[:, idx]
    s = jnp.einsum('bthd,btmhd->bthm', q.astype(f32), kg) * (HEAD_DIM ** -0.5)
    s = s - slopes[None, None, :, None] * (m * dil).astype(f32)[None, None, None, :]
    s = jnp.where(valid[None, :, None, :], s, NEG_INF)
    lse = jax.nn.logsumexp(s, axis=-1)
    p = jnp.exp(s - lse[..., None])
    o = jnp.einsum('bthm,btmhd->bthd', p, vg)
    return o, lse


def wkv_scan(r, decay, k, v, a_vec, b_vec, S0):
    def step(S, inp):
        r_t, w_t, k_t, v_t, a_t, b_t = inp
        sa = jnp.einsum('bhvk,bhk->bhv', S, a_t)
        S = S * w_t[:, :, None, :] + sa[..., None] * b_t[:, :, None, :] + v_t[..., None] * k_t[:, :, None, :]
        y = jnp.einsum('bhvk,bhk->bhv', S, r_t)
        return S, y
    xs = tuple(t.transpose(1, 0, 2, 3) for t in (r, decay, k, v, a_vec, b_vec))
    S, ys = lax.scan(step, S0.astype(jnp.float32), xs)
    return ys.transpose(1, 0, 2, 3), S


def rwkv_mix(zb, S0, w):
    B, T, _ = zb.shape
    H, N, R = RWKV_HEADS, RWKV_N, RWKV_WIDTH
    zf = zb.astype(jnp.float32)
    r, k, v, zw, za, zg = jnp.split(zf, [R, 2 * R, 3 * R, 3 * R + DECAY_LORA, 3 * R + DECAY_LORA + AAA_LORA], axis=-1)
    w_log = -jax.nn.softplus(-(w['w0'] + jnp.tanh(zw) @ w['w_lora_up'])) - 0.5
    decay = jnp.exp(-jnp.exp(w_log))
    a = jax.nn.sigmoid(w['a0'] + za @ w['a_lora_up'])
    g = jax.nn.sigmoid(zg) @ w['g_lora_up']
    kk = (k * w['k_k']).reshape(B, T, H, N)
    kk = kk / jnp.maximum(jnp.sqrt(jnp.sum(kk * kk, axis=-1, keepdims=True)), 1e-12)
    k = k * (1.0 + (a - 1.0) * w['k_a'])
    hd = lambda t: t.reshape(B, T, H, N)
    r_h, k_h, v_h, a_h, d_h = hd(r), hd(k), hd(v), hd(a), hd(decay)
    y, S = wkv_scan(r_h, d_h, k_h, v_h, -kk, kk * a_h, S0)
    mu = jnp.mean(y, axis=-1, keepdims=True)
    var = jnp.mean(jnp.square(y - mu), axis=-1, keepdims=True)
    yn = ((y - mu) * lax.rsqrt(var + GN_EPS)).reshape(B, T, R) * w['gn_g'] + w['gn_b']
    bonus = (jnp.sum(r_h * k_h * w['r_k'], axis=-1, keepdims=True) * v_h).reshape(B, T, R)
    return ((yn + bonus) * g).astype(zb.dtype), S


def block(x, kv_bufs, S0, shift_prev, w):
    B, T, _ = x.shape
    h = rms_norm(x, w['norm1_g'])
    z = h @ w['w_in']
    za, zb, zg = jnp.split(z, [3 * ATTN_WIDTH, 3 * ATTN_WIDTH + SHIFT_WIDTH], axis=-1)
    q, k, v = [t.reshape(B, T, N_ATTN_HEADS, HEAD_DIM) for t in jnp.split(za, 3, axis=-1)]
    slopes = alibi_slopes()
    outs, lses, kv_new = [], [], []
    for gi, (win, dil) in enumerate(ATTN_GROUPS):
        sl = slice(gi * HG, (gi + 1) * HG)
        qg, kg, vg = q[:, :, sl], k[:, :, sl], v[:, :, sl]
        if kv_bufs is None:
            o, l = dilated_attn_prompt(qg, kg, vg, dil, slopes[sl])
            rows = min(win, T)
            kv_new.append(jnp.stack([kg[:, T - rows:], vg[:, T - rows:]], axis=2))
        else:
            o, l = dilated_attn_sample(qg, kg, vg, kv_bufs[gi], dil, slopes[sl])
            kv_new.append(jnp.stack([kg, vg], axis=2))
        outs.append(o)
        lses.append(l)
    wts = jax.nn.softmax(jnp.stack(lses), axis=0)
    attn = jnp.sum(wts[..., None] * jnp.stack(outs), axis=0).reshape(B, T, ATTN_OUT_WIDTH).astype(x.dtype)
    z_prev = jnp.concatenate([shift_prev[:, None].astype(zb.dtype), zb[:, :-1]], axis=1)
    zb_mix = zb + (z_prev - zb) * w['mu_shift']
    rwkv, S = rwkv_mix(zb_mix, S0, w)
    gate = jax.nn.sigmoid((zg + w['b_gate']).astype(jnp.float32))
    gate_a, gate_b = gate[..., :D_MODEL], gate[..., D_MODEL:]
    merged = gate_a * (attn @ w['w_proj_a']) + gate_b * (rwkv @ w['w_proj_b'])
    x = x + merged.astype(x.dtype) @ w['w_out']
    hm = rms_norm(x, w['norm2_g'])
    x = x + jnp.square(jax.nn.relu(hm @ w['w_up'])) @ w['w_down']
    return x, kv_new[0], kv_new[1], kv_new[2], S, zb[:, -1]


def setup_inputs(seed: int = 0) -> dict:
    key = jax.random.key(seed)
    ks = list(jax.random.split(key, 40))
    f32 = jnp.float32

    def nrm(i, shape, scale):
        return scale * jax.random.normal(ks[i], shape, f32)

    def unif(i, shape, lo, hi):
        return jax.random.uniform(ks[i], shape, f32, lo, hi)

    Dd = DEPTH
    buf = lambda win: min(win, PAST_LEN)
    return {
        "x_prompt": nrm(0, (BATCH, SEQ, D_MODEL), 1.0),
        "x_sample": nrm(1, (DEC_BATCH, DEC_SEQ, D_MODEL), 1.0),
        "cache_kv_w128": nrm(2, (Dd, DEC_BATCH, buf(128), 2, HG, HEAD_DIM), 1.0),
        "cache_kv_w512": nrm(3, (Dd, DEC_BATCH, buf(512), 2, HG, HEAD_DIM), 1.0),
        "cache_kv_w2048": nrm(4, (Dd, DEC_BATCH, buf(2048), 2, HG, HEAD_DIM), 1.0),
        "state_wkv": nrm(5, (Dd, DEC_BATCH, RWKV_HEADS, RWKV_N, RWKV_N), 0.3),
        "state_shift": nrm(6, (Dd, DEC_BATCH, SHIFT_WIDTH), 1.0),
        "norm1_g": 1.0 + nrm(7, (Dd, D_MODEL), 0.05),
        "w_in": nrm(8, (Dd, D_MODEL, IN_WIDTH), D_MODEL ** -0.5),
        "b_gate": nrm(9, (Dd, 2 * D_MODEL), 0.1),
        "mu_shift": unif(10, (Dd, SHIFT_WIDTH), 0.0, 1.0),
        "w0": unif(11, (Dd, RWKV_WIDTH), -6.0, -0.5),
        "w_lora_up": nrm(12, (Dd, DECAY_LORA, RWKV_WIDTH), DECAY_LORA ** -0.5),
        "a0": nrm(13, (Dd, RWKV_WIDTH), 0.5),
        "a_lora_up": nrm(14, (Dd, AAA_LORA, RWKV_WIDTH), AAA_LORA ** -0.5),
        "g_lora_up": nrm(15, (Dd, GATE_LORA, RWKV_WIDTH), GATE_LORA ** -0.5),
        "k_k": 0.85 + nrm(16, (Dd, RWKV_WIDTH), 0.05),
        "k_a": 1.0 + nrm(17, (Dd, RWKV_WIDTH), 0.05),
        "r_k": nrm(18, (Dd, RWKV_HEADS, RWKV_N), 0.3),
        "gn_g": 1.0 + nrm(19, (Dd, RWKV_WIDTH), 0.05),
        "gn_b": nrm(20, (Dd, RWKV_WIDTH), 0.02),
        "w_proj_a": nrm(21, (Dd, ATTN_OUT_WIDTH, D_MODEL), ATTN_OUT_WIDTH ** -0.5),
        "w_proj_b": nrm(22, (Dd, RWKV_WIDTH, D_MODEL), RWKV_WIDTH ** -0.5),
        "w_out": nrm(23, (Dd, D_MODEL, D_MODEL), D_MODEL ** -0.5),
        "norm2_g": 1.0 + nrm(24, (Dd, D_MODEL), 0.05),
        "w_up": nrm(25, (Dd, D_MODEL, D_FF), D_MODEL ** -0.5),
        "w_down": nrm(26, (Dd, D_FF, D_MODEL), D_FF ** -0.5),
        "normf_g": 1.0 + nrm(27, (D_MODEL,), 0.05),
    }


def reference(x_prompt, x_sample, cache_kv_w128, cache_kv_w512, cache_kv_w2048, state_wkv, state_shift,
              norm1_g, w_in, b_gate, mu_shift, w0, w_lora_up, a0, a_lora_up, g_lora_up, k_k, k_a, r_k,
              gn_g, gn_b, w_proj_a, w_proj_b, w_out, norm2_g, w_up, w_down, normf_g):
    B = x_prompt.shape[0]
    xp, xs = x_prompt, x_sample
    per_p, per_s = [], []
    for l in range(DEPTH):
        w = dict(norm1_g=norm1_g[l], w_in=w_in[l], b_gate=b_gate[l], mu_shift=mu_shift[l], w0=w0[l],
                 w_lora_up=w_lora_up[l], a0=a0[l], a_lora_up=a_lora_up[l], g_lora_up=g_lora_up[l],
                 k_k=k_k[l], k_a=k_a[l], r_k=r_k[l], gn_g=gn_g[l], gn_b=gn_b[l], w_proj_a=w_proj_a[l],
                 w_proj_b=w_proj_b[l], w_out=w_out[l], norm2_g=norm2_g[l], w_up=w_up[l], w_down=w_down[l])
        S0p = jnp.zeros((B, RWKV_HEADS, RWKV_N, RWKV_N), jnp.float32)
        sh0p = jnp.zeros((B, SHIFT_WIDTH), xp.dtype)
        out_p = block(xp, None, S0p, sh0p, w)
        xp = out_p[0]
        per_p.append(out_p[1:])
        out_s = block(xs, (cache_kv_w128[l], cache_kv_w512[l], cache_kv_w2048[l]), state_wkv[l], state_shift[l], w)
        xs = out_s[0]
        per_s.append(out_s[1:])
    y_prompt = rms_norm(xp, normf_g)
    y_sample = rms_norm(xs, normf_g)
    kv128_p = jnp.stack([e[0] for e in per_p])
    kv512_p = jnp.stack([e[1] for e in per_p])
    kv2048_p = jnp.stack([e[2] for e in per_p])
    wkv_p = jnp.stack([e[3] for e in per_p])
    shift_p = jnp.stack([e[4] for e in per_p])
    kv128_s = jnp.stack([e[0] for e in per_s])
    kv512_s = jnp.stack([e[1] for e in per_s])
    kv2048_s = jnp.stack([e[2] for e in per_s])
    wkv_s = jnp.stack([e[3] for e in per_s])
    shift_s = jnp.stack([e[4] for e in per_s])
    return (y_prompt, y_sample, kv128_p, kv512_p, kv2048_p, wkv_p, shift_p, kv128_s, kv512_s, kv2048_s, wkv_s, shift_s)
```

```cpp
#include <hip/hip_runtime.h>
#include <hip/hip_cooperative_groups.h>
#include <cstdio>
#include <cstdint>
namespace cg = cooperative_groups;
namespace pg8 {
#define PG8_LAS __attribute__((address_space(3)))
typedef unsigned short bf16_t;
typedef short bf16x8 __attribute__((ext_vector_type(8)));
typedef float f32x4 __attribute__((ext_vector_type(4)));
typedef unsigned u32x4 __attribute__((ext_vector_type(4)));
constexpr int BM = 256, BK = 64, HALF = 128, HTB = HALF * BK * 2  , STAGE_BYTES = 8 * HTB, NXCD = 8, WGM = 8;

__host__ __device__ __forceinline__ int lds_byte(int r, int c) { const int st = (r >> 4) * 2 + (c >> 5), rr = r & 15, cc = c & 31, ob = rr * 64 + cc * 2; return st * 1024 + (ob ^ (((ob >> 9) & 1) << 5)); }
__host__ __device__ __forceinline__ void stage_rc(int b, int& R, int& C) { const int st = b / 1024, sb = b % 1024, swz = sb ^ (((sb >> 9) & 1) << 5); R = (st >> 1) * 16 + swz / 64; C = (st & 1) * 32 + (swz % 64) / 2; }
__host__ __device__ __forceinline__ int perm32(int rho) { const int n = rho >> 4, i = rho & 15; return 8 * (i >> 2) + 4 * n + (i & 3); }

struct Unit { int pm, pn; };
struct Gemm { const bf16_t* A; const bf16_t* Bt; int M, N, K; };

struct StaticOrder {
    int nM, nN, nwg, G, c;
    __host__ __device__ void init(int M, int N, int G_, int c_) { nM = M / BM; nN = N / BM; nwg = nM * nN; G = G_; c = c_; }
    __host__ __device__ bool next(int i, Unit& u) const {
        const long L = (long)i * G + c; if (L >= nwg) return false;
        int wgid = (int)L; { const int q = nwg / NXCD, r = nwg % NXCD, xcd = wgid % NXCD, off = wgid / NXCD; wgid = (xcd < r ? xcd * (q + 1) : r * (q + 1) + (xcd - r) * q) + off; }
        const int nig = WGM * nN, gid = wgid / nig, fm = gid * WGM, gsz = (nM - fm) < WGM ? (nM - fm) : WGM;
        u.pm = fm + ((wgid % nig) % gsz); u.pn = (wgid % nig) / gsz; return true;
    }
    __device__ __forceinline__ void a_ready(const Unit&) const {}
    __device__ __forceinline__ void done(const Unit&) const {}
};

__device__ __forceinline__ unsigned cvt_pk_bf16(float lo, float hi) { unsigned r; asm volatile("v_cvt_pk_bf16_f32 %0, %1, %2" : "=v"(r) : "v"(lo), "v"(hi)); return r; }
template <class Epi, class Sched, bool ALIGN_EPI = false, bool SP2 = false>
__device__ __forceinline__ void gemm_phase(PG8_LAS unsigned char* lds, const Gemm g, const Sched& S, const Epi& E) {
    const int tid = threadIdx.x, wid = __builtin_amdgcn_readfirstlane(tid >> 6), lane = tid & 63, wr = wid >> 2, wc = wid & 3, fr = lane & 15, fq = lane >> 4;
    const int K = g.K, nt = K / BK;
    unsigned voffA[2], voffB[2];
#pragma unroll
    for (int i = 0; i < 2; ++i) { int R, C; stage_rc(tid * 16 + i * 8192, R, C); const int Rb = Epi::PERM ? ((R & ~31) + perm32(R & 31)) : R;
        voffA[i] = (unsigned)(R * K + C) * 2u; voffB[i] = (unsigned)(Rb * K + C) * 2u; }
    const size_t kstep = (size_t)(BK * 2);
    const size_t hstep = (size_t)HALF * K * 2;
    const size_t tstep = 2 * hstep;
    const unsigned ldsw = (unsigned)wid * 1024u;
    const int aoff = lds_byte(wr * 64 + fr, fq * 8), boff = lds_byte(wc * 32 + fr, fq * 8);
#define PG8_SA(b, h) (((b) * 2 + (h)) * HTB)
#define PG8_SB(b, h) ((4 + (b) * 2 + (h)) * HTB)
#define PG8_STAGE(bufoff, gbase, voff) do { _Pragma("unroll") for (int _i = 0; _i < 2; ++_i) \
        __builtin_amdgcn_global_load_lds((const unsigned*)((const char*)(gbase) + (voff)[_i]), (PG8_LAS unsigned*)(lds + (bufoff) + ldsw + _i * 8192), 16, 0, 0); } while (0)
#define PG8_LDA(dst, b, h) do { _Pragma("unroll") for (int m = 0; m < 4; ++m) _Pragma("unroll") for (int k = 0; k < 2; ++k) dst[m][k] = *(const PG8_LAS bf16x8*)(lds + PG8_SA(b, h) + aoff + m * 2048 + k * 1024); } while (0)
#define PG8_LDB(dst, b, h) do { _Pragma("unroll") for (int n = 0; n < 2; ++n) _Pragma("unroll") for (int k = 0; k < 2; ++k) dst[n][k] = *(const PG8_LAS bf16x8*)(lds + PG8_SB(b, h) + boff + n * 2048 + k * 1024); } while (0)
#define PG8_MMA(ai, bj, At, Bt) do { __builtin_amdgcn_s_setprio(1); _Pragma("unroll") for (int m = 0; m < 4; ++m) _Pragma("unroll") for (int n = 0; n < 2; ++n) _Pragma("unroll") for (int k = 0; k < 2; ++k) \
        acc[ai][bj][m][n] = __builtin_amdgcn_mfma_f32_16x16x32_bf16(Bt[n][k], At[m][k], acc[ai][bj][m][n], 0, 0, 0); __builtin_amdgcn_s_setprio(0); } while (0)
#define PG8_WAIT_V(n) asm volatile("s_waitcnt vmcnt(" #n ")" ::: "memory")
#define PG8_WAIT_L(n) asm volatile("s_waitcnt lgkmcnt(" #n ")" ::: "memory")
#define PG8_BAR __builtin_amdgcn_s_barrier()
#define PG8_SCHED __builtin_amdgcn_sched_barrier(0)
    Unit cur, nxt; int ui = 0;
    if (!S.next(0, cur)) return;
    f32x4 acc[2][2][4][2];
#pragma unroll
    for (int a = 0; a < 2; ++a)
#pragma unroll
        for (int b = 0; b < 2; ++b)
#pragma unroll
            for (int m = 0; m < 4; ++m)
#pragma unroll
                for (int n = 0; n < 2; ++n) acc[a][b][m][n] = (f32x4){0.f, 0.f, 0.f, 0.f};
    bf16x8 At[4][2], B0[2][2], B1[2][2];
    const char* cA = (const char*)g.A + (size_t)cur.pm * tstep; const char* cB = (const char*)g.Bt + (size_t)cur.pn * tstep;
    S.a_ready(cur);
    if constexpr (SP2) {
        PG8_STAGE(PG8_SB(0, 0), cB, voffB); PG8_STAGE(PG8_SB(0, 1), cB + hstep, voffB); PG8_STAGE(PG8_SA(0, 0), cA, voffA); PG8_STAGE(PG8_SA(0, 1), cA + hstep, voffA);
        if (wr == 1) PG8_BAR;
        PG8_WAIT_V(2); PG8_BAR;
        PG8_STAGE(PG8_SB(1, 0), cB + kstep, voffB); PG8_STAGE(PG8_SA(1, 0), cA + kstep, voffA); PG8_STAGE(PG8_SB(1, 1), cB + hstep + kstep, voffB);
        PG8_WAIT_V(6); PG8_BAR;
    } else {
        PG8_STAGE(PG8_SB(0, 0), cB, voffB); PG8_STAGE(PG8_SA(0, 0), cA, voffA); PG8_STAGE(PG8_SB(0, 1), cB + hstep, voffB); PG8_STAGE(PG8_SA(0, 1), cA + hstep, voffA);
        if (wr == 1) PG8_BAR;
        PG8_WAIT_V(4); PG8_BAR;
        PG8_STAGE(PG8_SB(1, 0), cB + kstep, voffB); PG8_STAGE(PG8_SA(1, 0), cA + kstep, voffA); PG8_STAGE(PG8_SB(1, 1), cB + hstep + kstep, voffB);
        PG8_WAIT_V(6); PG8_BAR;
    }
    for (;;) {
        const bool has_next = S.next(ui + 1, nxt);
        const char* nA = has_next ? (const char*)g.A + (size_t)nxt.pm * tstep : cA; const char* nB = has_next ? (const char*)g.Bt + (size_t)nxt.pn * tstep : cB;
        for (int t = 0; t < nt; t += 2) {
            const bool last = (t == nt - 2);
            const char* a1 = cA + (size_t)(t + 1) * kstep;
            const char* a2 = last ? nA : cA + (size_t)(t + 2) * kstep; const char* b2 = last ? nB : cB + (size_t)(t + 2) * kstep;
            const char* a3 = a2 + kstep; const char* b3 = b2 + kstep;
            if (last && has_next) S.a_ready(nxt);
            if constexpr (SP2) {
            PG8_LDB(B0, 0, 0); PG8_LDB(B1, 0, 1); PG8_SCHED; PG8_LDA(At, 0, 0); PG8_STAGE(PG8_SA(1, 1), a1 + hstep, voffA);
            PG8_WAIT_V(8); PG8_WAIT_L(0); PG8_BAR; PG8_MMA(0, 0, At, B0); PG8_MMA(0, 1, At, B1); PG8_BAR; PG8_SCHED;
            PG8_LDA(At, 0, 1); PG8_STAGE(PG8_SB(0, 0), b2, voffB); PG8_STAGE(PG8_SB(0, 1), b2 + hstep, voffB); PG8_STAGE(PG8_SA(0, 0), a2, voffA);
            PG8_WAIT_V(8); PG8_WAIT_L(0); PG8_BAR; PG8_MMA(1, 0, At, B0); PG8_MMA(1, 1, At, B1); PG8_BAR; PG8_SCHED;
            PG8_LDB(B0, 1, 0); PG8_LDB(B1, 1, 1); PG8_SCHED; PG8_LDA(At, 1, 0); PG8_STAGE(PG8_SA(0, 1), a2 + hstep, voffA);
            PG8_WAIT_V(8); PG8_WAIT_L(0); PG8_BAR; PG8_MMA(0, 0, At, B0); PG8_MMA(0, 1, At, B1); PG8_BAR; PG8_SCHED;
            PG8_LDA(At, 1, 1); PG8_STAGE(PG8_SB(1, 0), b3, voffB); PG8_STAGE(PG8_SB(1, 1), b3 + hstep, voffB); PG8_STAGE(PG8_SA(1, 0), a3, voffA);
            PG8_WAIT_V(8); PG8_WAIT_L(0); PG8_BAR; PG8_MMA(1, 0, At, B0); PG8_MMA(1, 1, At, B1); PG8_BAR; PG8_SCHED;
            } else {
            PG8_LDB(B0, 0, 0); PG8_SCHED; PG8_LDA(At, 0, 0); PG8_STAGE(PG8_SA(1, 1), a1 + hstep, voffA);
            PG8_WAIT_L(8); PG8_BAR; PG8_WAIT_L(0); PG8_MMA(0, 0, At, B0); PG8_BAR; PG8_SCHED;
            PG8_LDB(B1, 0, 1); PG8_STAGE(PG8_SB(0, 0), b2, voffB);
            PG8_BAR; PG8_WAIT_L(0); PG8_MMA(0, 1, At, B1); PG8_BAR;
            PG8_LDA(At, 0, 1); PG8_STAGE(PG8_SA(0, 0), a2, voffA);
            PG8_BAR; PG8_WAIT_L(0); PG8_MMA(1, 0, At, B0); PG8_BAR; PG8_SCHED;
            PG8_STAGE(PG8_SB(0, 1), b2 + hstep, voffB);
            PG8_WAIT_V(6); PG8_BAR; PG8_MMA(1, 1, At, B1); PG8_BAR;
            PG8_LDB(B0, 1, 0); PG8_SCHED; PG8_LDA(At, 1, 0); PG8_STAGE(PG8_SA(0, 1), a2 + hstep, voffA);
            PG8_WAIT_L(8); PG8_BAR; PG8_WAIT_L(0); PG8_MMA(0, 0, At, B0); PG8_BAR; PG8_SCHED;
            PG8_LDB(B1, 1, 1); PG8_STAGE(PG8_SB(1, 0), b3, voffB);
            PG8_BAR; PG8_WAIT_L(0); PG8_MMA(0, 1, At, B1); PG8_BAR;
            PG8_LDA(At, 1, 1); PG8_STAGE(PG8_SA(1, 0), a3, voffA);
            PG8_BAR; PG8_WAIT_L(0); PG8_MMA(1, 0, At, B0); PG8_BAR; PG8_SCHED;
            PG8_STAGE(PG8_SB(1, 1), b3 + hstep, voffB);
            PG8_WAIT_V(6); PG8_BAR; PG8_MMA(1, 1, At, B1); PG8_BAR;
            }
        }
        if constexpr (ALIGN_EPI) { if (wr == 0) PG8_BAR; }
        if constexpr (!Epi::AFTER_DRAIN) { E(acc, cur, wr, wc, fr, fq); S.done(cur); }
        if (!has_next) break;
#pragma unroll
        for (int a = 0; a < 2; ++a)
#pragma unroll
            for (int b = 0; b < 2; ++b)
#pragma unroll
                for (int m = 0; m < 4; ++m)
#pragma unroll
                    for (int n = 0; n < 2; ++n) acc[a][b][m][n] = (f32x4){0.f, 0.f, 0.f, 0.f};
        cur = nxt; cA = nA; cB = nB; ++ui;
        if constexpr (ALIGN_EPI) { if (wr == 1) PG8_BAR; }
    }
    PG8_WAIT_V(0);
    if constexpr (!ALIGN_EPI) { if (wr == 0) PG8_BAR; }
    PG8_BAR;
    if constexpr (Epi::AFTER_DRAIN) { E.fused(acc, cur, wr, wc, fr, fq, lds, wid, lane); S.done(cur); }
#undef PG8_SA
#undef PG8_SB
#undef PG8_STAGE
#undef PG8_LDA
#undef PG8_LDB
#undef PG8_MMA
#undef PG8_WAIT_V
#undef PG8_WAIT_L
#undef PG8_BAR
#undef PG8_SCHED
}
}

#ifndef MK_USE_CG
#define MK_USE_CG 1
#endif
namespace mk {
using pg8::bf16_t; using pg8::bf16x8; using pg8::f32x4; using pg8::u32x4; using pg8::Unit; using pg8::cvt_pk_bf16;
typedef unsigned u32x2 __attribute__((ext_vector_type(2)));
typedef float f32x16 __attribute__((ext_vector_type(16)));
#define LAS __attribute__((address_space(3)))

constexpr int T_ = 2048, NB_ = 8, M_ = NB_ * T_, MS_ = 32, D_ = 1024, NIN_ = 6144, FF_ = 4096;
constexpr int QKVW = 2304, ZBW = 1792, GTW = 2048;
constexpr float NORM_EPS = 1e-6f, GN_EPS = 64e-5f;
constexpr size_t O_Y = 0, O_YS = O_Y + (size_t)M_ * D_, O_KV128P = O_YS + (size_t)MS_ * D_, O_KV512P = O_KV128P + (size_t)NB_ * 128 * 512,
                 O_KV2048P = O_KV512P + (size_t)NB_ * 512 * 512, O_WKVP = O_KV2048P + (size_t)NB_ * 2048 * 512, O_SHIFTP = O_WKVP + (size_t)NB_ * 8 * 4096,
                 O_KV128S = O_SHIFTP + (size_t)NB_ * ZBW, O_KV512S = O_KV128S + (size_t)MS_ * 512, O_KV2048S = O_KV512S + (size_t)MS_ * 512,
                 O_WKVS = O_KV2048S + (size_t)MS_ * 512, O_SHIFTS = O_WKVS + (size_t)MS_ * 8 * 4096, O_END = O_SHIFTS + (size_t)MS_ * ZBW;
constexpr size_t MiB = 1u << 20, KiB = 1u << 10;
constexpr size_t WS_CTL = 0, CTL_ZERO_BYTES = 1 * MiB;
constexpr size_t CTL_SS1 = 64 * KiB, CTL_SS1S = 128 * KiB, CTL_SS2 = 192 * KiB, CTL_SS2S = 256 * KiB, CTL_BAR = 512 * KiB;
constexpr size_t WS_WIN = 2 * MiB, WS_WA = 14 * MiB, WS_WB = 14 * MiB + 512 * KiB, WS_WO = 16 * MiB, WS_WUP = 18 * MiB, WS_WDN = 26 * MiB;
constexpr size_t WS_WL = 34 * MiB, WS_AL = WS_WL + 64 * KiB, WS_GL = WS_WL + 128 * KiB;
constexpr size_t WS_SMALL = 35 * MiB;
constexpr size_t SM_H1S = 0, SM_ZS = 64 * KiB, SM_ATTS = 832 * KiB, SM_RWS = 848 * KiB, SM_MGS = 880 * KiB, SM_X1GS = 944 * KiB, SM_US = 1024 * KiB;
constexpr size_t WS_H1 = 38 * MiB, WS_QKV = 70 * MiB, WS_ZB = 142 * MiB, WS_U = 70 * MiB, WS_GATE = 198 * MiB, WS_OG = 262 * MiB, WS_LSE = 286 * MiB,
                 WS_ATT = 287 * MiB, WS_RW = 295 * MiB, WS_MG = 311 * MiB, WS_Y = 343 * MiB, WS_G = 375 * MiB, WS_BON = 407 * MiB, WS_TMP = 343 * MiB, WS_END = 439 * MiB;
constexpr int RING_BYTES = 131072, MISC_OFF = RING_BYTES + 320, LDS_BYTES = 147456;

__device__ __forceinline__ float bf2f(unsigned short h) { return __builtin_bit_cast(float, (unsigned)h << 16); }
__device__ __forceinline__ unsigned f2bf(float f) { unsigned u = __builtin_bit_cast(unsigned, f); return (u + 0x7fffu + ((u >> 16) & 1u)) >> 16; }
__device__ __forceinline__ unsigned pk2(float lo, float hi) { return f2bf(lo) | (f2bf(hi) << 16); }
__device__ __forceinline__ float sigm(float x) { return 1.f / (1.f + __expf(-x)); }
__device__ __forceinline__ void store8bf(bf16_t* p, f32x4 v0, f32x4 v1) { u32x4 w; w.x = cvt_pk_bf16(v0[0], v0[1]); w.y = cvt_pk_bf16(v0[2], v0[3]); w.z = cvt_pk_bf16(v1[0], v1[1]); w.w = cvt_pk_bf16(v1[2], v1[3]); *(u32x4*)p = w; }
__device__ __forceinline__ void store4bf(bf16_t* p, f32x4 v) { u32x2 w; w.x = cvt_pk_bf16(v[0], v[1]); w.y = cvt_pk_bf16(v[2], v[3]); *(u32x2*)p = w; }
__device__ __forceinline__ f32x4 load4bf(const bf16_t* p) { const u32x2 w = *(const u32x2*)p; f32x4 r; r[0] = __builtin_bit_cast(float, w.x << 16); r[1] = __builtin_bit_cast(float, w.x & 0xffff0000u); r[2] = __builtin_bit_cast(float, w.y << 16); r[3] = __builtin_bit_cast(float, w.y & 0xffff0000u); return r; }
template <int CTRL> __device__ __forceinline__ float dppf(float v) { return __builtin_bit_cast(float, __builtin_amdgcn_update_dpp(0, __builtin_bit_cast(int, v), CTRL, 0xF, 0xF, true)); }
__device__ __forceinline__ float red16(float v) { v += dppf<0xB1>(v); v += dppf<0x4E>(v); v += dppf<0x141>(v); v += dppf<0x140>(v); return v; }
__device__ __forceinline__ float red8(float v) { v += dppf<0xB1>(v); v += dppf<0x4E>(v); v += dppf<0x141>(v); return v; }
__device__ __forceinline__ float wave_sum(float v) {
#pragma unroll
    for (int o = 1; o < 64; o <<= 1) v += __shfl_xor(v, o);
    return v;
}
__device__ __forceinline__ float wave_max(float v) {
#pragma unroll
    for (int o = 1; o < 64; o <<= 1) v = fmaxf(v, __shfl_xor(v, o));
    return v;
}

struct EpiZ {
    static constexpr bool PERM = true, AFTER_DRAIN = false;
    bf16_t* QKV; bf16_t* ZB; bf16_t* GATE; const float* b_gate; float* out;
    __device__ __forceinline__ void operator()(const f32x4 (&acc)[2][2][4][2], const Unit& u, int wr, int wc, int fr, int fq) const {
        const int pn = u.pn;
#pragma unroll
        for (int ai = 0; ai < 2; ++ai)
#pragma unroll
            for (int m = 0; m < 4; ++m) {
                const int row = u.pm * 256 + ai * 128 + wr * 64 + m * 16 + fr; const int b = row >> 11, t = row & 2047;
#pragma unroll
                for (int bj = 0; bj < 2; ++bj) {
                    const int col = pn * 256 + bj * 128 + wc * 32 + 8 * fq;
                    const f32x4 v0 = acc[ai][bj][m][0], v1 = acc[ai][bj][m][1];
                    if (pn < 9) {
                        store8bf(QKV + (size_t)row * QKVW + col, v0, v1);
                        if (col >= 768) {
                            const int kvsel = col >= 1536 ? 1 : 0; const int cc = col - 768 - kvsel * 768; const int head = cc >> 6, g = head >> 2, hs = head & 3, d = cc & 63;
                            const int rows_g = 128 << (2 * g); const int j = t - (T_ - rows_g);
                            if (j >= 0) { float* dst = out + (g == 0 ? O_KV128P : (g == 1 ? O_KV512P : O_KV2048P)) + ((size_t)(b * rows_g + j) * 2 + kvsel) * 256 + hs * 64 + d; *(f32x4*)dst = v0; *(f32x4*)(dst + 4) = v1; }
                        }
                    } else if (pn < 16) {
                        const int c = col - QKVW; store8bf(ZB + (size_t)row * ZBW + c, v0, v1);
                        if (t == T_ - 1) { float* dst = out + O_SHIFTP + (size_t)b * ZBW + c; *(f32x4*)dst = v0; *(f32x4*)(dst + 4) = v1; }
                    } else {
                        const int c = col - 4096; const f32x4 b0 = *(const f32x4*)(b_gate + c), b1 = *(const f32x4*)(b_gate + c + 4); f32x4 g0, g1;
#pragma unroll
                        for (int e = 0; e < 4; ++e) { g0[e] = sigm(v0[e] + b0[e]); g1[e] = sigm(v1[e] + b1[e]); }
                        store8bf(GATE + (size_t)row * GTW + c, g0, g1);
                    }
                }
            }
    }
};
struct EpiPA {
    static constexpr bool PERM = false, AFTER_DRAIN = false;
    const bf16_t* GATE; float* TMP;
    __device__ __forceinline__ void operator()(const f32x4 (&acc)[2][2][4][2], const Unit& u, int wr, int wc, int fr, int fq) const {
#pragma unroll
        for (int ai = 0; ai < 2; ++ai)
#pragma unroll
            for (int m = 0; m < 4; ++m) { const int row = u.pm * 256 + ai * 128 + wr * 64 + m * 16 + fr;
#pragma unroll
                for (int bj = 0; bj < 2; ++bj)
#pragma unroll
                    for (int n = 0; n < 2; ++n) { const int col = u.pn * 256 + bj * 128 + wc * 32 + 16 * n + 4 * fq;
                        const f32x4 ga = load4bf(GATE + (size_t)row * GTW + col); *(f32x4*)(TMP + (size_t)row * D_ + col) = ga * acc[ai][bj][m][n]; }
                asm volatile("" ::: "memory"); }
    }
};
struct EpiPB {
    static constexpr bool PERM = false, AFTER_DRAIN = false;
    const bf16_t* GATE; const float* TMP; bf16_t* MG;
    __device__ __forceinline__ void operator()(const f32x4 (&acc)[2][2][4][2], const Unit& u, int wr, int wc, int fr, int fq) const {
#pragma unroll
        for (int ai = 0; ai < 2; ++ai)
#pragma unroll
            for (int m = 0; m < 4; ++m) { const int row = u.pm * 256 + ai * 128 + wr * 64 + m * 16 + fr;
#pragma unroll
                for (int bj = 0; bj < 2; ++bj)
#pragma unroll
                    for (int n = 0; n < 2; ++n) { const int col = u.pn * 256 + bj * 128 + wc * 32 + 16 * n + 4 * fq;
                        const f32x4 gb = load4bf(GATE + (size_t)row * GTW + D_ + col); const f32x4 t = *(const f32x4*)(TMP + (size_t)row * D_ + col);
                        store4bf(MG + (size_t)row * D_ + col, t + gb * acc[ai][bj][m][n]); }
                asm volatile("" ::: "memory"); }
    }
};
template <bool WRITE_XG> struct EpiRes {
    static constexpr bool PERM = false, AFTER_DRAIN = false;
    const float* xin; float* xo; bf16_t* XG; const float* g; float* SS;
    __device__ __forceinline__ void operator()(const f32x4 (&acc)[2][2][4][2], const Unit& u, int wr, int wc, int fr, int fq) const {
#pragma unroll
        for (int ai = 0; ai < 2; ++ai)
#pragma unroll
            for (int m = 0; m < 4; ++m) { const int row = u.pm * 256 + ai * 128 + wr * 64 + m * 16 + fr; float ss = 0.f;
#pragma unroll
                for (int bj = 0; bj < 2; ++bj)
#pragma unroll
                    for (int n = 0; n < 2; ++n) { const int col = u.pn * 256 + bj * 128 + wc * 32 + 16 * n + 4 * fq;
                        const f32x4 x1 = *(const f32x4*)(xin + (size_t)row * D_ + col) + acc[ai][bj][m][n];
                        *(f32x4*)(xo + (size_t)row * D_ + col) = x1; ss += (x1[0] * x1[0] + x1[1] * x1[1]) + (x1[2] * x1[2] + x1[3] * x1[3]);
                        if (WRITE_XG) { const f32x4 gg = *(const f32x4*)(g + col); store4bf(XG + (size_t)row * D_ + col, x1 * gg); } }
                ss += __shfl_xor(ss, 16); ss += __shfl_xor(ss, 32);
                if (fq == 0) atomicAdd(SS + row, ss);
                asm volatile("" ::: "memory"); }
    }
};
struct EpiUp {
    static constexpr bool PERM = true, AFTER_DRAIN = false;
    const float* SS; bf16_t* U;
    __device__ __forceinline__ void operator()(const f32x4 (&acc)[2][2][4][2], const Unit& u, int wr, int wc, int fr, int fq) const {
#pragma unroll
        for (int ai = 0; ai < 2; ++ai)
#pragma unroll
            for (int m = 0; m < 4; ++m) { const int row = u.pm * 256 + ai * 128 + wr * 64 + m * 16 + fr; const float rs = rsqrtf(SS[row] * (1.f / D_) + NORM_EPS);
#pragma unroll
                for (int bj = 0; bj < 2; ++bj) { const int col = u.pn * 256 + bj * 128 + wc * 32 + 8 * fq; f32x4 v0 = acc[ai][bj][m][0] * rs, v1 = acc[ai][bj][m][1] * rs;
#pragma unroll
                    for (int e = 0; e < 4; ++e) { const float a = fmaxf(v0[e], 0.f), b = fmaxf(v1[e], 0.f); v0[e] = a * a; v1[e] = b * b; }
                    store8bf(U + (size_t)row * FF_ + col, v0, v1); } }
    }
};

struct SP { float* ZS; const float* b_gate; float* out; const float* xs; const float* g2; bf16_t* MGS; bf16_t* X1GS; bf16_t* US; float* SS1S; float* SS2S; };
template <int MODE> __device__ __forceinline__ void sample_gemm(LAS unsigned char* lds, const bf16_t* A1, int K1, const bf16_t* B1, const bf16_t* A2, int K2, const bf16_t* B2, int N, const SP p) {
    const int tid = threadIdx.x, wid = tid >> 6, lane = tid & 63, r = lane & 31, hh = lane >> 5;
    LAS float* P = (LAS float*)lds;
    for (int tile = blockIdx.x; tile < N / 32; tile += gridDim.x) {
        const int n0 = tile * 32;
        f32x16 acc1, acc2;
#pragma unroll
        for (int i = 0; i < 16; ++i) { acc1[i] = 0.f; acc2[i] = 0.f; }
        { const int kw = K1 / 8; const bf16_t* ap = A1 + (size_t)r * K1 + wid * kw + 8 * hh; const bf16_t* bp = B1 + (size_t)(n0 + r) * K1 + wid * kw + 8 * hh;
#pragma unroll 4
          for (int k = 0; k < kw; k += 16) { const bf16x8 a = *(const bf16x8*)(ap + k), b = *(const bf16x8*)(bp + k); acc1 = __builtin_amdgcn_mfma_f32_32x32x16_bf16(a, b, acc1, 0, 0, 0); } }
        if (K2 > 0) { const int kw = K2 / 8; const bf16_t* ap = A2 + (size_t)r * K2 + wid * kw + 8 * hh; const bf16_t* bp = B2 + (size_t)(n0 + r) * K2 + wid * kw + 8 * hh;
#pragma unroll 4
          for (int k = 0; k < kw; k += 16) { const bf16x8 a = *(const bf16x8*)(ap + k), b = *(const bf16x8*)(bp + k); acc2 = __builtin_amdgcn_mfma_f32_32x32x16_bf16(a, b, acc2, 0, 0, 0); } }
#pragma unroll
        for (int reg = 0; reg < 16; ++reg) { const int row = (reg & 3) + 8 * (reg >> 2) + 4 * hh; P[wid * 1024 + row * 32 + r] = acc1[reg]; if (K2 > 0) P[8192 + wid * 1024 + row * 32 + r] = acc2[reg]; }
        __syncthreads();
        const int row = tid >> 4, c2 = (tid & 15) * 2, col = n0 + c2;
        float s1a = 0.f, s1b = 0.f, s2a = 0.f, s2b = 0.f;
#pragma unroll
        for (int w = 0; w < 8; ++w) { s1a += P[w * 1024 + row * 32 + c2]; s1b += P[w * 1024 + row * 32 + c2 + 1]; if (K2 > 0) { s2a += P[8192 + w * 1024 + row * 32 + c2]; s2b += P[8192 + w * 1024 + row * 32 + c2 + 1]; } }
        if (MODE == 0) {
            p.ZS[(size_t)row * NIN_ + col] = s1a; p.ZS[(size_t)row * NIN_ + col + 1] = s1b;
            if (col >= 768 && col < QKVW) { const int kvsel = col >= 1536 ? 1 : 0; const int cc = col - 768 - kvsel * 768; const int head = cc >> 6, g = head >> 2, hs = head & 3, d = cc & 63;
                float* dst = p.out + (g == 0 ? O_KV128S : (g == 1 ? O_KV512S : O_KV2048S)) + ((size_t)row * 2 + kvsel) * 256 + hs * 64 + d; dst[0] = s1a; dst[1] = s1b; }
            else if (col >= QKVW && col < 4096) { float* dst = p.out + O_SHIFTS + (size_t)row * ZBW + (col - QKVW); dst[0] = s1a; dst[1] = s1b; }
        } else if (MODE == 1) {
            const float* zg = p.ZS + (size_t)row * NIN_ + 4096;
            const float ga0 = sigm(zg[col] + p.b_gate[col]), ga1 = sigm(zg[col + 1] + p.b_gate[col + 1]), gb0 = sigm(zg[D_ + col] + p.b_gate[D_ + col]), gb1 = sigm(zg[D_ + col + 1] + p.b_gate[D_ + col + 1]);
            *(unsigned*)(p.MGS + (size_t)row * D_ + col) = pk2(ga0 * s1a + gb0 * s2a, ga1 * s1b + gb1 * s2b);
        } else if (MODE == 2 || MODE == 4) {
            const float* xin = (MODE == 2) ? p.xs : (p.out + O_YS); float* xo = p.out + O_YS;
            const float x0 = xin[(size_t)row * D_ + col] + s1a, x1 = xin[(size_t)row * D_ + col + 1] + s1b;
            xo[(size_t)row * D_ + col] = x0; xo[(size_t)row * D_ + col + 1] = x1;
            if (MODE == 2) *(unsigned*)(p.X1GS + (size_t)row * D_ + col) = pk2(x0 * p.g2[col], x1 * p.g2[col + 1]);
            float ss = x0 * x0 + x1 * x1; ss = red16(ss);
            if ((tid & 15) == 0) atomicAdd((MODE == 2 ? p.SS1S : p.SS2S) + row, ss);
        } else if (MODE == 3) {
            const float rs = rsqrtf(p.SS1S[row] * (1.f / D_) + NORM_EPS); const float a = fmaxf(rs * s1a, 0.f), b = fmaxf(rs * s1b, 0.f);
            *(unsigned*)(p.US + (size_t)row * FF_ + col) = pk2(a * a, b * b);
        }
        __syncthreads();
    }
}

__device__ __forceinline__ void p0_transpose_item(const float* W, int K, int N, bf16_t* WT, LAS float* scr, int item, int lane) {
    const int nblk = N / 32, kb = item / nblk, nb = item % nblk, k0 = 64 * kb, n0 = 32 * nb;
#pragma unroll 8
    for (int i = 0; i < 32; ++i) { const int kk = 2 * i + (lane >> 5); scr[kk * 33 + (lane & 31)] = W[(size_t)(k0 + kk) * N + n0 + (lane & 31)]; }
    asm volatile("s_waitcnt lgkmcnt(0)" ::: "memory");
    const int c = lane & 7;
#pragma unroll
    for (int j = 0; j < 4; ++j) { const int n = (lane >> 3) + 8 * j; const LAS float* s = scr + (8 * c) * 33 + n;
        u32x4 o; o.x = pk2(s[0 * 33], s[1 * 33]); o.y = pk2(s[2 * 33], s[3 * 33]); o.z = pk2(s[4 * 33], s[5 * 33]); o.w = pk2(s[6 * 33], s[7 * 33]);
        *(u32x4*)(WT + (size_t)(n0 + n) * K + k0 + 8 * c) = o; }
    asm volatile("s_waitcnt lgkmcnt(0)" ::: "memory");
}
__device__ __forceinline__ void rms_row_to_bf16(const float* xrow, const float* g, bf16_t* orow, int lane) {
    f32x4 v[4]; float s = 0.f;
#pragma unroll
    for (int j = 0; j < 4; ++j) { v[j] = *((const f32x4*)xrow + lane + 64 * j); s += (v[j][0] * v[j][0] + v[j][1] * v[j][1]) + (v[j][2] * v[j][2] + v[j][3] * v[j][3]); }
    const float rs = rsqrtf(wave_sum(s) * (1.f / D_) + NORM_EPS);
#pragma unroll
    for (int j = 0; j < 4; ++j) { const f32x4 gg = *((const f32x4*)g + lane + 64 * j); store4bf(orow + 4 * (lane + 64 * j), v[j] * rs * gg); }
}

constexpr int AT_KS = 0, AT_VT = 36864, AT_PS = 72704;
__device__ __forceinline__ void attn_unit(LAS unsigned char* lds, int item, const bf16_t* QKV, bf16_t* OG, float* LSE) {
    const int tid = threadIdx.x, wid = tid >> 6, lane = tid & 63, fr = lane & 15, fq = lane >> 4;
    const int blk = item & 15, hs = (item >> 4) & 3, g = (item >> 6) % 3, b = item / 192;
    const int dsh = 2 * g, dil = 1 << dsh, nbk = 16 >> dsh, r = blk / nbk, n = blk % nbk, h = g * 4 + hs;
    const float slope = exp2f(-8.0f * (float)(h + 1) / 12.0f);
    const bf16_t* base = QKV + (size_t)b * T_ * QKVW;
    LAS unsigned char* Ks = lds + AT_KS; LAS unsigned char* Vt = lds + AT_VT; LAS unsigned char* Ps = lds + AT_PS + wid * (16 * 336);
#pragma unroll
    for (int i = 0; i < 4; ++i) { const int c = tid + 512 * i, row = c >> 3, part = c & 7; const int e = (n - 1) * 128 + row;
        u32x4 v = (u32x4){0u, 0u, 0u, 0u}; if (e >= 0) v = *(const u32x4*)(base + (size_t)((e << dsh) + r) * QKVW + 768 + h * 64 + part * 8);
        *(LAS u32x4*)(Ks + row * 144 + part * 16) = v; }
#pragma unroll
    for (int i = 0; i < 4; ++i) { const int key = tid & 255, part = (tid >> 8) + 2 * i; const int e = (n - 1) * 128 + key;
        u32x4 v = (u32x4){0u, 0u, 0u, 0u}; if (e >= 0) v = *(const u32x4*)(base + (size_t)((e << dsh) + r) * QKVW + 1536 + h * 64 + part * 8);
        LAS unsigned short* dst = (LAS unsigned short*)(Vt + (part * 8) * 560 + key * 2);
        dst[0 * 280] = (unsigned short)(v.x & 0xffff); dst[1 * 280] = (unsigned short)(v.x >> 16); dst[2 * 280] = (unsigned short)(v.y & 0xffff); dst[3 * 280] = (unsigned short)(v.y >> 16);
        dst[4 * 280] = (unsigned short)(v.z & 0xffff); dst[5 * 280] = (unsigned short)(v.z >> 16); dst[6 * 280] = (unsigned short)(v.w & 0xffff); dst[7 * 280] = (unsigned short)(v.w >> 16); }
    for (int idx = tid; idx < 64 * 12; idx += 512) { const int d = idx / 12, k2 = idx % 12; *(LAS unsigned*)(Vt + d * 560 + (256 + 2 * k2) * 2) = 0u; }
    const int qi = 16 * wid + fr; const int tq = ((n * 128 + qi) << dsh) + r;
    const bf16x8 qa0 = *(const bf16x8*)(base + (size_t)tq * QKVW + h * 64 + 8 * fq), qa1 = *(const bf16x8*)(base + (size_t)tq * QKVW + h * 64 + 32 + 8 * fq);
    __syncthreads();
    f32x4 s[10];
    float mx[4] = {-3.0e38f, -3.0e38f, -3.0e38f, -3.0e38f};
#pragma unroll
    for (int jt = 0; jt < 10; ++jt) {
        const int jtile = wid + jt; f32x4 a = (f32x4){0.f, 0.f, 0.f, 0.f};
        if (jtile < 16) {
            const bf16x8 k0 = *(const LAS bf16x8*)(Ks + (jtile * 16 + fr) * 144 + fq * 16), k1 = *(const LAS bf16x8*)(Ks + (jtile * 16 + fr) * 144 + 64 + fq * 16);
            a = __builtin_amdgcn_mfma_f32_16x16x32_bf16(qa0, k0, a, 0, 0, 0); a = __builtin_amdgcn_mfma_f32_16x16x32_bf16(qa1, k1, a, 0, 0, 0);
        }
        const int j = jtile * 16 + fr;
#pragma unroll
        for (int e = 0; e < 4; ++e) { const int i = 16 * wid + 4 * fq + e; const int delta = 128 + i - j;
            const bool valid = (jtile < 16) && (delta >= 0) && (delta <= 128) && (n > 0 || j >= 128);
            const float sc = valid ? (a[e] * 0.125f - slope * (float)(delta << dsh)) : -1.0e30f; a[e] = sc; mx[e] = fmaxf(mx[e], sc); }
        s[jt] = a;
    }
    float lsum[4];
#pragma unroll
    for (int e = 0; e < 4; ++e) { float m = mx[e]; m = fmaxf(m, __shfl_xor(m, 1)); m = fmaxf(m, __shfl_xor(m, 2)); m = fmaxf(m, __shfl_xor(m, 4)); m = fmaxf(m, __shfl_xor(m, 8)); mx[e] = m; lsum[e] = 0.f; }
#pragma unroll
    for (int jt = 0; jt < 10; ++jt)
#pragma unroll
        for (int e = 0; e < 4; ++e) { const float p = __expf(s[jt][e] - mx[e]); lsum[e] += p; *(LAS unsigned short*)(Ps + (4 * fq + e) * 336 + (jt * 16 + fr) * 2) = (unsigned short)f2bf(p); }
#pragma unroll
    for (int e = 0; e < 4; ++e) { float l = lsum[e]; l += __shfl_xor(l, 1); l += __shfl_xor(l, 2); l += __shfl_xor(l, 4); l += __shfl_xor(l, 8); lsum[e] = l; }
    asm volatile("s_waitcnt lgkmcnt(0)" ::: "memory");
    f32x4 o[4];
#pragma unroll
    for (int nt = 0; nt < 4; ++nt) o[nt] = (f32x4){0.f, 0.f, 0.f, 0.f};
#pragma unroll
    for (int ks = 0; ks < 5; ++ks) {
        const bf16x8 pa = *(const LAS bf16x8*)(Ps + fr * 336 + (32 * ks + 8 * fq) * 2);
#pragma unroll
        for (int nt = 0; nt < 4; ++nt) { const bf16x8 vb = *(const LAS bf16x8*)(Vt + (nt * 16 + fr) * 560 + (16 * wid + 32 * ks + 8 * fq) * 2); o[nt] = __builtin_amdgcn_mfma_f32_16x16x32_bf16(pa, vb, o[nt], 0, 0, 0); }
    }
#pragma unroll
    for (int e = 0; e < 4; ++e) { const int i = 16 * wid + 4 * fq + e; const int t = ((n * 128 + i) << dsh) + r; const size_t row = (size_t)b * T_ + t; const float inv = 1.f / lsum[e];
#pragma unroll
        for (int nt = 0; nt < 4; ++nt) OG[row * 768 + h * 64 + nt * 16 + fr] = (bf16_t)f2bf(o[nt][e] * inv);
        if (fr == 0) LSE[row * 12 + h] = mx[e] + __logf(lsum[e]); }
    __syncthreads();
}

__device__ __forceinline__ void sample_attn(LAS unsigned char* lds, int b, const float* ZS, const float* c128, const float* c512, const float* c2048, bf16_t* ATTS) {
    const int tid = threadIdx.x, wid = tid >> 6, lane = tid & 63;
    LAS float* qs = (LAS float*)lds;
    LAS float* sc = qs + 256;
    LAS float* og = sc + 4 * 132;
    LAS float* ls = og + 768;
    LAS float* lsm = ls + 12;
    const float* z = ZS + (size_t)b * NIN_;
    for (int g = 0; g < 3; ++g) {
        const int dsh = 2 * g, Lb = 128 << dsh; const float* cache = g == 0 ? c128 : (g == 1 ? c512 : c2048);
        const float* cb = cache + (size_t)b * Lb * 512;
        if (tid < 256) qs[tid] = z[g * 256 + tid];
        __syncthreads();
        { const int hs = tid >> 7, mi = tid & 127, m = mi + 1; const float slope = exp2f(-8.0f * (float)(g * 4 + hs + 1) / 12.0f);
          const float* kr = cb + (size_t)(Lb - (m << dsh)) * 512 + hs * 64; float d = 0.f;
#pragma unroll
          for (int i = 0; i < 16; ++i) { const f32x4 kv = *(const f32x4*)(kr + 4 * i); const f32x4 qv = *(const LAS f32x4*)(qs + hs * 64 + 4 * i); d += (kv[0] * qv[0] + kv[1] * qv[1]) + (kv[2] * qv[2] + kv[3] * qv[3]); }
          sc[hs * 132 + m] = d * 0.125f - slope * (float)(m << dsh);
          if (mi == 0) { const float* kn = z + 768 + (g * 4 + hs) * 64; float d0 = 0.f; for (int i = 0; i < 64; ++i) d0 += kn[i] * qs[hs * 64 + i]; sc[hs * 132] = d0 * 0.125f; } }
        __syncthreads();
        if (wid < 4) { const int hs = wid; float v0 = sc[hs * 132 + lane], v1 = sc[hs * 132 + 64 + lane], v2 = lane == 0 ? sc[hs * 132 + 128] : -3.0e38f;
            const float mxx = wave_max(fmaxf(fmaxf(v0, v1), v2)); const float p0 = __expf(v0 - mxx), p1 = __expf(v1 - mxx), p2 = lane == 0 ? __expf(v2 - mxx) : 0.f;
            const float l = wave_sum(p0 + p1 + p2); sc[hs * 132 + lane] = p0; sc[hs * 132 + 64 + lane] = p1; if (lane == 0) { sc[hs * 132 + 128] = p2; ls[g * 4 + hs] = mxx + __logf(l); lsm[hs] = l; } }
        __syncthreads();
        { const int hs = tid >> 7, d = (tid >> 1) & 63, half = tid & 1; float acc = 0.f;
          const int m0 = half ? 65 : 0, m1 = half ? 129 : 65;
          for (int m = m0; m < m1; ++m) { const float vv = (m == 0) ? z[1536 + (g * 4 + hs) * 64 + d] : cb[(size_t)(Lb - (m << dsh)) * 512 + 256 + hs * 64 + d]; acc += sc[hs * 132 + m] * vv; }
          acc += __shfl_xor(acc, 1);
          if (half == 0) og[(g * 4 + hs) * 64 + d] = acc / lsm[hs]; }
        __syncthreads();
    }
    if (tid < 256) { const int hs = tid >> 6, d = tid & 63; const float l0 = ls[hs], l1 = ls[4 + hs], l2 = ls[8 + hs]; const float mm = fmaxf(l0, fmaxf(l1, l2));
        const float w0 = __expf(l0 - mm), w1 = __expf(l1 - mm), w2 = __expf(l2 - mm); const float inv = 1.f / (w0 + w1 + w2);
        ATTS[(size_t)b * 256 + tid] = (bf16_t)f2bf((w0 * og[hs * 64 + d] + w1 * og[(4 + hs) * 64 + d] + w2 * og[(8 + hs) * 64 + d]) * inv); }
    __syncthreads();
}

struct RwW { const float *mu, *w0, *a0, *k_k, *k_a, *r_k, *gn_g, *gn_b, *wl, *al, *gl; };
__device__ __forceinline__ float decay_of(float w0c, float wl) { const float x = -(w0c + wl); const float sp = fmaxf(x, 0.f) + log1pf(__expf(-fabsf(x))); return __expf(-__expf(-sp - 0.5f)); }

__device__ __forceinline__ void sample_rwkv(LAS unsigned char* lds, int item, const float* ZS, const float* state_wkv, const float* state_shift, const RwW w, float* out, bf16_t* RWS) {
    const int tid = threadIdx.x, wid = tid >> 6, lane = tid & 63; const int b = item >> 3, h = item & 7;
    LAS float* xr = (LAS float*)lds; LAS float* xk = xr + 64; LAS float* xv = xk + 64; LAS float* lw = xv + 64; LAS float* la = lw + 64; LAS float* lg = la + 64;
    LAS float* pw = lg + 128; LAS float* pa = pw + 64; LAS float* pg = pa + 64;
    LAS float* sR = pg + 64; LAS float* sW = sR + 64; LAS float* sK = sW + 64; LAS float* sV = sK + 64; LAS float* sA = sV + 64; LAS float* sB = sA + 64; LAS float* sG = sB + 64; LAS float* sY = sG + 64; LAS float* sC = sY + 64;
    const float* zb = ZS + (size_t)b * NIN_ + QKVW; const float* pv = state_shift + (size_t)b * ZBW;
    if (tid < 448) { int col; if (tid < 192) col = (tid >> 6) * 512 + h * 64 + (tid & 63); else col = 1536 + (tid - 192);
        const float cur = zb[col], prv = pv[col]; const float mx = cur + (prv - cur) * w.mu[col];
        if (tid < 64) xr[tid] = mx; else if (tid < 128) xk[tid - 64] = mx; else if (tid < 192) xv[tid - 128] = mx; else if (tid < 256) lw[tid - 192] = tanhf(mx); else if (tid < 320) la[tid - 256] = mx; else lg[tid - 320] = sigm(mx); }
    __syncthreads();
    if (tid < 192) { const int which = tid >> 6, nn = tid & 63, c = h * 64 + nn; float acc = 0.f;
        if (which == 0) { for (int j = 0; j < 64; ++j) acc += lw[j] * w.wl[j * 512 + c]; pw[nn] = acc; }
        else if (which == 1) { for (int j = 0; j < 64; ++j) acc += la[j] * w.al[j * 512 + c]; pa[nn] = acc; }
        else { for (int j = 0; j < 128; ++j) acc += lg[j] * w.gl[j * 512 + c]; pg[nn] = acc; } }
    __syncthreads();
    if (wid == 0) { const int c = h * 64 + lane; const float r = xr[lane], k = xk[lane], v = xv[lane];
        const float dec = decay_of(w.w0[c], pw[lane]); const float a = sigm(w.a0[c] + pa[lane]);
        const float kkr = k * w.k_k[c]; const float nrm = fmaxf(sqrtf(wave_sum(kkr * kkr)), 1e-12f); const float kk = kkr / nrm;
        const float kp = k * (1.f + (a - 1.f) * w.k_a[c]); const float cs = wave_sum(r * kp * w.r_k[c]);
        sR[lane] = r; sW[lane] = dec; sK[lane] = kp; sV[lane] = v; sA[lane] = -kk; sB[lane] = kk * a; sG[lane] = pg[lane]; if (lane == 0) sC[0] = cs; }
    __syncthreads();
    { const int row = tid >> 3, kq = tid & 7; const float* S0 = state_wkv + ((size_t)(b * 8 + h) * 64 + row) * 64 + 8 * kq; float s[8];
      const f32x4 s0 = *(const f32x4*)S0, s1 = *(const f32x4*)(S0 + 4); s[0] = s0[0]; s[1] = s0[1]; s[2] = s0[2]; s[3] = s0[3]; s[4] = s1[0]; s[5] = s1[1]; s[6] = s1[2]; s[7] = s1[3];
      float dot = 0.f;
#pragma unroll
      for (int i = 0; i < 8; ++i) dot += s[i] * sA[8 * kq + i];
      const float sa = red8(dot); const float vv = sV[row]; float yp = 0.f;
#pragma unroll
      for (int i = 0; i < 8; ++i) { s[i] = s[i] * sW[8 * kq + i] + sa * sB[8 * kq + i] + vv * sK[8 * kq + i]; yp += s[i] * sR[8 * kq + i]; }
      const float y = red8(yp); float* So = out + O_WKVS + ((size_t)(b * 8 + h) * 64 + row) * 64 + 8 * kq;
      *(f32x4*)So = (f32x4){s[0], s[1], s[2], s[3]}; *(f32x4*)(So + 4) = (f32x4){s[4], s[5], s[6], s[7]};
      if (kq == 0) sY[row] = y; }
    __syncthreads();
    if (wid == 0) { const int c = h * 64 + lane; const float y = sY[lane]; const float mu = wave_sum(y) * (1.f / 64.f); const float dv = y - mu; const float var = wave_sum(dv * dv) * (1.f / 64.f);
        const float yn = dv * rsqrtf(var + GN_EPS) * w.gn_g[c] + w.gn_b[c]; RWS[(size_t)b * 512 + c] = (bf16_t)f2bf((yn + sC[0] * sV[lane]) * sG[lane]); }
    __syncthreads();
}

constexpr int SC_C = 32;
constexpr int SC_XR = 0, SC_XK = 8192, SC_XV = 16384, SC_PW = 24576, SC_PA = 32768, SC_PG = 40960, SC_LW = 49152, SC_LA = SC_LW + 32 * 144, SC_LG = SC_LA + 32 * 144, SC_END = SC_LG + 32 * 272;
__device__ __forceinline__ void scan_unit(LAS unsigned char* lds, int su, const bf16_t* ZB, const RwW w, const bf16_t* WlT, const bf16_t* AlT, const bf16_t* GlT, float* Y, float* G, float* BON, float* out) {
    const int tid = threadIdx.x, wid = tid >> 6, lane = tid & 63, fr = lane & 15, fq = lane >> 4;
    const int bh = su >> 1, rs = su & 1, b = bh >> 3, h = bh & 7;
    LAS float* XR = (LAS float*)(lds + SC_XR); LAS float* XK = (LAS float*)(lds + SC_XK); LAS float* XV = (LAS float*)(lds + SC_XV);
    LAS float* PW = (LAS float*)(lds + SC_PW); LAS float* PA = (LAS float*)(lds + SC_PA); LAS float* PG = (LAS float*)(lds + SC_PG);
    LAS unsigned char* LW = lds + SC_LW; LAS unsigned char* LA = lds + SC_LA; LAS unsigned char* LG = lds + SC_LG;
    const int ttile = wid >> 2, ntile = wid & 3; const int ncol = h * 64 + ntile * 16 + fr;
    bf16x8 Bw[2], Ba[2], Bg[4];
#pragma unroll
    for (int ks = 0; ks < 2; ++ks) { Bw[ks] = *(const bf16x8*)(WlT + (size_t)ncol * 64 + 32 * ks + 8 * fq); Ba[ks] = *(const bf16x8*)(AlT + (size_t)ncol * 64 + 32 * ks + 8 * fq); }
#pragma unroll
    for (int ks = 0; ks < 4; ++ks) Bg[ks] = *(const bf16x8*)(GlT + (size_t)ncol * 128 + 32 * ks + 8 * fq);
    const int tt = tid >> 4, q = tid & 15, c0 = h * 64 + 4 * q;
    const f32x4 mu_r = *(const f32x4*)(w.mu + c0), mu_k = *(const f32x4*)(w.mu + 512 + c0), mu_v = *(const f32x4*)(w.mu + 1024 + c0);
    const f32x4 mu_w = *(const f32x4*)(w.mu + 1536 + 4 * q), mu_a = *(const f32x4*)(w.mu + 1600 + 4 * q), mu_g0 = *(const f32x4*)(w.mu + 1664 + 8 * q), mu_g1 = *(const f32x4*)(w.mu + 1668 + 8 * q);
    const f32x4 c_w0 = *(const f32x4*)(w.w0 + c0), c_a0 = *(const f32x4*)(w.a0 + c0), c_kk = *(const f32x4*)(w.k_k + c0), c_ka = *(const f32x4*)(w.k_a + c0), c_rk = *(const f32x4*)(w.r_k + c0);
    const int rowl = tid >> 4, kq = tid & 15;
    float s0 = 0.f, s1 = 0.f, s2 = 0.f, s3 = 0.f;
    const bf16_t* zbase = ZB + (size_t)b * T_ * ZBW;
    for (int t0 = 0; t0 < T_; t0 += SC_C) {
        { const int t = t0 + tt; const bf16_t* cur = zbase + (size_t)t * ZBW; const bf16_t* prv = cur - ZBW; const bool hp = t > 0;
          const f32x4 z4 = (f32x4){0.f, 0.f, 0.f, 0.f};
          f32x4 cr = load4bf(cur + c0), ck = load4bf(cur + 512 + c0), cv = load4bf(cur + 1024 + c0), cw = load4bf(cur + 1536 + 4 * q), ca = load4bf(cur + 1600 + 4 * q), cg0 = load4bf(cur + 1664 + 8 * q), cg1 = load4bf(cur + 1668 + 8 * q);
          f32x4 pr = hp ? load4bf(prv + c0) : z4, pk = hp ? load4bf(prv + 512 + c0) : z4, pv = hp ? load4bf(prv + 1024 + c0) : z4, pw = hp ? load4bf(prv + 1536 + 4 * q) : z4, pa = hp ? load4bf(prv + 1600 + 4 * q) : z4,
                pg0 = hp ? load4bf(prv + 1664 + 8 * q) : z4, pg1 = hp ? load4bf(prv + 1668 + 8 * q) : z4;
          cr = cr + (pr - cr) * mu_r; ck = ck + (pk - ck) * mu_k; cv = cv + (pv - cv) * mu_v; cw = cw + (pw - cw) * mu_w; ca = ca + (pa - ca) * mu_a; cg0 = cg0 + (pg0 - cg0) * mu_g0; cg1 = cg1 + (pg1 - cg1) * mu_g1;
          *(LAS f32x4*)(XR + tt * 64 + 4 * q) = cr; *(LAS f32x4*)(XK + tt * 64 + 4 * q) = ck; *(LAS f32x4*)(XV + tt * 64 + 4 * q) = cv;
          u32x2 o; o.x = pk2(tanhf(cw[0]), tanhf(cw[1])); o.y = pk2(tanhf(cw[2]), tanhf(cw[3])); *(LAS u32x2*)(LW + tt * 144 + 8 * q) = o;
          o.x = pk2(ca[0], ca[1]); o.y = pk2(ca[2], ca[3]); *(LAS u32x2*)(LA + tt * 144 + 8 * q) = o;
          u32x4 o4; o4.x = pk2(sigm(cg0[0]), sigm(cg0[1])); o4.y = pk2(sigm(cg0[2]), sigm(cg0[3])); o4.z = pk2(sigm(cg1[0]), sigm(cg1[1])); o4.w = pk2(sigm(cg1[2]), sigm(cg1[3])); *(LAS u32x4*)(LG + tt * 272 + 16 * q) = o4; }
        __syncthreads();
        { f32x4 wl = (f32x4){0.f, 0.f, 0.f, 0.f}, al = wl, gl = wl;
#pragma unroll
          for (int ks = 0; ks < 2; ++ks) { const bf16x8 aw = *(const LAS bf16x8*)(LW + (ttile * 16 + fr) * 144 + 64 * ks + 16 * fq), aa = *(const LAS bf16x8*)(LA + (ttile * 16 + fr) * 144 + 64 * ks + 16 * fq);
              wl = __builtin_amdgcn_mfma_f32_16x16x32_bf16(aw, Bw[ks], wl, 0, 0, 0); al = __builtin_amdgcn_mfma_f32_16x16x32_bf16(aa, Ba[ks], al, 0, 0, 0); }
#pragma unroll
          for (int ks = 0; ks < 4; ++ks) { const bf16x8 ag = *(const LAS bf16x8*)(LG + (ttile * 16 + fr) * 272 + 64 * ks + 16 * fq); gl = __builtin_amdgcn_mfma_f32_16x16x32_bf16(ag, Bg[ks], gl, 0, 0, 0); }
#pragma unroll
          for (int e = 0; e < 4; ++e) { const int tr = ttile * 16 + 4 * fq + e, nc = ntile * 16 + fr; PW[tr * 64 + nc] = wl[e]; PA[tr * 64 + nc] = al[e]; PG[tr * 64 + nc] = gl[e]; } }
        __syncthreads();
        { const f32x4 wl = *(LAS f32x4*)(PW + tt * 64 + 4 * q), al = *(LAS f32x4*)(PA + tt * 64 + 4 * q), gl = *(LAS f32x4*)(PG + tt * 64 + 4 * q);
          const f32x4 r4 = *(LAS f32x4*)(XR + tt * 64 + 4 * q), k4 = *(LAS f32x4*)(XK + tt * 64 + 4 * q), v4 = *(LAS f32x4*)(XV + tt * 64 + 4 * q);
          f32x4 dec, a4, kkr, kp; float ssq = 0.f, cs = 0.f;
#pragma unroll
          for (int e = 0; e < 4; ++e) { dec[e] = decay_of(c_w0[e], wl[e]); a4[e] = sigm(c_a0[e] + al[e]); kkr[e] = k4[e] * c_kk[e]; ssq += kkr[e] * kkr[e]; kp[e] = k4[e] * (1.f + (a4[e] - 1.f) * c_ka[e]); cs += r4[e] * kp[e] * c_rk[e]; }
          ssq = red16(ssq); cs = red16(cs); const float inv = 1.f / fmaxf(sqrtf(ssq), 1e-12f);
          const f32x4 kk = kkr * inv;
          *(LAS f32x4*)(PW + tt * 64 + 4 * q) = dec; *(LAS f32x4*)(PA + tt * 64 + 4 * q) = -kk; *(LAS f32x4*)(PG + tt * 64 + 4 * q) = kk * a4; *(LAS f32x4*)(XK + tt * 64 + 4 * q) = kp;
          if (rs == 0) { const size_t off = ((size_t)b * T_ + t0 + tt) * 512 + c0; *(f32x4*)(G + off) = gl; *(f32x4*)(BON + off) = v4 * cs; } }
        __syncthreads();
        { float* yp = Y + ((size_t)b * T_ + t0) * 512 + h * 64 + rs * 32 + rowl;
#pragma unroll 4
          for (int i = 0; i < SC_C; ++i) {
              const f32x4 a4 = *(LAS f32x4*)(PA + i * 64 + 4 * kq), w4 = *(LAS f32x4*)(PW + i * 64 + 4 * kq), b4 = *(LAS f32x4*)(PG + i * 64 + 4 * kq), k4 = *(LAS f32x4*)(XK + i * 64 + 4 * kq), r4 = *(LAS f32x4*)(XR + i * 64 + 4 * kq);
              const float vv = XV[i * 64 + rs * 32 + rowl];
              const float sa = red16((s0 * a4[0] + s1 * a4[1]) + (s2 * a4[2] + s3 * a4[3]));
              s0 = (s0 * w4[0] + vv * k4[0]) + sa * b4[0]; s1 = (s1 * w4[1] + vv * k4[1]) + sa * b4[1]; s2 = (s2 * w4[2] + vv * k4[2]) + sa * b4[2]; s3 = (s3 * w4[3] + vv * k4[3]) + sa * b4[3];
              const float y = red16((s0 * r4[0] + s1 * r4[1]) + (s2 * r4[2] + s3 * r4[3]));
              if (kq == 0) yp[(size_t)i * 512] = y;
          } }
        __syncthreads();
    }
    *(f32x4*)(out + O_WKVP + ((size_t)(b * 8 + h) * 64 + rs * 32 + rowl) * 64 + 4 * kq) = (f32x4){s0, s1, s2, s3};
}

struct Args { const float* in[28]; float* out; unsigned char* ws; int ph_lo, ph_hi; };
constexpr int N_PH = 9;

__global__ void __launch_bounds__(512, 2) fwd_kernel(Args args) {
    extern __shared__ __attribute__((aligned(16))) unsigned char lds_raw[];
    LAS unsigned char* lds = (LAS unsigned char*)lds_raw;
    const int tid = threadIdx.x, lane = tid & 63, wid = __builtin_amdgcn_readfirstlane(tid >> 6);
    const int G = gridDim.x, bx = blockIdx.x;
    const int gw = bx * 8 + wid, NGW = G * 8;
    unsigned char* ws = args.ws; float* out = args.out;
    const float* x = args.in[0]; const float* xs = args.in[1];
    unsigned* ctl = (unsigned*)(ws + WS_CTL);
    float* SS1 = (float*)(ws + CTL_SS1); float* SS1S = (float*)(ws + CTL_SS1S); float* SS2 = (float*)(ws + CTL_SS2); float* SS2S = (float*)(ws + CTL_SS2S);
    bf16_t* WinT = (bf16_t*)(ws + WS_WIN); bf16_t* WaT = (bf16_t*)(ws + WS_WA); bf16_t* WbT = (bf16_t*)(ws + WS_WB); bf16_t* WoT = (bf16_t*)(ws + WS_WO); bf16_t* WupT = (bf16_t*)(ws + WS_WUP); bf16_t* WdnT = (bf16_t*)(ws + WS_WDN);
    bf16_t* WlT = (bf16_t*)(ws + WS_WL); bf16_t* AlT = (bf16_t*)(ws + WS_AL); bf16_t* GlT = (bf16_t*)(ws + WS_GL);
    unsigned char* sm = ws + WS_SMALL;
    bf16_t* H1S = (bf16_t*)(sm + SM_H1S); float* ZS = (float*)(sm + SM_ZS); bf16_t* ATTS = (bf16_t*)(sm + SM_ATTS); bf16_t* RWS = (bf16_t*)(sm + SM_RWS); bf16_t* MGS = (bf16_t*)(sm + SM_MGS); bf16_t* X1GS = (bf16_t*)(sm + SM_X1GS); bf16_t* US = (bf16_t*)(sm + SM_US);
    bf16_t* H1 = (bf16_t*)(ws + WS_H1); bf16_t* QKV = (bf16_t*)(ws + WS_QKV); bf16_t* ZB = (bf16_t*)(ws + WS_ZB); bf16_t* U = (bf16_t*)(ws + WS_U); bf16_t* GATE = (bf16_t*)(ws + WS_GATE);
    bf16_t* OG = (bf16_t*)(ws + WS_OG); float* LSE = (float*)(ws + WS_LSE); bf16_t* ATT = (bf16_t*)(ws + WS_ATT); bf16_t* RW = (bf16_t*)(ws + WS_RW); bf16_t* MG = (bf16_t*)(ws + WS_MG);
    float* Yb = (float*)(ws + WS_Y); float* Gb = (float*)(ws + WS_G); float* BON = (float*)(ws + WS_BON); float* TMP = (float*)(ws + WS_TMP);
    SP sp; sp.ZS = ZS; sp.b_gate = args.in[9]; sp.out = out; sp.xs = xs; sp.g2 = args.in[24]; sp.MGS = MGS; sp.X1GS = X1GS; sp.US = US; sp.SS1S = SS1S; sp.SS2S = SS2S;
    const int lo = args.ph_lo, hi = args.ph_hi;
#ifndef MK_ONLY
#define MK_ONLY -1
#endif
#define IN(k) ((MK_ONLY < 0 || MK_ONLY == (k)) && lo <= (k) && (k) < hi)
#define SEAM(k) do { if (IN(k) && IN((k) + 1)) { cg::this_grid().sync(); } } while (0)

    if (IN(0)) {
        LAS float* scr = (LAS float*)(lds + wid * 16384);
        constexpr int I_IN = 16 * 192, I_A = 4 * 32, I_B = 8 * 32, I_O = 16 * 32, I_UP = 16 * 128, I_DN = 64 * 32, I_WL = 16, I_AL = 16, I_GL = 32;
        constexpr int NITEMS = I_IN + I_A + I_B + I_O + I_UP + I_DN + I_WL + I_AL + I_GL;
        for (int it = gw; it < NITEMS; it += NGW) {
            int r = it;
            if (r < I_IN) { p0_transpose_item(args.in[8], 1024, 6144, WinT, scr, r, lane); continue; } r -= I_IN;
            if (r < I_A) { p0_transpose_item(args.in[21], 256, 1024, WaT, scr, r, lane); continue; } r -= I_A;
            if (r < I_B) { p0_transpose_item(args.in[22], 512, 1024, WbT, scr, r, lane); continue; } r -= I_B;
            if (r < I_O) { p0_transpose_item(args.in[23], 1024, 1024, WoT, scr, r, lane); continue; } r -= I_O;
            if (r < I_UP) { p0_transpose_item(args.in[25], 1024, 4096, WupT, scr, r, lane); continue; } r -= I_UP;
            if (r < I_DN) { p0_transpose_item(args.in[26], 4096, 1024, WdnT, scr, r, lane); continue; } r -= I_DN;
            if (r < I_WL) { p0_transpose_item(args.in[12], 64, 512, WlT, scr, r, lane); continue; } r -= I_WL;
            if (r < I_AL) { p0_transpose_item(args.in[14], 64, 512, AlT, scr, r, lane); continue; } r -= I_AL;
            p0_transpose_item(args.in[15], 128, 512, GlT, scr, r, lane);
        }
        for (int m = gw; m < M_ + MS_; m += NGW) { if (m < M_) rms_row_to_bf16(x + (size_t)m * D_, args.in[7], H1 + (size_t)m * D_, lane); else rms_row_to_bf16(xs + (size_t)(m - M_) * D_, args.in[7], H1S + (size_t)(m - M_) * D_, lane); }
        __syncthreads();
    }
    SEAM(0);
    if (IN(1)) {
        pg8::Gemm g{H1, WinT, M_, NIN_, D_}; pg8::StaticOrder S; S.init(M_, NIN_, G, bx);
        EpiZ E{QKV, ZB, GATE, args.in[9], out};
        pg8::gemm_phase<EpiZ, pg8::StaticOrder, true, true>(lds, g, S, E);
        sample_gemm<0>(lds, H1S, D_, WinT, nullptr, 0, nullptr, NIN_, sp);
    }
    SEAM(1);
    if (IN(2)) {
        RwW w; w.mu = args.in[10]; w.w0 = args.in[11]; w.wl = args.in[12]; w.a0 = args.in[13]; w.al = args.in[14]; w.gl = args.in[15]; w.k_k = args.in[16]; w.k_a = args.in[17]; w.r_k = args.in[18]; w.gn_g = args.in[19]; w.gn_b = args.in[20];
        for (int su = bx; su < 128; su += G) scan_unit(lds, su, ZB, w, WlT, AlT, GlT, Yb, Gb, BON, out);
        volatile LAS int* qslot = (volatile LAS int*)(lds + MISC_OFF);
        constexpr int NQ = 32 + 256 + 1536;
        for (;;) {
            if (tid == 0) *qslot = (int)atomicAdd(ctl, 1u);
            __syncthreads(); const int item = *qslot; __syncthreads();
            if (item >= NQ) break;
            if (item < 32) sample_attn(lds, item, ZS, args.in[2], args.in[3], args.in[4], ATTS);
            else if (item < 288) sample_rwkv(lds, item - 32, ZS, args.in[5], args.in[6], w, out, RWS);
            else attn_unit(lds, item - 288, QKV, OG, LSE);
        }
    }
    SEAM(2);
    if (IN(3)) {
        const float* gn_g = args.in[19]; const float* gn_b = args.in[20];
        for (int m = gw; m < M_; m += NGW) {
            { const int hs = lane >> 4; const float l0 = LSE[(size_t)m * 12 + hs], l1 = LSE[(size_t)m * 12 + 4 + hs], l2 = LSE[(size_t)m * 12 + 8 + hs]; const float mm = fmaxf(l0, fmaxf(l1, l2));
              const float w0 = __expf(l0 - mm), w1 = __expf(l1 - mm), w2 = __expf(l2 - mm); const float inv = 1.f / (w0 + w1 + w2);
              const f32x4 o0 = load4bf(OG + (size_t)m * 768 + 4 * lane), o1 = load4bf(OG + (size_t)m * 768 + 256 + 4 * lane), o2 = load4bf(OG + (size_t)m * 768 + 512 + 4 * lane);
              store4bf(ATT + (size_t)m * 256 + 4 * lane, (o0 * w0 + o1 * w1 + o2 * w2) * inv); }
            { const size_t off = (size_t)m * 512 + 8 * lane; const f32x4 y0 = *(const f32x4*)(Yb + off), y1 = *(const f32x4*)(Yb + off + 4);
              const float mu = red8((y0[0] + y0[1]) + (y0[2] + y0[3]) + (y1[0] + y1[1]) + (y1[2] + y1[3])) * (1.f / 64.f); const f32x4 d0 = y0 - mu, d1 = y1 - mu;
              const float var = red8((d0[0] * d0[0] + d0[1] * d0[1]) + (d0[2] * d0[2] + d0[3] * d0[3]) + (d1[0] * d1[0] + d1[1] * d1[1]) + (d1[2] * d1[2] + d1[3] * d1[3])) * (1.f / 64.f); const float rstd = rsqrtf(var + GN_EPS);
              const f32x4 g0 = *(const f32x4*)(gn_g + 8 * lane), g1 = *(const f32x4*)(gn_g + 8 * lane + 4), b0 = *(const f32x4*)(gn_b + 8 * lane), b1 = *(const f32x4*)(gn_b + 8 * lane + 4);
              const f32x4 bo0 = *(const f32x4*)(BON + off), bo1 = *(const f32x4*)(BON + off + 4), gg0 = *(const f32x4*)(Gb + off), gg1 = *(const f32x4*)(Gb + off + 4);
              store8bf(RW + off, (d0 * rstd * g0 + b0 + bo0) * gg0, (d1 * rstd * g1 + b1 + bo1) * gg1); }
        }
    }
    SEAM(3);
    if (IN(4)) {
        pg8::StaticOrder S; S.init(M_, D_, G, bx);
        int ka = 256, kb = 512; asm volatile("" : "+s"(ka), "+s"(kb));
        { pg8::Gemm g{ATT, WaT, M_, D_, ka}; EpiPA E{GATE, TMP}; pg8::gemm_phase<EpiPA, pg8::StaticOrder, true, true>(lds, g, S, E); }
        { pg8::Gemm g{RW, WbT, M_, D_, kb}; EpiPB E{GATE, TMP, MG}; pg8::gemm_phase<EpiPB, pg8::StaticOrder, true, true>(lds, g, S, E); }
        sample_gemm<1>(lds, ATTS, 256, WaT, RWS, 512, WbT, D_, sp);
    }
    SEAM(4);
    if (IN(5)) {
        pg8::Gemm g{MG, WoT, M_, D_, D_}; pg8::StaticOrder S; S.init(M_, D_, G, bx);
        EpiRes<true> E{x, out + O_Y, H1, args.in[24], SS1};
        pg8::gemm_phase<EpiRes<true>, pg8::StaticOrder, true, true>(lds, g, S, E);
        sample_gemm<2>(lds, MGS, D_, WoT, nullptr, 0, nullptr, D_, sp);
    }
    SEAM(5);
    if (IN(6)) {
        pg8::Gemm g{H1, WupT, M_, FF_, D_}; pg8::StaticOrder S; S.init(M_, FF_, G, bx);
        EpiUp E{SS1, U};
        pg8::gemm_phase<EpiUp, pg8::StaticOrder, true, true>(lds, g, S, E);
        sample_gemm<3>(lds, X1GS, D_, WupT, nullptr, 0, nullptr, FF_, sp);
    }
    SEAM(6);
    if (IN(7)) {
        pg8::Gemm g{U, WdnT, M_, D_, FF_}; pg8::StaticOrder S; S.init(M_, D_, G, bx);
        EpiRes<false> E{out + O_Y, out + O_Y, nullptr, nullptr, SS2};
        pg8::gemm_phase<EpiRes<false>, pg8::StaticOrder, true, true>(lds, g, S, E);
        sample_gemm<4>(lds, US, FF_, WdnT, nullptr, 0, nullptr, D_, sp);
    }
    SEAM(7);
    if (IN(8)) {
        const float* gf = args.in[27];
        for (int m = gw; m < M_ + MS_; m += NGW) {
            float* row = (m < M_) ? (out + O_Y + (size_t)m * D_) : (out + O_YS + (size_t)(m - M_) * D_); const float ss = (m < M_) ? SS2[m] : SS2S[m - M_];
            const float rs = rsqrtf(ss * (1.f / D_) + NORM_EPS);
#pragma unroll
            for (int j = 0; j < 4; ++j) { f32x4* p = (f32x4*)row + lane + 64 * j; const f32x4 gg = *((const f32x4*)gf + lane + 64 * j); *p = *p * rs * gg; }
        }
    }
#undef IN
#undef SEAM
}
}

#ifndef MK_N_LAUNCHES
#define MK_N_LAUNCHES 1
#endif
extern "C" void kernel_launch(void* const* d_in, const int* in_sizes, int n_in, void* d_out, int out_size, void* d_ws, size_t ws_size, hipStream_t stream) {
    static int grid = 0;
    if (grid == 0) {
        if (n_in != 28 || (size_t)out_size != mk::O_END || ws_size < mk::WS_END) { fprintf(stderr, "kernel_launch: unexpected shapes: n_in %d out %d ws %zu\n", n_in, out_size, ws_size); grid = -1; return; }
        int dev = 0, cus = 0, per_cu = 0;
        if (hipGetDevice(&dev) != hipSuccess || hipDeviceGetAttribute(&cus, hipDeviceAttributeMultiprocessorCount, dev) != hipSuccess) { grid = -1; return; }
        if (hipFuncSetAttribute((const void*)mk::fwd_kernel, hipFuncAttributeMaxDynamicSharedMemorySize, mk::LDS_BYTES) != hipSuccess) { fprintf(stderr, "kernel_launch: hipFuncSetAttribute failed\n"); grid = -1; return; }
        if (hipOccupancyMaxActiveBlocksPerMultiprocessor(&per_cu, (const void*)mk::fwd_kernel, 512, mk::LDS_BYTES) != hipSuccess || per_cu < 1) { fprintf(stderr, "kernel_launch: occupancy query says %d\n", per_cu); }
        (void)hipGetLastError();
        grid = cus;
    }
    if (grid < 0) return;
    (void)hipMemsetAsync((char*)d_ws + mk::WS_CTL, 0, mk::CTL_ZERO_BYTES, stream);
    mk::Args a{};
    for (int i = 0; i < 28; ++i) a.in[i] = (const float*)d_in[i];
    a.out = (float*)d_out; a.ws = (unsigned char*)d_ws;
    if (MK_N_LAUNCHES == 1) {
        a.ph_lo = 0; a.ph_hi = mk::N_PH;
        void* params[] = {&a};
        hipError_t e = hipLaunchCooperativeKernel((const void*)mk::fwd_kernel, dim3(grid), dim3(512), params, mk::LDS_BYTES, stream);
        if (e != hipSuccess) fprintf(stderr, "cooperative launch failed: %s (grid %d)\n", hipGetErrorString(e), grid);
    } else {
        for (int ph = 0; ph < mk::N_PH; ++ph) { a.ph_lo = ph; a.ph_hi = ph + 1; hipLaunchKernelGGL(mk::fwd_kernel, dim3(grid), dim3(512), mk::LDS_BYTES, stream, a); }
    }
}
```

```cpp
#include <hip/hip_runtime.h>
#include <hip/hip_cooperative_groups.h>
#include <cstdio>
#include <cstdint>
namespace cg = cooperative_groups;
namespace pg8 {
#define PG8_LAS __attribute__((address_space(3)))
typedef unsigned short bf16_t;
typedef short bf16x8 __attribute__((ext_vector_type(8)));
typedef float f32x4 __attribute__((ext_vector_type(4)));
typedef unsigned u32x4 __attribute__((ext_vector_type(4)));
constexpr int BM = 256, BK = 64, HALF = 128, HTB = HALF * BK * 2  , STAGE_BYTES = 8 * HTB, NXCD = 8, WGM = 8;

__host__ __device__ __forceinline__ int lds_byte(int r, int c) { const int st = (r >> 4) * 2 + (c >> 5), rr = r & 15, cc = c & 31, ob = rr * 64 + cc * 2; return st * 1024 + (ob ^ (((ob >> 9) & 1) << 5)); }
__host__ __device__ __forceinline__ void stage_rc(int b, int& R, int& C) { const int st = b / 1024, sb = b % 1024, swz = sb ^ (((sb >> 9) & 1) << 5); R = (st >> 1) * 16 + swz / 64; C = (st & 1) * 32 + (swz % 64) / 2; }
__host__ __device__ __forceinline__ int perm32(int rho) { const int n = rho >> 4, i = rho & 15; return 8 * (i >> 2) + 4 * n + (i & 3); }

struct Unit { int pm, pn; };
struct Gemm { const bf16_t* A; const bf16_t* Bt; int M, N, K; };

struct StaticOrder {
    int nM, nN, nwg, G, c;
    __host__ __device__ void init(int M, int N, int G_, int c_) { nM = M / BM; nN = N / BM; nwg = nM * nN; G = G_; c = c_; }
    __host__ __device__ bool next(int i, Unit& u) const {
        const long L = (long)i * G + c; if (L >= nwg) return false;
        int wgid = (int)L; { const int q = nwg / NXCD, r = nwg % NXCD, xcd = wgid % NXCD, off = wgid / NXCD; wgid = (xcd < r ? xcd * (q + 1) : r * (q + 1) + (xcd - r) * q) + off; }
        const int nig = WGM * nN, gid = wgid / nig, fm = gid * WGM, gsz = (nM - fm) < WGM ? (nM - fm) : WGM;
        u.pm = fm + ((wgid % nig) % gsz); u.pn = (wgid % nig) / gsz; return true;
    }
    __device__ __forceinline__ void a_ready(const Unit&) const {}
    __device__ __forceinline__ void done(const Unit&) const {}
};

__device__ __forceinline__ unsigned cvt_pk_bf16(float lo, float hi) { unsigned r; asm volatile("v_cvt_pk_bf16_f32 %0, %1, %2" : "=v"(r) : "v"(lo), "v"(hi)); return r; }
template <class Epi, class Sched, bool ALIGN_EPI = false, bool SP2 = false>
__device__ __forceinline__ void gemm_phase(PG8_LAS unsigned char* lds, const Gemm g, const Sched& S, const Epi& E) {
    const int tid = threadIdx.x, wid = __builtin_amdgcn_readfirstlane(tid >> 6), lane = tid & 63, wr = wid >> 2, wc = wid & 3, fr = lane & 15, fq = lane >> 4;
    const int K = g.K, nt = K / BK;
    unsigned voffA[2], voffB[2];
#pragma unroll
    for (int i = 0; i < 2; ++i) { int R, C; stage_rc(tid * 16 + i * 8192, R, C); const int Rb = Epi::PERM ? ((R & ~31) + perm32(R & 31)) : R;
        voffA[i] = (unsigned)(R * K + C) * 2u; voffB[i] = (unsigned)(Rb * K + C) * 2u; }
    const size_t kstep = (size_t)(BK * 2);
    const size_t hstep = (size_t)HALF * K * 2;
    const size_t tstep = 2 * hstep;
    const unsigned ldsw = (unsigned)wid * 1024u;
    const int aoff = lds_byte(wr * 64 + fr, fq * 8), boff = lds_byte(wc * 32 + fr, fq * 8);
#define PG8_SA(b, h) (((b) * 2 + (h)) * HTB)
#define PG8_SB(b, h) ((4 + (b) * 2 + (h)) * HTB)
#define PG8_STAGE(bufoff, gbase, voff) do { _Pragma("unroll") for (int _i = 0; _i < 2; ++_i) \
        __builtin_amdgcn_global_load_lds((const unsigned*)((const char*)(gbase) + (voff)[_i]), (PG8_LAS unsigned*)(lds + (bufoff) + ldsw + _i * 8192), 16, 0, 0); } while (0)
#define PG8_LDA(dst, b, h) do { _Pragma("unroll") for (int m = 0; m < 4; ++m) _Pragma("unroll") for (int k = 0; k < 2; ++k) dst[m][k] = *(const PG8_LAS bf16x8*)(lds + PG8_SA(b, h) + aoff + m * 2048 + k * 1024); } while (0)
#define PG8_LDB(dst, b, h) do { _Pragma("unroll") for (int n = 0; n < 2; ++n) _Pragma("unroll") for (int k = 0; k < 2; ++k) dst[n][k] = *(const PG8_LAS bf16x8*)(lds + PG8_SB(b, h) + boff + n * 2048 + k * 1024); } while (0)
#define PG8_MMA(ai, bj, At, Bt) do { __builtin_amdgcn_s_setprio(1); _Pragma("unroll") for (int m = 0; m < 4; ++m) _Pragma("unroll") for (int n = 0; n < 2; ++n) _Pragma("unroll") for (int k = 0; k < 2; ++k) \
        acc[ai][bj][m][n] = __builtin_amdgcn_mfma_f32_16x16x32_bf16(Bt[n][k], At[m][k], acc[ai][bj][m][n], 0, 0, 0); __builtin_amdgcn_s_setprio(0); } while (0)
#define PG8_WAIT_V(n) asm volatile("s_waitcnt vmcnt(" #n ")" ::: "memory")
#define PG8_WAIT_L(n) asm volatile("s_waitcnt lgkmcnt(" #n ")" ::: "memory")
#define PG8_BAR __builtin_amdgcn_s_barrier()
#define PG8_SCHED __builtin_amdgcn_sched_barrier(0)
    Unit cur, nxt; int ui = 0;
    if (!S.next(0, cur)) return;
    f32x4 acc[2][2][4][2];
#pragma unroll
    for (int a = 0; a < 2; ++a)
#pragma unroll
        for (int b = 0; b < 2; ++b)
#pragma unroll
            for (int m = 0; m < 4; ++m)
#pragma unroll
                for (int n = 0; n < 2; ++n) acc[a][b][m][n] = (f32x4){0.f, 0.f, 0.f, 0.f};
    bf16x8 At[4][2], B0[2][2], B1[2][2];
    const char* cA = (const char*)g.A + (size_t)cur.pm * tstep; const char* cB = (const char*)g.Bt + (size_t)cur.pn * tstep;
    S.a_ready(cur);
    if constexpr (SP2) {
        PG8_STAGE(PG8_SB(0, 0), cB, voffB); PG8_STAGE(PG8_SB(0, 1), cB + hstep, voffB); PG8_STAGE(PG8_SA(0, 0), cA, voffA); PG8_STAGE(PG8_SA(0, 1), cA + hstep, voffA);
        if (wr == 1) PG8_BAR;
        PG8_WAIT_V(2); PG8_BAR;
        PG8_STAGE(PG8_SB(1, 0), cB + kstep, voffB); PG8_STAGE(PG8_SA(1, 0), cA + kstep, voffA); PG8_STAGE(PG8_SB(1, 1), cB + hstep + kstep, voffB);
        PG8_WAIT_V(6); PG8_BAR;
    } else {
        PG8_STAGE(PG8_SB(0, 0), cB, voffB); PG8_STAGE(PG8_SA(0, 0), cA, voffA); PG8_STAGE(PG8_SB(0, 1), cB + hstep, voffB); PG8_STAGE(PG8_SA(0, 1), cA + hstep, voffA);
        if (wr == 1) PG8_BAR;
        PG8_WAIT_V(4); PG8_BAR;
        PG8_STAGE(PG8_SB(1, 0), cB + kstep, voffB); PG8_STAGE(PG8_SA(1, 0), cA + kstep, voffA); PG8_STAGE(PG8_SB(1, 1), cB + hstep + kstep, voffB);
        PG8_WAIT_V(6); PG8_BAR;
    }
    for (;;) {
        const bool has_next = S.next(ui + 1, nxt);
        const char* nA = has_next ? (const char*)g.A + (size_t)nxt.pm * tstep : cA; const char* nB = has_next ? (const char*)g.Bt + (size_t)nxt.pn * tstep : cB;
        for (int t = 0; t < nt; t += 2) {
            const bool last = (t == nt - 2);
            const char* a1 = cA + (size_t)(t + 1) * kstep;
            const char* a2 = last ? nA : cA + (size_t)(t + 2) * kstep; const char* b2 = last ? nB : cB + (size_t)(t + 2) * kstep;
            const char* a3 = a2 + kstep; const char* b3 = b2 + kstep;
            if (last && has_next) S.a_ready(nxt);
            if constexpr (SP2) {
            PG8_LDB(B0, 0, 0); PG8_LDB(B1, 0, 1); PG8_SCHED; PG8_LDA(At, 0, 0); PG8_STAGE(PG8_SA(1, 1), a1 + hstep, voffA);
            PG8_WAIT_V(8); PG8_WAIT_L(0); PG8_BAR; PG8_MMA(0, 0, At, B0); PG8_MMA(0, 1, At, B1); PG8_BAR; PG8_SCHED;
            PG8_LDA(At, 0, 1); PG8_STAGE(PG8_SB(0, 0), b2, voffB); PG8_STAGE(PG8_SB(0, 1), b2 + hstep, voffB); PG8_STAGE(PG8_SA(0, 0), a2, voffA);
            PG8_WAIT_V(8); PG8_WAIT_L(0); PG8_BAR; PG8_MMA(1, 0, At, B0); PG8_MMA(1, 1, At, B1); PG8_BAR; PG8_SCHED;
            PG8_LDB(B0, 1, 0); PG8_LDB(B1, 1, 1); PG8_SCHED; PG8_LDA(At, 1, 0); PG8_STAGE(PG8_SA(0, 1), a2 + hstep, voffA);
            PG8_WAIT_V(8); PG8_WAIT_L(0); PG8_BAR; PG8_MMA(0, 0, At, B0); PG8_MMA(0, 1, At, B1); PG8_BAR; PG8_SCHED;
            PG8_LDA(At, 1, 1); PG8_STAGE(PG8_SB(1, 0), b3, voffB); PG8_STAGE(PG8_SB(1, 1), b3 + hstep, voffB); PG8_STAGE(PG8_SA(1, 0), a3, voffA);
            PG8_WAIT_V(8); PG8_WAIT_L(0); PG8_BAR; PG8_MMA(1, 0, At, B0); PG8_MMA(1, 1, At, B1); PG8_BAR; PG8_SCHED;
            } else {
            PG8_LDB(B0, 0, 0); PG8_SCHED; PG8_LDA(At, 0, 0); PG8_STAGE(PG8_SA(1, 1), a1 + hstep, voffA);
            PG8_WAIT_L(8); PG8_BAR; PG8_WAIT_L(0); PG8_MMA(0, 0, At, B0); PG8_BAR; PG8_SCHED;
            PG8_LDB(B1, 0, 1); PG8_STAGE(PG8_SB(0, 0), b2, voffB);
            PG8_BAR; PG8_WAIT_L(0); PG8_MMA(0, 1, At, B1); PG8_BAR;
            PG8_LDA(At, 0, 1); PG8_STAGE(PG8_SA(0, 0), a2, voffA);
            PG8_BAR; PG8_WAIT_L(0); PG8_MMA(1, 0, At, B0); PG8_BAR; PG8_SCHED;
            PG8_STAGE(PG8_SB(0, 1), b2 + hstep, voffB);
            PG8_WAIT_V(6); PG8_BAR; PG8_MMA(1, 1, At, B1); PG8_BAR;
            PG8_LDB(B0, 1, 0); PG8_SCHED; PG8_LDA(At, 1, 0); PG8_STAGE(PG8_SA(0, 1), a2 + hstep, voffA);
            PG8_WAIT_L(8); PG8_BAR; PG8_WAIT_L(0); PG8_MMA(0, 0, At, B0); PG8_BAR; PG8_SCHED;
            PG8_LDB(B1, 1, 1); PG8_STAGE(PG8_SB(1, 0), b3, voffB);
            PG8_BAR; PG8_WAIT_L(0); PG8_MMA(0, 1, At, B1); PG8_BAR;
            PG8_LDA(At, 1, 1); PG8_STAGE(PG8_SA(1, 0), a3, voffA);
            PG8_BAR; PG8_WAIT_L(0); PG8_MMA(1, 0, At, B0); PG8_BAR; PG8_SCHED;
            PG8_STAGE(PG8_SB(1, 1), b3 + hstep, voffB);
            PG8_WAIT_V(6); PG8_BAR; PG8_MMA(1, 1, At, B1); PG8_BAR;
            }
        }
        if constexpr (ALIGN_EPI) { if (wr == 0) PG8_BAR; }
        if constexpr (!Epi::AFTER_DRAIN) { E(acc, cur, wr, wc, fr, fq); S.done(cur); }
        if (!has_next) break;
#pragma unroll
        for (int a = 0; a < 2; ++a)
#pragma unroll
            for (int b = 0; b < 2; ++b)
#pragma unroll
                for (int m = 0; m < 4; ++m)
#pragma unroll
                    for (int n = 0; n < 2; ++n) acc[a][b][m][n] = (f32x4){0.f, 0.f, 0.f, 0.f};
        cur = nxt; cA = nA; cB = nB; ++ui;
        if constexpr (ALIGN_EPI) { if (wr == 1) PG8_BAR; }
    }
    PG8_WAIT_V(0);
    if constexpr (!ALIGN_EPI) { if (wr == 0) PG8_BAR; }
    PG8_BAR;
    if constexpr (Epi::AFTER_DRAIN) { E.fused(acc, cur, wr, wc, fr, fq, lds, wid, lane); S.done(cur); }
#undef PG8_SA
#undef PG8_SB
#undef PG8_STAGE
#undef PG8_LDA
#undef PG8_LDB
#undef PG8_MMA
#undef PG8_WAIT_V
#undef PG8_WAIT_L
#undef PG8_BAR
#undef PG8_SCHED
}
}

#ifndef MK_USE_CG
#define MK_USE_CG 1
#endif
namespace mk {
using pg8::bf16_t; using pg8::bf16x8; using pg8::f32x4; using pg8::u32x4; using pg8::Unit; using pg8::cvt_pk_bf16;
typedef unsigned u32x2 __attribute__((ext_vector_type(2)));
typedef float f32x16 __attribute__((ext_vector_type(16)));
#define LAS __attribute__((address_space(3)))

constexpr int T_ = 2048, NB_ = 8, M_ = NB_ * T_, MS_ = 32, D_ = 1024, NIN_ = 6144, FF_ = 4096;
constexpr int QKVW = 2304, ZBW = 1792, GTW = 2048;
constexpr float NORM_EPS = 1e-6f, GN_EPS = 64e-5f;
constexpr size_t O_Y = 0, O_YS = O_Y + (size_t)M_ * D_, O_KV128P = O_YS + (size_t)MS_ * D_, O_KV512P = O_KV128P + (size_t)NB_ * 128 * 512,
                 O_KV2048P = O_KV512P + (size_t)NB_ * 512 * 512, O_WKVP = O_KV2048P + (size_t)NB_ * 2048 * 512, O_SHIFTP = O_WKVP + (size_t)NB_ * 8 * 4096,
                 O_KV128S = O_SHIFTP + (size_t)NB_ * ZBW, O_KV512S = O_KV128S + (size_t)MS_ * 512, O_KV2048S = O_KV512S + (size_t)MS_ * 512,
                 O_WKVS = O_KV2048S + (size_t)MS_ * 512, O_SHIFTS = O_WKVS + (size_t)MS_ * 8 * 4096, O_END = O_SHIFTS + (size_t)MS_ * ZBW;
constexpr size_t MiB = 1u << 20, KiB = 1u << 10;
constexpr size_t WS_CTL = 0, CTL_ZERO_BYTES = 1 * MiB;
constexpr size_t CTL_SS1 = 64 * KiB, CTL_SS1S = 128 * KiB, CTL_SS2 = 192 * KiB, CTL_SS2S = 256 * KiB, CTL_BAR = 512 * KiB;
constexpr size_t WS_WIN = 2 * MiB, WS_WA = 14 * MiB, WS_WB = 14 * MiB + 512 * KiB, WS_WO = 16 * MiB, WS_WUP = 18 * MiB, WS_WDN = 26 * MiB;
constexpr size_t WS_WL = 34 * MiB, WS_AL = WS_WL + 64 * KiB, WS_GL = WS_WL + 128 * KiB;
constexpr size_t WS_SMALL = 35 * MiB;
constexpr size_t SM_H1S = 0, SM_ZS = 64 * KiB, SM_ATTS = 832 * KiB, SM_RWS = 848 * KiB, SM_MGS = 880 * KiB, SM_X1GS = 944 * KiB, SM_US = 1024 * KiB;
constexpr size_t WS_H1 = 38 * MiB, WS_QKV = 70 * MiB, WS_ZB = 142 * MiB, WS_U = 70 * MiB, WS_GATE = 198 * MiB, WS_OG = 262 * MiB, WS_LSE = 286 * MiB,
                 WS_ATT = 287 * MiB, WS_RW = 295 * MiB, WS_MG = 311 * MiB, WS_Y = 343 * MiB, WS_G = 375 * MiB, WS_BON = 407 * MiB, WS_TMP = 343 * MiB, WS_END = 439 * MiB;
constexpr int RING_BYTES = 131072, MISC_OFF = RING_BYTES + 320, LDS_BYTES = 147456;

__device__ __forceinline__ float bf2f(unsigned short h) { return __builtin_bit_cast(float, (unsigned)h << 16); }
__device__ __forceinline__ unsigned f2bf(float f) { unsigned u = __builtin_bit_cast(unsigned, f); return (u + 0x7fffu + ((u >> 16) & 1u)) >> 16; }
__device__ __forceinline__ unsigned pk2(float lo, float hi) { return f2bf(lo) | (f2bf(hi) << 16); }
__device__ __forceinline__ float sigm(float x) { return 1.f / (1.f + __expf(-x)); }
__device__ __forceinline__ void store8bf(bf16_t* p, f32x4 v0, f32x4 v1) { u32x4 w; w.x = cvt_pk_bf16(v0[0], v0[1]); w.y = cvt_pk_bf16(v0[2], v0[3]); w.z = cvt_pk_bf16(v1[0], v1[1]); w.w = cvt_pk_bf16(v1[2], v1[3]); *(u32x4*)p = w; }
__device__ __forceinline__ void store4bf(bf16_t* p, f32x4 v) { u32x2 w; w.x = cvt_pk_bf16(v[0], v[1]); w.y = cvt_pk_bf16(v[2], v[3]); *(u32x2*)p = w; }
__device__ __forceinline__ f32x4 load4bf(const bf16_t* p) { const u32x2 w = *(const u32x2*)p; f32x4 r; r[0] = __builtin_bit_cast(float, w.x << 16); r[1] = __builtin_bit_cast(float, w.x & 0xffff0000u); r[2] = __builtin_bit_cast(float, w.y << 16); r[3] = __builtin_bit_cast(float, w.y & 0xffff0000u); return r; }
template <int CTRL> __device__ __forceinline__ float dppf(float v) { return __builtin_bit_cast(float, __builtin_amdgcn_update_dpp(0, __builtin_bit_cast(int, v), CTRL, 0xF, 0xF, true)); }
__device__ __forceinline__ float red16(float v) { v += dppf<0xB1>(v); v += dppf<0x4E>(v); v += dppf<0x141>(v); v += dppf<0x140>(v); return v; }
__device__ __forceinline__ float red8(float v) { v += dppf<0xB1>(v); v += dppf<0x4E>(v); v += dppf<0x141>(v); return v; }
__device__ __forceinline__ float wave_sum(float v) {
#pragma unroll
    for (int o = 1; o < 64; o <<= 1) v += __shfl_xor(v, o);
    return v;
}
__device__ __forceinline__ float wave_max(float v) {
#pragma unroll
    for (int o = 1; o < 64; o <<= 1) v = fmaxf(v, __shfl_xor(v, o));
    return v;
}

#define XB_TMO      128
#define XB_XCNT(j)  (256  + 64 * (j))
#define XB_XSUB(j)  (1280 + 64 * (j))
#define XB_XGEN(j)  (2304 + 64 * (j))
#define XB_TOP      3328
#define XB_TOPGEN   3392
#define XCD_BAR_WORDS 3456
#define XB_SPIN_CAP (1u << 18)

__device__ __forceinline__ unsigned xb_ld(unsigned* p)              { return __hip_atomic_load(p, __ATOMIC_RELAXED, __HIP_MEMORY_SCOPE_AGENT); }
__device__ __forceinline__ unsigned xb_add(unsigned* p, unsigned v) { return __hip_atomic_fetch_add(p, v, __ATOMIC_RELAXED, __HIP_MEMORY_SCOPE_AGENT); }
__device__ __forceinline__ unsigned xb_xcc_id() { return (unsigned)__builtin_amdgcn_s_getreg((3 << 11) | 20) & 0xFu; }
#define XB_SPIN(cond, bar) do { unsigned _sp = 0; while (cond) { __builtin_amdgcn_s_sleep(1); \
    if ((++_sp & 255u) == 0u) { if (xb_ld(&(bar)[XB_TMO])) break; if (_sp > XB_SPIN_CAP) { atomicAdd(&(bar)[XB_TMO], 1u); break; } } } } while (0)

struct XcdBarrier {
    unsigned* bar; unsigned x;
    volatile LAS unsigned* st;
};

__device__ __forceinline__ XcdBarrier xcd_barrier_post(unsigned* bar, volatile LAS unsigned* st) {
    XcdBarrier b; b.bar = bar; b.x = xb_xcc_id(); b.st = st;
    if (threadIdx.x == 0) (void)xb_add(&bar[XB_XCNT(b.x)], 1u);
    return b;
}
__device__ __forceinline__ void xcd_barrier_complete(unsigned* bar, unsigned x, unsigned& nloc, unsigned& nx) {
    const unsigned G = gridDim.x * gridDim.y * gridDim.z;
    unsigned sum, cnt, mine, sp = 0u;
    for (;;) {
        sum = 0u; cnt = 0u; mine = 0u;
#pragma unroll
        for (unsigned j = 0; j < 16; ++j) { const unsigned c = xb_ld(&bar[XB_XCNT(j)]); sum += c; cnt += (c > 0u) ? 1u : 0u; mine = (j == x) ? c : mine; }
        if (sum == G) break;
        __builtin_amdgcn_s_sleep(1);
        if ((++sp & 255u) == 0u) { if (xb_ld(&bar[XB_TMO])) break; if (sp > XB_SPIN_CAP) { atomicAdd(&bar[XB_TMO], 1u); break; } }
    }
    nloc = mine > 0u ? mine : 1u; nx = cnt > 0u ? cnt : 1u;
}

__device__ __forceinline__ void xcd_barrier(const XcdBarrier& b) {
    asm volatile("s_waitcnt vmcnt(0)" ::: "memory");
    __syncthreads();
    if (threadIdx.x == 0) {
        unsigned* bar = b.bar;
        __builtin_amdgcn_s_waitcnt(0);
        unsigned nloc = b.st[0], nx = b.st[1];
        if (nloc == 0u) { xcd_barrier_complete(bar, b.x, nloc, nx); b.st[0] = nloc; b.st[1] = nx; }
        const unsigned old = xb_add(&bar[XB_XSUB(b.x)], 1u);
        const unsigned gen = old / nloc;
        if (old + 1u == (gen + 1u) * nloc) {
            __builtin_amdgcn_fence(__ATOMIC_RELEASE, "agent");
            asm volatile("s_waitcnt vmcnt(0)" ::: "memory");
            const unsigned og = xb_add(&bar[XB_TOP], 1u);
            const unsigned tg = og / nx;
            if (og + 1u == (tg + 1u) * nx) xb_add(&bar[XB_TOPGEN], 1u);
            else XB_SPIN(xb_ld(&bar[XB_TOPGEN]) == tg, bar);
            __builtin_amdgcn_fence(__ATOMIC_ACQUIRE, "agent");
            xb_add(&bar[XB_XGEN(b.x)], 1u);
            asm volatile("s_waitcnt vmcnt(0)" ::: "memory");
        } else {
            XB_SPIN(xb_ld(&bar[XB_XGEN(b.x)]) == gen, bar);
            __builtin_amdgcn_fence(__ATOMIC_ACQUIRE, "agent");
            asm volatile("s_waitcnt vmcnt(0)" ::: "memory");
        }
    }
    __syncthreads();
}

struct EpiZ {
    static constexpr bool PERM = true, AFTER_DRAIN = false;
    bf16_t* QKV; bf16_t* ZB; bf16_t* GATE; const float* b_gate; float* out;
    __device__ __forceinline__ void operator()(const f32x4 (&acc)[2][2][4][2], const Unit& u, int wr, int wc, int fr, int fq) const {
        const int pn = u.pn;
#pragma unroll
        for (int ai = 0; ai < 2; ++ai)
#pragma unroll
            for (int m = 0; m < 4; ++m) {
                const int row = u.pm * 256 + ai * 128 + wr * 64 + m * 16 + fr; const int b = row >> 11, t = row & 2047;
#pragma unroll
                for (int bj = 0; bj < 2; ++bj) {
                    const int col = pn * 256 + bj * 128 + wc * 32 + 8 * fq;
                    const f32x4 v0 = acc[ai][bj][m][0], v1 = acc[ai][bj][m][1];
                    if (pn < 9) {
                        store8bf(QKV + (size_t)row * QKVW + col, v0, v1);
                        if (col >= 768) {
                            const int kvsel = col >= 1536 ? 1 : 0; const int cc = col - 768 - kvsel * 768; const int head = cc >> 6, g = head >> 2, hs = head & 3, d = cc & 63;
                            const int rows_g = 128 << (2 * g); const int j = t - (T_ - rows_g);
                            if (j >= 0) { float* dst = out + (g == 0 ? O_KV128P : (g == 1 ? O_KV512P : O_KV2048P)) + ((size_t)(b * rows_g + j) * 2 + kvsel) * 256 + hs * 64 + d; *(f32x4*)dst = v0; *(f32x4*)(dst + 4) = v1; }
                        }
                    } else if (pn < 16) {
                        const int c = col - QKVW; store8bf(ZB + (size_t)row * ZBW + c, v0, v1);
                        if (t == T_ - 1) { float* dst = out + O_SHIFTP + (size_t)b * ZBW + c; *(f32x4*)dst = v0; *(f32x4*)(dst + 4) = v1; }
                    } else {
                        const int c = col - 4096; const f32x4 b0 = *(const f32x4*)(b_gate + c), b1 = *(const f32x4*)(b_gate + c + 4); f32x4 g0, g1;
#pragma unroll
                        for (int e = 0; e < 4; ++e) { g0[e] = sigm(v0[e] + b0[e]); g1[e] = sigm(v1[e] + b1[e]); }
                        store8bf(GATE + (size_t)row * GTW + c, g0, g1);
                    }
                }
            }
    }
};
struct EpiPA {
    static constexpr bool PERM = false, AFTER_DRAIN = false;
    const bf16_t* GATE; float* TMP;
    __device__ __forceinline__ void operator()(const f32x4 (&acc)[2][2][4][2], const Unit& u, int wr, int wc, int fr, int fq) const {
#pragma unroll
        for (int ai = 0; ai < 2; ++ai)
#pragma unroll
            for (int m = 0; m < 4; ++m) { const int row = u.pm * 256 + ai * 128 + wr * 64 + m * 16 + fr;
#pragma unroll
                for (int bj = 0; bj < 2; ++bj)
#pragma unroll
                    for (int n = 0; n < 2; ++n) { const int col = u.pn * 256 + bj * 128 + wc * 32 + 16 * n + 4 * fq;
                        const f32x4 ga = load4bf(GATE + (size_t)row * GTW + col); *(f32x4*)(TMP + (size_t)row * D_ + col) = ga * acc[ai][bj][m][n]; }
                asm volatile("" ::: "memory"); }
    }
};
struct EpiPB {
    static constexpr bool PERM = false, AFTER_DRAIN = false;
    const bf16_t* GATE; const float* TMP; bf16_t* MG;
    __device__ __forceinline__ void operator()(const f32x4 (&acc)[2][2][4][2], const Unit& u, int wr, int wc, int fr, int fq) const {
#pragma unroll
        for (int ai = 0; ai < 2; ++ai)
#pragma unroll
            for (int m = 0; m < 4; ++m) { const int row = u.pm * 256 + ai * 128 + wr * 64 + m * 16 + fr;
#pragma unroll
                for (int bj = 0; bj < 2; ++bj)
#pragma unroll
                    for (int n = 0; n < 2; ++n) { const int col = u.pn * 256 + bj * 128 + wc * 32 + 16 * n + 4 * fq;
                        const f32x4 gb = load4bf(GATE + (size_t)row * GTW + D_ + col); const f32x4 t = *(const f32x4*)(TMP + (size_t)row * D_ + col);
                        store4bf(MG + (size_t)row * D_ + col, t + gb * acc[ai][bj][m][n]); }
                asm volatile("" ::: "memory"); }
    }
};
template <bool WRITE_XG> struct EpiRes {
    static constexpr bool PERM = false, AFTER_DRAIN = false;
    const float* xin; float* xo; bf16_t* XG; const float* g; float* SS;
    __device__ __forceinline__ void operator()(const f32x4 (&acc)[2][2][4][2], const Unit& u, int wr, int wc, int fr, int fq) const {
#pragma unroll
        for (int ai = 0; ai < 2; ++ai)
#pragma unroll
            for (int m = 0; m < 4; ++m) { const int row = u.pm * 256 + ai * 128 + wr * 64 + m * 16 + fr; float ss = 0.f;
#pragma unroll
                for (int bj = 0; bj < 2; ++bj)
#pragma unroll
                    for (int n = 0; n < 2; ++n) { const int col = u.pn * 256 + bj * 128 + wc * 32 + 16 * n + 4 * fq;
                        const f32x4 x1 = *(const f32x4*)(xin + (size_t)row * D_ + col) + acc[ai][bj][m][n];
                        *(f32x4*)(xo + (size_t)row * D_ + col) = x1; ss += (x1[0] * x1[0] + x1[1] * x1[1]) + (x1[2] * x1[2] + x1[3] * x1[3]);
                        if (WRITE_XG) { const f32x4 gg = *(const f32x4*)(g + col); store4bf(XG + (size_t)row * D_ + col, x1 * gg); } }
                ss += __shfl_xor(ss, 16); ss += __shfl_xor(ss, 32);
                if (fq == 0) atomicAdd(SS + row, ss);
                asm volatile("" ::: "memory"); }
    }
};
struct EpiUp {
    static constexpr bool PERM = true, AFTER_DRAIN = false;
    const float* SS; bf16_t* U;
    __device__ __forceinline__ void operator()(const f32x4 (&acc)[2][2][4][2], const Unit& u, int wr, int wc, int fr, int fq) const {
#pragma unroll
        for (int ai = 0; ai < 2; ++ai)
#pragma unroll
            for (int m = 0; m < 4; ++m) { const int row = u.pm * 256 + ai * 128 + wr * 64 + m * 16 + fr; const float rs = rsqrtf(SS[row] * (1.f / D_) + NORM_EPS);
#pragma unroll
                for (int bj = 0; bj < 2; ++bj) { const int col = u.pn * 256 + bj * 128 + wc * 32 + 8 * fq; f32x4 v0 = acc[ai][bj][m][0] * rs, v1 = acc[ai][bj][m][1] * rs;
#pragma unroll
                    for (int e = 0; e < 4; ++e) { const float a = fmaxf(v0[e], 0.f), b = fmaxf(v1[e], 0.f); v0[e] = a * a; v1[e] = b * b; }
                    store8bf(U + (size_t)row * FF_ + col, v0, v1); } }
    }
};

struct SP { float* ZS; const float* b_gate; float* out; const float* xs; const float* g2; bf16_t* MGS; bf16_t* X1GS; bf16_t* US; float* SS1S; float* SS2S; };
template <int MODE> __device__ __forceinline__ void sample_gemm(LAS unsigned char* lds, const bf16_t* A1, int K1, const bf16_t* B1, const bf16_t* A2, int K2, const bf16_t* B2, int N, const SP p) {
    const int tid = threadIdx.x, wid = tid >> 6, lane = tid & 63, r = lane & 31, hh = lane >> 5;
    LAS float* P = (LAS float*)lds;
    for (int tile = blockIdx.x; tile < N / 32; tile += gridDim.x) {
        const int n0 = tile * 32;
        f32x16 acc1, acc2;
#pragma unroll
        for (int i = 0; i < 16; ++i) { acc1[i] = 0.f; acc2[i] = 0.f; }
        { const int kw = K1 / 8; const bf16_t* ap = A1 + (size_t)r * K1 + wid * kw + 8 * hh; const bf16_t* bp = B1 + (size_t)(n0 + r) * K1 + wid * kw + 8 * hh;
#pragma unroll 4
          for (int k = 0; k < kw; k += 16) { const bf16x8 a = *(const bf16x8*)(ap + k), b = *(const bf16x8*)(bp + k); acc1 = __builtin_amdgcn_mfma_f32_32x32x16_bf16(a, b, acc1, 0, 0, 0); } }
        if (K2 > 0) { const int kw = K2 / 8; const bf16_t* ap = A2 + (size_t)r * K2 + wid * kw + 8 * hh; const bf16_t* bp = B2 + (size_t)(n0 + r) * K2 + wid * kw + 8 * hh;
#pragma unroll 4
          for (int k = 0; k < kw; k += 16) { const bf16x8 a = *(const bf16x8*)(ap + k), b = *(const bf16x8*)(bp + k); acc2 = __builtin_amdgcn_mfma_f32_32x32x16_bf16(a, b, acc2, 0, 0, 0); } }
#pragma unroll
        for (int reg = 0; reg < 16; ++reg) { const int row = (reg & 3) + 8 * (reg >> 2) + 4 * hh; P[wid * 1024 + row * 32 + r] = acc1[reg]; if (K2 > 0) P[8192 + wid * 1024 + row * 32 + r] = acc2[reg]; }
        __syncthreads();
        const int row = tid >> 4, c2 = (tid & 15) * 2, col = n0 + c2;
        float s1a = 0.f, s1b = 0.f, s2a = 0.f, s2b = 0.f;
#pragma unroll
        for (int w = 0; w < 8; ++w) { s1a += P[w * 1024 + row * 32 + c2]; s1b += P[w * 1024 + row * 32 + c2 + 1]; if (K2 > 0) { s2a += P[8192 + w * 1024 + row * 32 + c2]; s2b += P[8192 + w * 1024 + row * 32 + c2 + 1]; } }
        if (MODE == 0) {
            p.ZS[(size_t)row * NIN_ + col] = s1a; p.ZS[(size_t)row * NIN_ + col + 1] = s1b;
            if (col >= 768 && col < QKVW) { const int kvsel = col >= 1536 ? 1 : 0; const int cc = col - 768 - kvsel * 768; const int head = cc >> 6, g = head >> 2, hs = head & 3, d = cc & 63;
                float* dst = p.out + (g == 0 ? O_KV128S : (g == 1 ? O_KV512S : O_KV2048S)) + ((size_t)row * 2 + kvsel) * 256 + hs * 64 + d; dst[0] = s1a; dst[1] = s1b; }
            else if (col >= QKVW && col < 4096) { float* dst = p.out + O_SHIFTS + (size_t)row * ZBW + (col - QKVW); dst[0] = s1a; dst[1] = s1b; }
        } else if (MODE == 1) {
            const float* zg = p.ZS + (size_t)row * NIN_ + 4096;
            const float ga0 = sigm(zg[col] + p.b_gate[col]), ga1 = sigm(zg[col + 1] + p.b_gate[col + 1]), gb0 = sigm(zg[D_ + col] + p.b_gate[D_ + col]), gb1 = sigm(zg[D_ + col + 1] + p.b_gate[D_ + col + 1]);
            *(unsigned*)(p.MGS + (size_t)row * D_ + col) = pk2(ga0 * s1a + gb0 * s2a, ga1 * s1b + gb1 * s2b);
        } else if (MODE == 2 || MODE == 4) {
            const float* xin = (MODE == 2) ? p.xs : (p.out + O_YS); float* xo = p.out + O_YS;
            const float x0 = xin[(size_t)row * D_ + col] + s1a, x1 = xin[(size_t)row * D_ + col + 1] + s1b;
            xo[(size_t)row * D_ + col] = x0; xo[(size_t)row * D_ + col + 1] = x1;
            if (MODE == 2) *(unsigned*)(p.X1GS + (size_t)row * D_ + col) = pk2(x0 * p.g2[col], x1 * p.g2[col + 1]);
            float ss = x0 * x0 + x1 * x1; ss = red16(ss);
            if ((tid & 15) == 0) atomicAdd((MODE == 2 ? p.SS1S : p.SS2S) + row, ss);
        } else if (MODE == 3) {
            const float rs = rsqrtf(p.SS1S[row] * (1.f / D_) + NORM_EPS); const float a = fmaxf(rs * s1a, 0.f), b = fmaxf(rs * s1b, 0.f);
            *(unsigned*)(p.US + (size_t)row * FF_ + col) = pk2(a * a, b * b);
        }
        __syncthreads();
    }
}

__device__ __forceinline__ void p0_transpose_item(const float* W, int K, int N, bf16_t* WT, LAS float* scr, int item, int lane) {
    const int nblk = N / 32, kb = item / nblk, nb = item % nblk, k0 = 64 * kb, n0 = 32 * nb;
#pragma unroll 8
    for (int i = 0; i < 32; ++i) { const int kk = 2 * i + (lane >> 5); scr[kk * 33 + (lane & 31)] = W[(size_t)(k0 + kk) * N + n0 + (lane & 31)]; }
    asm volatile("s_waitcnt lgkmcnt(0)" ::: "memory");
    const int c = lane & 7;
#pragma unroll
    for (int j = 0; j < 4; ++j) { const int n = (lane >> 3) + 8 * j; const LAS float* s = scr + (8 * c) * 33 + n;
        u32x4 o; o.x = pk2(s[0 * 33], s[1 * 33]); o.y = pk2(s[2 * 33], s[3 * 33]); o.z = pk2(s[4 * 33], s[5 * 33]); o.w = pk2(s[6 * 33], s[7 * 33]);
        *(u32x4*)(WT + (size_t)(n0 + n) * K + k0 + 8 * c) = o; }
    asm volatile("s_waitcnt lgkmcnt(0)" ::: "memory");
}
__device__ __forceinline__ void rms_row_to_bf16(const float* xrow, const float* g, bf16_t* orow, int lane) {
    f32x4 v[4]; float s = 0.f;
#pragma unroll
    for (int j = 0; j < 4; ++j) { v[j] = *((const f32x4*)xrow + lane + 64 * j); s += (v[j][0] * v[j][0] + v[j][1] * v[j][1]) + (v[j][2] * v[j][2] + v[j][3] * v[j][3]); }
    const float rs = rsqrtf(wave_sum(s) * (1.f / D_) + NORM_EPS);
#pragma unroll
    for (int j = 0; j < 4; ++j) { const f32x4 gg = *((const f32x4*)g + lane + 64 * j); store4bf(orow + 4 * (lane + 64 * j), v[j] * rs * gg); }
}

constexpr int AT_KS = 0, AT_VT = 36864, AT_PS = 72704;
__device__ __forceinline__ void attn_unit(LAS unsigned char* lds, int item, const bf16_t* QKV, bf16_t* OG, float* LSE) {
    const int tid = threadIdx.x, wid = tid >> 6, lane = tid & 63, fr = lane & 15, fq = lane >> 4;
    const int blk = item & 15, hs = (item >> 4) & 3, g = (item >> 6) % 3, b = item / 192;
    const int dsh = 2 * g, dil = 1 << dsh, nbk = 16 >> dsh, r = blk / nbk, n = blk % nbk, h = g * 4 + hs;
    const float slope = exp2f(-8.0f * (float)(h + 1) / 12.0f);
    const bf16_t* base = QKV + (size_t)b * T_ * QKVW;
    LAS unsigned char* Ks = lds + AT_KS; LAS unsigned char* Vt = lds + AT_VT; LAS unsigned char* Ps = lds + AT_PS + wid * (16 * 336);
#pragma unroll
    for (int i = 0; i < 4; ++i) { const int c = tid + 512 * i, row = c >> 3, part = c & 7; const int e = (n - 1) * 128 + row;
        u32x4 v = (u32x4){0u, 0u, 0u, 0u}; if (e >= 0) v = *(const u32x4*)(base + (size_t)((e << dsh) + r) * QKVW + 768 + h * 64 + part * 8);
        *(LAS u32x4*)(Ks + row * 144 + part * 16) = v; }
#pragma unroll
    for (int i = 0; i < 4; ++i) { const int key = tid & 255, part = (tid >> 8) + 2 * i; const int e = (n - 1) * 128 + key;
        u32x4 v = (u32x4){0u, 0u, 0u, 0u}; if (e >= 0) v = *(const u32x4*)(base + (size_t)((e << dsh) + r) * QKVW + 1536 + h * 64 + part * 8);
        LAS unsigned short* dst = (LAS unsigned short*)(Vt + (part * 8) * 560 + key * 2);
        dst[0 * 280] = (unsigned short)(v.x & 0xffff); dst[1 * 280] = (unsigned short)(v.x >> 16); dst[2 * 280] = (unsigned short)(v.y & 0xffff); dst[3 * 280] = (unsigned short)(v.y >> 16);
        dst[4 * 280] = (unsigned short)(v.z & 0xffff); dst[5 * 280] = (unsigned short)(v.z >> 16); dst[6 * 280] = (unsigned short)(v.w & 0xffff); dst[7 * 280] = (unsigned short)(v.w >> 16); }
    for (int idx = tid; idx < 64 * 12; idx += 512) { const int d = idx / 12, k2 = idx % 12; *(LAS unsigned*)(Vt + d * 560 + (256 + 2 * k2) * 2) = 0u; }
    const int qi = 16 * wid + fr; const int tq = ((n * 128 + qi) << dsh) + r;
    const bf16x8 qa0 = *(const bf16x8*)(base + (size_t)tq * QKVW + h * 64 + 8 * fq), qa1 = *(const bf16x8*)(base + (size_t)tq * QKVW + h * 64 + 32 + 8 * fq);
    __syncthreads();
    f32x4 s[10];
    float mx[4] = {-3.0e38f, -3.0e38f, -3.0e38f, -3.0e38f};
#pragma unroll
    for (int jt = 0; jt < 10; ++jt) {
        const int jtile = wid + jt; f32x4 a = (f32x4){0.f, 0.f, 0.f, 0.f};
        if (jtile < 16) {
            const bf16x8 k0 = *(const LAS bf16x8*)(Ks + (jtile * 16 + fr) * 144 + fq * 16), k1 = *(const LAS bf16x8*)(Ks + (jtile * 16 + fr) * 144 + 64 + fq * 16);
            a = __builtin_amdgcn_mfma_f32_16x16x32_bf16(qa0, k0, a, 0, 0, 0); a = __builtin_amdgcn_mfma_f32_16x16x32_bf16(qa1, k1, a, 0, 0, 0);
        }
        const int j = jtile * 16 + fr;
#pragma unroll
        for (int e = 0; e < 4; ++e) { const int i = 16 * wid + 4 * fq + e; const int delta = 128 + i - j;
            const bool valid = (jtile < 16) && (delta >= 0) && (delta <= 128) && (n > 0 || j >= 128);
            const float sc = valid ? (a[e] * 0.125f - slope * (float)(delta << dsh)) : -1.0e30f; a[e] = sc; mx[e] = fmaxf(mx[e], sc); }
        s[jt] = a;
    }
    float lsum[4];
#pragma unroll
    for (int e = 0; e < 4; ++e) { float m = mx[e]; m = fmaxf(m, __shfl_xor(m, 1)); m = fmaxf(m, __shfl_xor(m, 2)); m = fmaxf(m, __shfl_xor(m, 4)); m = fmaxf(m, __shfl_xor(m, 8)); mx[e] = m; lsum[e] = 0.f; }
#pragma unroll
    for (int jt = 0; jt < 10; ++jt)
#pragma unroll
        for (int e = 0; e < 4; ++e) { const float p = __expf(s[jt][e] - mx[e]); lsum[e] += p; *(LAS unsigned short*)(Ps + (4 * fq + e) * 336 + (jt * 16 + fr) * 2) = (unsigned short)f2bf(p); }
#pragma unroll
    for (int e = 0; e < 4; ++e) { float l = lsum[e]; l += __shfl_xor(l, 1); l += __shfl_xor(l, 2); l += __shfl_xor(l, 4); l += __shfl_xor(l, 8); lsum[e] = l; }
    asm volatile("s_waitcnt lgkmcnt(0)" ::: "memory");
    f32x4 o[4];
#pragma unroll
    for (int nt = 0; nt < 4; ++nt) o[nt] = (f32x4){0.f, 0.f, 0.f, 0.f};
#pragma unroll
    for (int ks = 0; ks < 5; ++ks) {
        const bf16x8 pa = *(const LAS bf16x8*)(Ps + fr * 336 + (32 * ks + 8 * fq) * 2);
#pragma unroll
        for (int nt = 0; nt < 4; ++nt) { const bf16x8 vb = *(const LAS bf16x8*)(Vt + (nt * 16 + fr) * 560 + (16 * wid + 32 * ks + 8 * fq) * 2); o[nt] = __builtin_amdgcn_mfma_f32_16x16x32_bf16(pa, vb, o[nt], 0, 0, 0); }
    }
#pragma unroll
    for (int e = 0; e < 4; ++e) { const int i = 16 * wid + 4 * fq + e; const int t = ((n * 128 + i) << dsh) + r; const size_t row = (size_t)b * T_ + t; const float inv = 1.f / lsum[e];
#pragma unroll
        for (int nt = 0; nt < 4; ++nt) OG[row * 768 + h * 64 + nt * 16 + fr] = (bf16_t)f2bf(o[nt][e] * inv);
        if (fr == 0) LSE[row * 12 + h] = mx[e] + __logf(lsum[e]); }
    __syncthreads();
}

__device__ __forceinline__ void sample_attn(LAS unsigned char* lds, int b, const float* ZS, const float* c128, const float* c512, const float* c2048, bf16_t* ATTS) {
    const int tid = threadIdx.x, wid = tid >> 6, lane = tid & 63;
    LAS float* qs = (LAS float*)lds;
    LAS float* sc = qs + 256;
    LAS float* og = sc + 4 * 132;
    LAS float* ls = og + 768;
    LAS float* lsm = ls + 12;
    const float* z = ZS + (size_t)b * NIN_;
    for (int g = 0; g < 3; ++g) {
        const int dsh = 2 * g, Lb = 128 << dsh; const float* cache = g == 0 ? c128 : (g == 1 ? c512 : c2048);
        const float* cb = cache + (size_t)b * Lb * 512;
        if (tid < 256) qs[tid] = z[g * 256 + tid];
        __syncthreads();
        { const int hs = tid >> 7, mi = tid & 127, m = mi + 1; const float slope = exp2f(-8.0f * (float)(g * 4 + hs + 1) / 12.0f);
          const float* kr = cb + (size_t)(Lb - (m << dsh)) * 512 + hs * 64; float d = 0.f;
#pragma unroll
          for (int i = 0; i < 16; ++i) { const f32x4 kv = *(const f32x4*)(kr + 4 * i); const f32x4 qv = *(const LAS f32x4*)(qs + hs * 64 + 4 * i); d += (kv[0] * qv[0] + kv[1] * qv[1]) + (kv[2] * qv[2] + kv[3] * qv[3]); }
          sc[hs * 132 + m] = d * 0.125f - slope * (float)(m << dsh);
          if (mi == 0) { const float* kn = z + 768 + (g * 4 + hs) * 64; float d0 = 0.f; for (int i = 0; i < 64; ++i) d0 += kn[i] * qs[hs * 64 + i]; sc[hs * 132] = d0 * 0.125f; } }
        __syncthreads();
        if (wid < 4) { const int hs = wid; float v0 = sc[hs * 132 + lane], v1 = sc[hs * 132 + 64 + lane], v2 = lane == 0 ? sc[hs * 132 + 128] : -3.0e38f;
            const float mxx = wave_max(fmaxf(fmaxf(v0, v1), v2)); const float p0 = __expf(v0 - mxx), p1 = __expf(v1 - mxx), p2 = lane == 0 ? __expf(v2 - mxx) : 0.f;
            const float l = wave_sum(p0 + p1 + p2); sc[hs * 132 + lane] = p0; sc[hs * 132 + 64 + lane] = p1; if (lane == 0) { sc[hs * 132 + 128] = p2; ls[g * 4 + hs] = mxx + __logf(l); lsm[hs] = l; } }
        __syncthreads();
        { const int hs = tid >> 7, d = (tid >> 1) & 63, half = tid & 1; float acc = 0.f;
          const int m0 = half ? 65 : 0, m1 = half ? 129 : 65;
          for (int m = m0; m < m1; ++m) { const float vv = (m == 0) ? z[1536 + (g * 4 + hs) * 64 + d] : cb[(size_t)(Lb - (m << dsh)) * 512 + 256 + hs * 64 + d]; acc += sc[hs * 132 + m] * vv; }
          acc += __shfl_xor(acc, 1);
          if (half == 0) og[(g * 4 + hs) * 64 + d] = acc / lsm[hs]; }
        __syncthreads();
    }
    if (tid < 256) { const int hs = tid >> 6, d = tid & 63; const float l0 = ls[hs], l1 = ls[4 + hs], l2 = ls[8 + hs]; const float mm = fmaxf(l0, fmaxf(l1, l2));
        const float w0 = __expf(l0 - mm), w1 = __expf(l1 - mm), w2 = __expf(l2 - mm); const float inv = 1.f / (w0 + w1 + w2);
        ATTS[(size_t)b * 256 + tid] = (bf16_t)f2bf((w0 * og[hs * 64 + d] + w1 * og[(4 + hs) * 64 + d] + w2 * og[(8 + hs) * 64 + d]) * inv); }
    __syncthreads();
}

struct RwW { const float *mu, *w0, *a0, *k_k, *k_a, *r_k, *gn_g, *gn_b, *wl, *al, *gl; };
__device__ __forceinline__ float decay_of(float w0c, float wl) { const float x = -(w0c + wl); const float sp = fmaxf(x, 0.f) + log1pf(__expf(-fabsf(x))); return __expf(-__expf(-sp - 0.5f)); }

__device__ __forceinline__ void sample_rwkv(LAS unsigned char* lds, int item, const float* ZS, const float* state_wkv, const float* state_shift, const RwW w, float* out, bf16_t* RWS) {
    const int tid = threadIdx.x, wid = tid >> 6, lane = tid & 63; const int b = item >> 3, h = item & 7;
    LAS float* xr = (LAS float*)lds; LAS float* xk = xr + 64; LAS float* xv = xk + 64; LAS float* lw = xv + 64; LAS float* la = lw + 64; LAS float* lg = la + 64;
    LAS float* pw = lg + 128; LAS float* pa = pw + 64; LAS float* pg = pa + 64;
    LAS float* sR = pg + 64; LAS float* sW = sR + 64; LAS float* sK = sW + 64; LAS float* sV = sK + 64; LAS float* sA = sV + 64; LAS float* sB = sA + 64; LAS float* sG = sB + 64; LAS float* sY = sG + 64; LAS float* sC = sY + 64;
    const float* zb = ZS + (size_t)b * NIN_ + QKVW; const float* pv = state_shift + (size_t)b * ZBW;
    if (tid < 448) { int col; if (tid < 192) col = (tid >> 6) * 512 + h * 64 + (tid & 63); else col = 1536 + (tid - 192);
        const float cur = zb[col], prv = pv[col]; const float mx = cur + (prv - cur) * w.mu[col];
        if (tid < 64) xr[tid] = mx; else if (tid < 128) xk[tid - 64] = mx; else if (tid < 192) xv[tid - 128] = mx; else if (tid < 256) lw[tid - 192] = tanhf(mx); else if (tid < 320) la[tid - 256] = mx; else lg[tid - 320] = sigm(mx); }
    __syncthreads();
    if (tid < 192) { const int which = tid >> 6, nn = tid & 63, c = h * 64 + nn; float acc = 0.f;
        if (which == 0) { for (int j = 0; j < 64; ++j) acc += lw[j] * w.wl[j * 512 + c]; pw[nn] = acc; }
        else if (which == 1) { for (int j = 0; j < 64; ++j) acc += la[j] * w.al[j * 512 + c]; pa[nn] = acc; }
        else { for (int j = 0; j < 128; ++j) acc += lg[j] * w.gl[j * 512 + c]; pg[nn] = acc; } }
    __syncthreads();
    if (wid == 0) { const int c = h * 64 + lane; const float r = xr[lane], k = xk[lane], v = xv[lane];
        const float dec = decay_of(w.w0[c], pw[lane]); const float a = sigm(w.a0[c] + pa[lane]);
        const float kkr = k * w.k_k[c]; const float nrm = fmaxf(sqrtf(wave_sum(kkr * kkr)), 1e-12f); const float kk = kkr / nrm;
        const float kp = k * (1.f + (a - 1.f) * w.k_a[c]); const float cs = wave_sum(r * kp * w.r_k[c]);
        sR[lane] = r; sW[lane] = dec; sK[lane] = kp; sV[lane] = v; sA[lane] = -kk; sB[lane] = kk * a; sG[lane] = pg[lane]; if (lane == 0) sC[0] = cs; }
    __syncthreads();
    { const int row = tid >> 3, kq = tid & 7; const float* S0 = state_wkv + ((size_t)(b * 8 + h) * 64 + row) * 64 + 8 * kq; float s[8];
      const f32x4 s0 = *(const f32x4*)S0, s1 = *(const f32x4*)(S0 + 4); s[0] = s0[0]; s[1] = s0[1]; s[2] = s0[2]; s[3] = s0[3]; s[4] = s1[0]; s[5] = s1[1]; s[6] = s1[2]; s[7] = s1[3];
      float dot = 0.f;
#pragma unroll
      for (int i = 0; i < 8; ++i) dot += s[i] * sA[8 * kq + i];
      const float sa = red8(dot); const float vv = sV[row]; float yp = 0.f;
#pragma unroll
      for (int i = 0; i < 8; ++i) { s[i] = s[i] * sW[8 * kq + i] + sa * sB[8 * kq + i] + vv * sK[8 * kq + i]; yp += s[i] * sR[8 * kq + i]; }
      const float y = red8(yp); float* So = out + O_WKVS + ((size_t)(b * 8 + h) * 64 + row) * 64 + 8 * kq;
      *(f32x4*)So = (f32x4){s[0], s[1], s[2], s[3]}; *(f32x4*)(So + 4) = (f32x4){s[4], s[5], s[6], s[7]};
      if (kq == 0) sY[row] = y; }
    __syncthreads();
    if (wid == 0) { const int c = h * 64 + lane; const float y = sY[lane]; const float mu = wave_sum(y) * (1.f / 64.f); const float dv = y - mu; const float var = wave_sum(dv * dv) * (1.f / 64.f);
        const float yn = dv * rsqrtf(var + GN_EPS) * w.gn_g[c] + w.gn_b[c]; RWS[(size_t)b * 512 + c] = (bf16_t)f2bf((yn + sC[0] * sV[lane]) * sG[lane]); }
    __syncthreads();
}

constexpr int SC_C = 32;
constexpr int SC_XR = 0, SC_XK = 8192, SC_XV = 16384, SC_PW = 24576, SC_PA = 32768, SC_PG = 40960, SC_LW = 49152, SC_LA = SC_LW + 32 * 144, SC_LG = SC_LA + 32 * 144, SC_END = SC_LG + 32 * 272;
__device__ __forceinline__ void scan_unit(LAS unsigned char* lds, int su, const bf16_t* ZB, const RwW w, const bf16_t* WlT, const bf16_t* AlT, const bf16_t* GlT, float* Y, float* G, float* BON, float* out) {
    const int tid = threadIdx.x, wid = tid >> 6, lane = tid & 63, fr = lane & 15, fq = lane >> 4;
    const int bh = su >> 1, rs = su & 1, b = bh >> 3, h = bh & 7;
    LAS float* XR = (LAS float*)(lds + SC_XR); LAS float* XK = (LAS float*)(lds + SC_XK); LAS float* XV = (LAS float*)(lds + SC_XV);
    LAS float* PW = (LAS float*)(lds + SC_PW); LAS float* PA = (LAS float*)(lds + SC_PA); LAS float* PG = (LAS float*)(lds + SC_PG);
    LAS unsigned char* LW = lds + SC_LW; LAS unsigned char* LA = lds + SC_LA; LAS unsigned char* LG = lds + SC_LG;
    const int ttile = wid >> 2, ntile = wid & 3; const int ncol = h * 64 + ntile * 16 + fr;
    bf16x8 Bw[2], Ba[2], Bg[4];
#pragma unroll
    for (int ks = 0; ks < 2; ++ks) { Bw[ks] = *(const bf16x8*)(WlT + (size_t)ncol * 64 + 32 * ks + 8 * fq); Ba[ks] = *(const bf16x8*)(AlT + (size_t)ncol * 64 + 32 * ks + 8 * fq); }
#pragma unroll
    for (int ks = 0; ks < 4; ++ks) Bg[ks] = *(const bf16x8*)(GlT + (size_t)ncol * 128 + 32 * ks + 8 * fq);
    const int tt = tid >> 4, q = tid & 15, c0 = h * 64 + 4 * q;
    const f32x4 mu_r = *(const f32x4*)(w.mu + c0), mu_k = *(const f32x4*)(w.mu + 512 + c0), mu_v = *(const f32x4*)(w.mu + 1024 + c0);
    const f32x4 mu_w = *(const f32x4*)(w.mu + 1536 + 4 * q), mu_a = *(const f32x4*)(w.mu + 1600 + 4 * q), mu_g0 = *(const f32x4*)(w.mu + 1664 + 8 * q), mu_g1 = *(const f32x4*)(w.mu + 1668 + 8 * q);
    const f32x4 c_w0 = *(const f32x4*)(w.w0 + c0), c_a0 = *(const f32x4*)(w.a0 + c0), c_kk = *(const f32x4*)(w.k_k + c0), c_ka = *(const f32x4*)(w.k_a + c0), c_rk = *(const f32x4*)(w.r_k + c0);
    const int rowl = tid >> 4, kq = tid & 15;
    float s0 = 0.f, s1 = 0.f, s2 = 0.f, s3 = 0.f;
    const bf16_t* zbase = ZB + (size_t)b * T_ * ZBW;
    for (int t0 = 0; t0 < T_; t0 += SC_C) {
        { const int t = t0 + tt; const bf16_t* cur = zbase + (size_t)t * ZBW; const bf16_t* prv = cur - ZBW; const bool hp = t > 0;
          const f32x4 z4 = (f32x4){0.f, 0.f, 0.f, 0.f};
          f32x4 cr = load4bf(cur + c0), ck = load4bf(cur + 512 + c0), cv = load4bf(cur + 1024 + c0), cw = load4bf(cur + 1536 + 4 * q), ca = load4bf(cur + 1600 + 4 * q), cg0 = load4bf(cur + 1664 + 8 * q), cg1 = load4bf(cur + 1668 + 8 * q);
          f32x4 pr = hp ? load4bf(prv + c0) : z4, pk = hp ? load4bf(prv + 512 + c0) : z4, pv = hp ? load4bf(prv + 1024 + c0) : z4, pw = hp ? load4bf(prv + 1536 + 4 * q) : z4, pa = hp ? load4bf(prv + 1600 + 4 * q) : z4,
                pg0 = hp ? load4bf(prv + 1664 + 8 * q) : z4, pg1 = hp ? load4bf(prv + 1668 + 8 * q) : z4;
          cr = cr + (pr - cr) * mu_r; ck = ck + (pk - ck) * mu_k; cv = cv + (pv - cv) * mu_v; cw = cw + (pw - cw) * mu_w; ca = ca + (pa - ca) * mu_a; cg0 = cg0 + (pg0 - cg0) * mu_g0; cg1 = cg1 + (pg1 - cg1) * mu_g1;
          *(LAS f32x4*)(XR + tt * 64 + 4 * q) = cr; *(LAS f32x4*)(XK + tt * 64 + 4 * q) = ck; *(LAS f32x4*)(XV + tt * 64 + 4 * q) = cv;
          u32x2 o; o.x = pk2(tanhf(cw[0]), tanhf(cw[1])); o.y = pk2(tanhf(cw[2]), tanhf(cw[3])); *(LAS u32x2*)(LW + tt * 144 + 8 * q) = o;
          o.x = pk2(ca[0], ca[1]); o.y = pk2(ca[2], ca[3]); *(LAS u32x2*)(LA + tt * 144 + 8 * q) = o;
          u32x4 o4; o4.x = pk2(sigm(cg0[0]), sigm(cg0[1])); o4.y = pk2(sigm(cg0[2]), sigm(cg0[3])); o4.z = pk2(sigm(cg1[0]), sigm(cg1[1])); o4.w = pk2(sigm(cg1[2]), sigm(cg1[3])); *(LAS u32x4*)(LG + tt * 272 + 16 * q) = o4; }
        __syncthreads();
        { f32x4 wl = (f32x4){0.f, 0.f, 0.f, 0.f}, al = wl, gl = wl;
#pragma unroll
          for (int ks = 0; ks < 2; ++ks) { const bf16x8 aw = *(const LAS bf16x8*)(LW + (ttile * 16 + fr) * 144 + 64 * ks + 16 * fq), aa = *(const LAS bf16x8*)(LA + (ttile * 16 + fr) * 144 + 64 * ks + 16 * fq);
              wl = __builtin_amdgcn_mfma_f32_16x16x32_bf16(aw, Bw[ks], wl, 0, 0, 0); al = __builtin_amdgcn_mfma_f32_16x16x32_bf16(aa, Ba[ks], al, 0, 0, 0); }
#pragma unroll
          for (int ks = 0; ks < 4; ++ks) { const bf16x8 ag = *(const LAS bf16x8*)(LG + (ttile * 16 + fr) * 272 + 64 * ks + 16 * fq); gl = __builtin_amdgcn_mfma_f32_16x16x32_bf16(ag, Bg[ks], gl, 0, 0, 0); }
#pragma unroll
          for (int e = 0; e < 4; ++e) { const int tr = ttile * 16 + 4 * fq + e, nc = ntile * 16 + fr; PW[tr * 64 + nc] = wl[e]; PA[tr * 64 + nc] = al[e]; PG[tr * 64 + nc] = gl[e]; } }
        __syncthreads();
        { const f32x4 wl = *(LAS f32x4*)(PW + tt * 64 + 4 * q), al = *(LAS f32x4*)(PA + tt * 64 + 4 * q), gl = *(LAS f32x4*)(PG + tt * 64 + 4 * q);
          const f32x4 r4 = *(LAS f32x4*)(XR + tt * 64 + 4 * q), k4 = *(LAS f32x4*)(XK + tt * 64 + 4 * q), v4 = *(LAS f32x4*)(XV + tt * 64 + 4 * q);
          f32x4 dec, a4, kkr, kp; float ssq = 0.f, cs = 0.f;
#pragma unroll
          for (int e = 0; e < 4; ++e) { dec[e] = decay_of(c_w0[e], wl[e]); a4[e] = sigm(c_a0[e] + al[e]); kkr[e] = k4[e] * c_kk[e]; ssq += kkr[e] * kkr[e]; kp[e] = k4[e] * (1.f + (a4[e] - 1.f) * c_ka[e]); cs += r4[e] * kp[e] * c_rk[e]; }
          ssq = red16(ssq); cs = red16(cs); const float inv = 1.f / fmaxf(sqrtf(ssq), 1e-12f);
          const f32x4 kk = kkr * inv;
          *(LAS f32x4*)(PW + tt * 64 + 4 * q) = dec; *(LAS f32x4*)(PA + tt * 64 + 4 * q) = -kk; *(LAS f32x4*)(PG + tt * 64 + 4 * q) = kk * a4; *(LAS f32x4*)(XK + tt * 64 + 4 * q) = kp;
          if (rs == 0) { const size_t off = ((size_t)b * T_ + t0 + tt) * 512 + c0; *(f32x4*)(G + off) = gl; *(f32x4*)(BON + off) = v4 * cs; } }
        __syncthreads();
        { float* yp = Y + ((size_t)b * T_ + t0) * 512 + h * 64 + rs * 32 + rowl;
#pragma unroll 4
          for (int i = 0; i < SC_C; ++i) {
              const f32x4 a4 = *(LAS f32x4*)(PA + i * 64 + 4 * kq), w4 = *(LAS f32x4*)(PW + i * 64 + 4 * kq), b4 = *(LAS f32x4*)(PG + i * 64 + 4 * kq), k4 = *(LAS f32x4*)(XK + i * 64 + 4 * kq), r4 = *(LAS f32x4*)(XR + i * 64 + 4 * kq);
              const float vv = XV[i * 64 + rs * 32 + rowl];
              const float sa = red16((s0 * a4[0] + s1 * a4[1]) + (s2 * a4[2] + s3 * a4[3]));
              s0 = (s0 * w4[0] + vv * k4[0]) + sa * b4[0]; s1 = (s1 * w4[1] + vv * k4[1]) + sa * b4[1]; s2 = (s2 * w4[2] + vv * k4[2]) + sa * b4[2]; s3 = (s3 * w4[3] + vv * k4[3]) + sa * b4[3];
              const float y = red16((s0 * r4[0] + s1 * r4[1]) + (s2 * r4[2] + s3 * r4[3]));
              if (kq == 0) yp[(size_t)i * 512] = y;
          } }
        __syncthreads();
    }
    *(f32x4*)(out + O_WKVP + ((size_t)(b * 8 + h) * 64 + rs * 32 + rowl) * 64 + 4 * kq) = (f32x4){s0, s1, s2, s3};
}

struct Args { const float* in[28]; float* out; unsigned char* ws; int ph_lo, ph_hi; };
constexpr int N_PH = 9;

__global__ void __launch_bounds__(512, 2) fwd_kernel(Args args) {
    extern __shared__ __attribute__((aligned(16))) unsigned char lds_raw[];
    LAS unsigned char* lds = (LAS unsigned char*)lds_raw;
    const int tid = threadIdx.x, lane = tid & 63, wid = __builtin_amdgcn_readfirstlane(tid >> 6);
    const int G = gridDim.x, bx = blockIdx.x;
    const int gw = bx * 8 + wid, NGW = G * 8;
    unsigned char* ws = args.ws; float* out = args.out;
    const float* x = args.in[0]; const float* xs = args.in[1];
    unsigned* ctl = (unsigned*)(ws + WS_CTL);
    float* SS1 = (float*)(ws + CTL_SS1); float* SS1S = (float*)(ws + CTL_SS1S); float* SS2 = (float*)(ws + CTL_SS2); float* SS2S = (float*)(ws + CTL_SS2S);
    bf16_t* WinT = (bf16_t*)(ws + WS_WIN); bf16_t* WaT = (bf16_t*)(ws + WS_WA); bf16_t* WbT = (bf16_t*)(ws + WS_WB); bf16_t* WoT = (bf16_t*)(ws + WS_WO); bf16_t* WupT = (bf16_t*)(ws + WS_WUP); bf16_t* WdnT = (bf16_t*)(ws + WS_WDN);
    bf16_t* WlT = (bf16_t*)(ws + WS_WL); bf16_t* AlT = (bf16_t*)(ws + WS_AL); bf16_t* GlT = (bf16_t*)(ws + WS_GL);
    unsigned char* sm = ws + WS_SMALL;
    bf16_t* H1S = (bf16_t*)(sm + SM_H1S); float* ZS = (float*)(sm + SM_ZS); bf16_t* ATTS = (bf16_t*)(sm + SM_ATTS); bf16_t* RWS = (bf16_t*)(sm + SM_RWS); bf16_t* MGS = (bf16_t*)(sm + SM_MGS); bf16_t* X1GS = (bf16_t*)(sm + SM_X1GS); bf16_t* US = (bf16_t*)(sm + SM_US);
    bf16_t* H1 = (bf16_t*)(ws + WS_H1); bf16_t* QKV = (bf16_t*)(ws + WS_QKV); bf16_t* ZB = (bf16_t*)(ws + WS_ZB); bf16_t* U = (bf16_t*)(ws + WS_U); bf16_t* GATE = (bf16_t*)(ws + WS_GATE);
    bf16_t* OG = (bf16_t*)(ws + WS_OG); float* LSE = (float*)(ws + WS_LSE); bf16_t* ATT = (bf16_t*)(ws + WS_ATT); bf16_t* RW = (bf16_t*)(ws + WS_RW); bf16_t* MG = (bf16_t*)(ws + WS_MG);
    float* Yb = (float*)(ws + WS_Y); float* Gb = (float*)(ws + WS_G); float* BON = (float*)(ws + WS_BON); float* TMP = (float*)(ws + WS_TMP);
    SP sp; sp.ZS = ZS; sp.b_gate = args.in[9]; sp.out = out; sp.xs = xs; sp.g2 = args.in[24]; sp.MGS = MGS; sp.X1GS = X1GS; sp.US = US; sp.SS1S = SS1S; sp.SS2S = SS2S;
    const int lo = args.ph_lo, hi = args.ph_hi;
    if (tid < 32) ((volatile LAS unsigned*)(lds + MISC_OFF))[tid] = 0u;
    __syncthreads();
    if (lo < 0) cg::this_grid().sync();
    XcdBarrier xbar = xcd_barrier_post((unsigned*)(ws + CTL_BAR), (volatile LAS unsigned*)(lds + MISC_OFF) + 8);
#ifndef MK_ONLY
#define MK_ONLY -1
#endif
#define IN(k) ((MK_ONLY < 0 || MK_ONLY == (k)) && lo <= (k) && (k) < hi)
#define SEAM(k) do { if (IN(k) && IN((k) + 1)) { xcd_barrier(xbar); } } while (0)

    if (IN(0)) {
        LAS float* scr = (LAS float*)(lds + wid * 16384);
        constexpr int I_IN = 16 * 192, I_A = 4 * 32, I_B = 8 * 32, I_O = 16 * 32, I_UP = 16 * 128, I_DN = 64 * 32, I_WL = 16, I_AL = 16, I_GL = 32;
        constexpr int NITEMS = I_IN + I_A + I_B + I_O + I_UP + I_DN + I_WL + I_AL + I_GL;
        for (int it = gw; it < NITEMS; it += NGW) {
            int r = it;
            if (r < I_IN) { p0_transpose_item(args.in[8], 1024, 6144, WinT, scr, r, lane); continue; } r -= I_IN;
            if (r < I_A) { p0_transpose_item(args.in[21], 256, 1024, WaT, scr, r, lane); continue; } r -= I_A;
            if (r < I_B) { p0_transpose_item(args.in[22], 512, 1024, WbT, scr, r, lane); continue; } r -= I_B;
            if (r < I_O) { p0_transpose_item(args.in[23], 1024, 1024, WoT, scr, r, lane); continue; } r -= I_O;
            if (r < I_UP) { p0_transpose_item(args.in[25], 1024, 4096, WupT, scr, r, lane); continue; } r -= I_UP;
            if (r < I_DN) { p0_transpose_item(args.in[26], 4096, 1024, WdnT, scr, r, lane); continue; } r -= I_DN;
            if (r < I_WL) { p0_transpose_item(args.in[12], 64, 512, WlT, scr, r, lane); continue; } r -= I_WL;
            if (r < I_AL) { p0_transpose_item(args.in[14], 64, 512, AlT, scr, r, lane); continue; } r -= I_AL;
            p0_transpose_item(args.in[15], 128, 512, GlT, scr, r, lane);
        }
        for (int m = gw; m < M_ + MS_; m += NGW) { if (m < M_) rms_row_to_bf16(x + (size_t)m * D_, args.in[7], H1 + (size_t)m * D_, lane); else rms_row_to_bf16(xs + (size_t)(m - M_) * D_, args.in[7], H1S + (size_t)(m - M_) * D_, lane); }
        __syncthreads();
    }
    SEAM(0);
    if (IN(1)) {
        pg8::Gemm g{H1, WinT, M_, NIN_, D_}; pg8::StaticOrder S; S.init(M_, NIN_, G, bx);
        EpiZ E{QKV, ZB, GATE, args.in[9], out};
        pg8::gemm_phase<EpiZ, pg8::StaticOrder, true, true>(lds, g, S, E);
        sample_gemm<0>(lds, H1S, D_, WinT, nullptr, 0, nullptr, NIN_, sp);
    }
    SEAM(1);
    if (IN(2)) {
        RwW w; w.mu = args.in[10]; w.w0 = args.in[11]; w.wl = args.in[12]; w.a0 = args.in[13]; w.al = args.in[14]; w.gl = args.in[15]; w.k_k = args.in[16]; w.k_a = args.in[17]; w.r_k = args.in[18]; w.gn_g = args.in[19]; w.gn_b = args.in[20];
        for (int su = bx; su < 128; su += G) scan_unit(lds, su, ZB, w, WlT, AlT, GlT, Yb, Gb, BON, out);
        volatile LAS int* qslot = (volatile LAS int*)(lds + MISC_OFF);
        constexpr int NQ = 32 + 256 + 1536;
        for (;;) {
            if (tid == 0) *qslot = (int)atomicAdd(ctl, 1u);
            __syncthreads(); const int item = *qslot; __syncthreads();
            if (item >= NQ) break;
            if (item < 32) sample_attn(lds, item, ZS, args.in[2], args.in[3], args.in[4], ATTS);
            else if (item < 288) sample_rwkv(lds, item - 32, ZS, args.in[5], args.in[6], w, out, RWS);
            else attn_unit(lds, item - 288, QKV, OG, LSE);
        }
    }
    SEAM(2);
    if (IN(3)) {
        const float* gn_g = args.in[19]; const float* gn_b = args.in[20];
        for (int m = gw; m < M_; m += NGW) {
            { const int hs = lane >> 4; const float l0 = LSE[(size_t)m * 12 + hs], l1 = LSE[(size_t)m * 12 + 4 + hs], l2 = LSE[(size_t)m * 12 + 8 + hs]; const float mm = fmaxf(l0, fmaxf(l1, l2));
              const float w0 = __expf(l0 - mm), w1 = __expf(l1 - mm), w2 = __expf(l2 - mm); const float inv = 1.f / (w0 + w1 + w2);
              const f32x4 o0 = load4bf(OG + (size_t)m * 768 + 4 * lane), o1 = load4bf(OG + (size_t)m * 768 + 256 + 4 * lane), o2 = load4bf(OG + (size_t)m * 768 + 512 + 4 * lane);
              store4bf(ATT + (size_t)m * 256 + 4 * lane, (o0 * w0 + o1 * w1 + o2 * w2) * inv); }
            { const size_t off = (size_t)m * 512 + 8 * lane; const f32x4 y0 = *(const f32x4*)(Yb + off), y1 = *(const f32x4*)(Yb + off + 4);
              const float mu = red8((y0[0] + y0[1]) + (y0[2] + y0[3]) + (y1[0] + y1[1]) + (y1[2] + y1[3])) * (1.f / 64.f); const f32x4 d0 = y0 - mu, d1 = y1 - mu;
              const float var = red8((d0[0] * d0[0] + d0[1] * d0[1]) + (d0[2] * d0[2] + d0[3] * d0[3]) + (d1[0] * d1[0] + d1[1] * d1[1]) + (d1[2] * d1[2] + d1[3] * d1[3])) * (1.f / 64.f); const float rstd = rsqrtf(var + GN_EPS);
              const f32x4 g0 = *(const f32x4*)(gn_g + 8 * lane), g1 = *(const f32x4*)(gn_g + 8 * lane + 4), b0 = *(const f32x4*)(gn_b + 8 * lane), b1 = *(const f32x4*)(gn_b + 8 * lane + 4);
              const f32x4 bo0 = *(const f32x4*)(BON + off), bo1 = *(const f32x4*)(BON + off + 4), gg0 = *(const f32x4*)(Gb + off), gg1 = *(const f32x4*)(Gb + off + 4);
              store8bf(RW + off, (d0 * rstd * g0 + b0 + bo0) * gg0, (d1 * rstd * g1 + b1 + bo1) * gg1); }
        }
    }
    SEAM(3);
    if (IN(4)) {
        pg8::StaticOrder S; S.init(M_, D_, G, bx);
        int ka = 256, kb = 512; asm volatile("" : "+s"(ka), "+s"(kb));
        { pg8::Gemm g{ATT, WaT, M_, D_, ka}; EpiPA E{GATE, TMP}; pg8::gemm_phase<EpiPA, pg8::StaticOrder, true, true>(lds, g, S, E); }
        { pg8::Gemm g{RW, WbT, M_, D_, kb}; EpiPB E{GATE, TMP, MG}; pg8::gemm_phase<EpiPB, pg8::StaticOrder, true, true>(lds, g, S, E); }
        sample_gemm<1>(lds, ATTS, 256, WaT, RWS, 512, WbT, D_, sp);
    }
    SEAM(4);
    if (IN(5)) {
        pg8::Gemm g{MG, WoT, M_, D_, D_}; pg8::StaticOrder S; S.init(M_, D_, G, bx);
        EpiRes<true> E{x, out + O_Y, H1, args.in[24], SS1};
        pg8::gemm_phase<EpiRes<true>, pg8::StaticOrder, true, true>(lds, g, S, E);
        sample_gemm<2>(lds, MGS, D_, WoT, nullptr, 0, nullptr, D_, sp);
    }
    SEAM(5);
    if (IN(6)) {
        pg8::Gemm g{H1, WupT, M_, FF_, D_}; pg8::StaticOrder S; S.init(M_, FF_, G, bx);
        EpiUp E{SS1, U};
        pg8::gemm_phase<EpiUp, pg8::StaticOrder, true, true>(lds, g, S, E);
        sample_gemm<3>(lds, X1GS, D_, WupT, nullptr, 0, nullptr, FF_, sp);
    }
    SEAM(6);
    if (IN(7)) {
        pg8::Gemm g{U, WdnT, M_, D_, FF_}; pg8::StaticOrder S; S.init(M_, D_, G, bx);
        EpiRes<false> E{out + O_Y, out + O_Y, nullptr, nullptr, SS2};
        pg8::gemm_phase<EpiRes<false>, pg8::StaticOrder, true, true>(lds, g, S, E);
        sample_gemm<4>(lds, US, FF_, WdnT, nullptr, 0, nullptr, D_, sp);
    }
    SEAM(7);
    if (IN(8)) {
        const float* gf = args.in[27];
        for (int m = gw; m < M_ + MS_; m += NGW) {
            float* row = (m < M_) ? (out + O_Y + (size_t)m * D_) : (out + O_YS + (size_t)(m - M_) * D_); const float ss = (m < M_) ? SS2[m] : SS2S[m - M_];
            const float rs = rsqrtf(ss * (1.f / D_) + NORM_EPS);
#pragma unroll
            for (int j = 0; j < 4; ++j) { f32x4* p = (f32x4*)row + lane + 64 * j; const f32x4 gg = *((const f32x4*)gf + lane + 64 * j); *p = *p * rs * gg; }
        }
    }
#undef IN
#undef SEAM
}
}

#ifndef MK_N_LAUNCHES
#define MK_N_LAUNCHES 1
#endif
extern "C" void kernel_launch(void* const* d_in, const int* in_sizes, int n_in, void* d_out, int out_size, void* d_ws, size_t ws_size, hipStream_t stream) {
    static int grid = 0;
    if (grid == 0) {
        if (n_in != 28 || (size_t)out_size != mk::O_END || ws_size < mk::WS_END) { fprintf(stderr, "kernel_launch: unexpected shapes: n_in %d out %d ws %zu\n", n_in, out_size, ws_size); grid = -1; return; }
        int dev = 0, cus = 0, per_cu = 0;
        if (hipGetDevice(&dev) != hipSuccess || hipDeviceGetAttribute(&cus, hipDeviceAttributeMultiprocessorCount, dev) != hipSuccess) { grid = -1; return; }
        if (hipFuncSetAttribute((const void*)mk::fwd_kernel, hipFuncAttributeMaxDynamicSharedMemorySize, mk::LDS_BYTES) != hipSuccess) { fprintf(stderr, "kernel_launch: hipFuncSetAttribute failed\n"); grid = -1; return; }
        if (hipOccupancyMaxActiveBlocksPerMultiprocessor(&per_cu, (const void*)mk::fwd_kernel, 512, mk::LDS_BYTES) != hipSuccess || per_cu < 1) { fprintf(stderr, "kernel_launch: occupancy query says %d\n", per_cu); }
        (void)hipGetLastError();
        grid = cus;
    }
    if (grid < 0) return;
    (void)hipMemsetAsync((char*)d_ws + mk::WS_CTL, 0, mk::CTL_ZERO_BYTES, stream);
    mk::Args a{};
    for (int i = 0; i < 28; ++i) a.in[i] = (const float*)d_in[i];
    a.out = (float*)d_out; a.ws = (unsigned char*)d_ws;
    if (MK_N_LAUNCHES == 1) {
        a.ph_lo = 0; a.ph_hi = mk::N_PH;
        void* params[] = {&a};
        hipError_t e = hipLaunchCooperativeKernel((const void*)mk::fwd_kernel, dim3(grid), dim3(512), params, mk::LDS_BYTES, stream);
        if (e != hipSuccess) fprintf(stderr, "cooperative launch failed: %s (grid %d)\n", hipGetErrorString(e), grid);
    } else {
        for (int ph = 0; ph < mk::N_PH; ++ph) { a.ph_lo = ph; a.ph_hi = ph + 1; hipLaunchKernelGGL(mk::fwd_kernel, dim3(grid), dim3(512), mk::LDS_BYTES, stream, a); }
    }
}
```

```cpp
#include <hip/hip_runtime.h>
#include <hip/hip_cooperative_groups.h>
#include <cstdio>
#include <cstdint>
namespace cg = cooperative_groups;
namespace pg8 {
#define PG8_LAS __attribute__((address_space(3)))
typedef unsigned short bf16_t;
typedef short bf16x8 __attribute__((ext_vector_type(8)));
typedef float f32x4 __attribute__((ext_vector_type(4)));
typedef unsigned u32x4 __attribute__((ext_vector_type(4)));
constexpr int BM = 256, BK = 64, HALF = 128, HTB = HALF * BK * 2  , STAGE_BYTES = 8 * HTB, NXCD = 8, WGM = 8;

__host__ __device__ __forceinline__ int lds_byte(int r, int c) { const int st = (r >> 4) * 2 + (c >> 5), rr = r & 15, cc = c & 31, ob = rr * 64 + cc * 2; return st * 1024 + (ob ^ (((ob >> 9) & 1) << 5)); }
__host__ __device__ __forceinline__ void stage_rc(int b, int& R, int& C) { const int st = b / 1024, sb = b % 1024, swz = sb ^ (((sb >> 9) & 1) << 5); R = (st >> 1) * 16 + swz / 64; C = (st & 1) * 32 + (swz % 64) / 2; }
__host__ __device__ __forceinline__ int perm32(int rho) { const int n = rho >> 4, i = rho & 15; return 8 * (i >> 2) + 4 * n + (i & 3); }

struct Unit { int pm, pn; };
struct Gemm { const bf16_t* A; const bf16_t* Bt; int M, N, K; };

struct StaticOrder {
    int nM, nN, nwg, G, c;
    __host__ __device__ void init(int M, int N, int G_, int c_) { nM = M / BM; nN = N / BM; nwg = nM * nN; G = G_; c = c_; }
    __host__ __device__ bool next(int i, Unit& u) const {
        const long L = (long)i * G + c; if (L >= nwg) return false;
        int wgid = (int)L; { const int q = nwg / NXCD, r = nwg % NXCD, xcd = wgid % NXCD, off = wgid / NXCD; wgid = (xcd < r ? xcd * (q + 1) : r * (q + 1) + (xcd - r) * q) + off; }
        const int nig = WGM * nN, gid = wgid / nig, fm = gid * WGM, gsz = (nM - fm) < WGM ? (nM - fm) : WGM;
        u.pm = fm + ((wgid % nig) % gsz); u.pn = (wgid % nig) / gsz; return true;
    }
    __device__ __forceinline__ void a_ready(const Unit&) const {}
    __device__ __forceinline__ void done(const Unit&) const {}
};

__device__ __forceinline__ unsigned cvt_pk_bf16(float lo, float hi) { unsigned r; asm volatile("v_cvt_pk_bf16_f32 %0, %1, %2" : "=v"(r) : "v"(lo), "v"(hi)); return r; }
template <class Epi, class Sched, bool ALIGN_EPI = false, bool SP2 = false>
__device__ __forceinline__ void gemm_phase(PG8_LAS unsigned char* lds, const Gemm g, const Sched& S, const Epi& E) {
    const int tid = threadIdx.x, wid = __builtin_amdgcn_readfirstlane(tid >> 6), lane = tid & 63, wr = wid >> 2, wc = wid & 3, fr = lane & 15, fq = lane >> 4;
    const int K = g.K, nt = K / BK;
    unsigned voffA[2], voffB[2];
#pragma unroll
    for (int i = 0; i < 2; ++i) { int R, C; stage_rc(tid * 16 + i * 8192, R, C); const int Rb = Epi::PERM ? ((R & ~31) + perm32(R & 31)) : R;
        voffA[i] = (unsigned)(R * K + C) * 2u; voffB[i] = (unsigned)(Rb * K + C) * 2u; }
    const size_t kstep = (size_t)(BK * 2);
    const size_t hstep = (size_t)HALF * K * 2;
    const size_t tstep = 2 * hstep;
    const unsigned ldsw = (unsigned)wid * 1024u;
    const int aoff = lds_byte(wr * 64 + fr, fq * 8), boff = lds_byte(wc * 32 + fr, fq * 8);
#define PG8_SA(b, h) (((b) * 2 + (h)) * HTB)
#define PG8_SB(b, h) ((4 + (b) * 2 + (h)) * HTB)
#define PG8_STAGE(bufoff, gbase, voff) do { _Pragma("unroll") for (int _i = 0; _i < 2; ++_i) \
        __builtin_amdgcn_global_load_lds((const unsigned*)((const char*)(gbase) + (voff)[_i]), (PG8_LAS unsigned*)(lds + (bufoff) + ldsw + _i * 8192), 16, 0, 0); } while (0)
#define PG8_LDA(dst, b, h) do { _Pragma("unroll") for (int m = 0; m < 4; ++m) _Pragma("unroll") for (int k = 0; k < 2; ++k) dst[m][k] = *(const PG8_LAS bf16x8*)(lds + PG8_SA(b, h) + aoff + m * 2048 + k * 1024); } while (0)
#define PG8_LDB(dst, b, h) do { _Pragma("unroll") for (int n = 0; n < 2; ++n) _Pragma("unroll") for (int k = 0; k < 2; ++k) dst[n][k] = *(const PG8_LAS bf16x8*)(lds + PG8_SB(b, h) + boff + n * 2048 + k * 1024); } while (0)
#define PG8_MMA(ai, bj, At, Bt) do { __builtin_amdgcn_s_setprio(1); _Pragma("unroll") for (int m = 0; m < 4; ++m) _Pragma("unroll") for (int n = 0; n < 2; ++n) _Pragma("unroll") for (int k = 0; k < 2; ++k) \
        acc[ai][bj][m][n] = __builtin_amdgcn_mfma_f32_16x16x32_bf16(Bt[n][k], At[m][k], acc[ai][bj][m][n], 0, 0, 0); __builtin_amdgcn_s_setprio(0); } while (0)
#define PG8_WAIT_V(n) asm volatile("s_waitcnt vmcnt(" #n ")" ::: "memory")
#define PG8_WAIT_L(n) asm volatile("s_waitcnt lgkmcnt(" #n ")" ::: "memory")
#define PG8_BAR __builtin_amdgcn_s_barrier()
#define PG8_SCHED __builtin_amdgcn_sched_barrier(0)
    Unit cur, nxt; int ui = 0;
    if (!S.next(0, cur)) return;
    f32x4 acc[2][2][4][2];
#pragma unroll
    for (int a = 0; a < 2; ++a)
#pragma unroll
        for (int b = 0; b < 2; ++b)
#pragma unroll
            for (int m = 0; m < 4; ++m)
#pragma unroll
                for (int n = 0; n < 2; ++n) acc[a][b][m][n] = (f32x4){0.f, 0.f, 0.f, 0.f};
    bf16x8 At[4][2], B0[2][2], B1[2][2];
    const char* cA = (const char*)g.A + (size_t)cur.pm * tstep; const char* cB = (const char*)g.Bt + (size_t)cur.pn * tstep;
    S.a_ready(cur);
    if constexpr (SP2) {
        PG8_STAGE(PG8_SB(0, 0), cB, voffB); PG8_STAGE(PG8_SB(0, 1), cB + hstep, voffB); PG8_STAGE(PG8_SA(0, 0), cA, voffA); PG8_STAGE(PG8_SA(0, 1), cA + hstep, voffA);
        if (wr == 1) PG8_BAR;
        PG8_WAIT_V(2); PG8_BAR;
        PG8_STAGE(PG8_SB(1, 0), cB + kstep, voffB); PG8_STAGE(PG8_SA(1, 0), cA + kstep, voffA); PG8_STAGE(PG8_SB(1, 1), cB + hstep + kstep, voffB);
        PG8_WAIT_V(6); PG8_BAR;
    } else {
        PG8_STAGE(PG8_SB(0, 0), cB, voffB); PG8_STAGE(PG8_SA(0, 0), cA, voffA); PG8_STAGE(PG8_SB(0, 1), cB + hstep, voffB); PG8_STAGE(PG8_SA(0, 1), cA + hstep, voffA);
        if (wr == 1) PG8_BAR;
        PG8_WAIT_V(4); PG8_BAR;
        PG8_STAGE(PG8_SB(1, 0), cB + kstep, voffB); PG8_STAGE(PG8_SA(1, 0), cA + kstep, voffA); PG8_STAGE(PG8_SB(1, 1), cB + hstep + kstep, voffB);
        PG8_WAIT_V(6); PG8_BAR;
    }
    for (;;) {
        const bool has_next = S.next(ui + 1, nxt);
        const char* nA = has_next ? (const char*)g.A + (size_t)nxt.pm * tstep : cA; const char* nB = has_next ? (const char*)g.Bt + (size_t)nxt.pn * tstep : cB;
        for (int t = 0; t < nt; t += 2) {
            const bool last = (t == nt - 2);
            const char* a1 = cA + (size_t)(t + 1) * kstep;
            const char* a2 = last ? nA : cA + (size_t)(t + 2) * kstep; const char* b2 = last ? nB : cB + (size_t)(t + 2) * kstep;
            const char* a3 = a2 + kstep; const char* b3 = b2 + kstep;
            if (last && has_next) S.a_ready(nxt);
            if constexpr (SP2) {
            PG8_LDB(B0, 0, 0); PG8_LDB(B1, 0, 1); PG8_SCHED; PG8_LDA(At, 0, 0); PG8_STAGE(PG8_SA(1, 1), a1 + hstep, voffA);
            PG8_WAIT_V(8); PG8_WAIT_L(0); PG8_BAR; PG8_MMA(0, 0, At, B0); PG8_MMA(0, 1, At, B1); PG8_BAR; PG8_SCHED;
            PG8_LDA(At, 0, 1); PG8_STAGE(PG8_SB(0, 0), b2, voffB); PG8_STAGE(PG8_SB(0, 1), b2 + hstep, voffB); PG8_STAGE(PG8_SA(0, 0), a2, voffA);
            PG8_WAIT_V(8); PG8_WAIT_L(0); PG8_BAR; PG8_MMA(1, 0, At, B0); PG8_MMA(1, 1, At, B1); PG8_BAR; PG8_SCHED;
            PG8_LDB(B0, 1, 0); PG8_LDB(B1, 1, 1); PG8_SCHED; PG8_LDA(At, 1, 0); PG8_STAGE(PG8_SA(0, 1), a2 + hstep, voffA);
            PG8_WAIT_V(8); PG8_WAIT_L(0); PG8_BAR; PG8_MMA(0, 0, At, B0); PG8_MMA(0, 1, At, B1); PG8_BAR; PG8_SCHED;
            PG8_LDA(At, 1, 1); PG8_STAGE(PG8_SB(1, 0), b3, voffB); PG8_STAGE(PG8_SB(1, 1), b3 + hstep, voffB); PG8_STAGE(PG8_SA(1, 0), a3, voffA);
            PG8_WAIT_V(8); PG8_WAIT_L(0); PG8_BAR; PG8_MMA(1, 0, At, B0); PG8_MMA(1, 1, At, B1); PG8_BAR; PG8_SCHED;
            } else {
            PG8_LDB(B0, 0, 0); PG8_SCHED; PG8_LDA(At, 0, 0); PG8_STAGE(PG8_SA(1, 1), a1 + hstep, voffA);
            PG8_WAIT_L(8); PG8_BAR; PG8_WAIT_L(0); PG8_MMA(0, 0, At, B0); PG8_BAR; PG8_SCHED;
            PG8_LDB(B1, 0, 1); PG8_STAGE(PG8_SB(0, 0), b2, voffB);
            PG8_BAR; PG8_WAIT_L(0); PG8_MMA(0, 1, At, B1); PG8_BAR;
            PG8_LDA(At, 0, 1); PG8_STAGE(PG8_SA(0, 0), a2, voffA);
            PG8_BAR; PG8_WAIT_L(0); PG8_MMA(1, 0, At, B0); PG8_BAR; PG8_SCHED;
            PG8_STAGE(PG8_SB(0, 1), b2 + hstep, voffB);
            PG8_WAIT_V(6); PG8_BAR; PG8_MMA(1, 1, At, B1); PG8_BAR;
            PG8_LDB(B0, 1, 0); PG8_SCHED; PG8_LDA(At, 1, 0); PG8_STAGE(PG8_SA(0, 1), a2 + hstep, voffA);
            PG8_WAIT_L(8); PG8_BAR; PG8_WAIT_L(0); PG8_MMA(0, 0, At, B0); PG8_BAR; PG8_SCHED;
            PG8_LDB(B1, 1, 1); PG8_STAGE(PG8_SB(1, 0), b3, voffB);
            PG8_BAR; PG8_WAIT_L(0); PG8_MMA(0, 1, At, B1); PG8_BAR;
            PG8_LDA(At, 1, 1); PG8_STAGE(PG8_SA(1, 0), a3, voffA);
            PG8_BAR; PG8_WAIT_L(0); PG8_MMA(1, 0, At, B0); PG8_BAR; PG8_SCHED;
            PG8_STAGE(PG8_SB(1, 1), b3 + hstep, voffB);
            PG8_WAIT_V(6); PG8_BAR; PG8_MMA(1, 1, At, B1); PG8_BAR;
            }
        }
        if constexpr (ALIGN_EPI) { if (wr == 0) PG8_BAR; }
        if constexpr (!Epi::AFTER_DRAIN) { E(acc, cur, wr, wc, fr, fq); S.done(cur); }
        if (!has_next) break;
#pragma unroll
        for (int a = 0; a < 2; ++a)
#pragma unroll
            for (int b = 0; b < 2; ++b)
#pragma unroll
                for (int m = 0; m < 4; ++m)
#pragma unroll
                    for (int n = 0; n < 2; ++n) acc[a][b][m][n] = (f32x4){0.f, 0.f, 0.f, 0.f};
        cur = nxt; cA = nA; cB = nB; ++ui;
        if constexpr (ALIGN_EPI) { if (wr == 1) PG8_BAR; }
    }
    PG8_WAIT_V(0);
    if constexpr (!ALIGN_EPI) { if (wr == 0) PG8_BAR; }
    PG8_BAR;
    if constexpr (Epi::AFTER_DRAIN) { E.fused(acc, cur, wr, wc, fr, fq, lds, wid, lane); S.done(cur); }
#undef PG8_SA
#undef PG8_SB
#undef PG8_STAGE
#undef PG8_LDA
#undef PG8_LDB
#undef PG8_MMA
#undef PG8_WAIT_V
#undef PG8_WAIT_L
#undef PG8_BAR
#undef PG8_SCHED
}
}

#ifndef MK_USE_CG
#define MK_USE_CG 1
#endif
namespace mk {
using pg8::bf16_t; using pg8::bf16x8; using pg8::f32x4; using pg8::u32x4; using pg8::Unit; using pg8::cvt_pk_bf16;
typedef unsigned u32x2 __attribute__((ext_vector_type(2)));
typedef float f32x16 __attribute__((ext_vector_type(16)));
#define LAS __attribute__((address_space(3)))

constexpr int T_ = 2048, NB_ = 8, M_ = NB_ * T_, MS_ = 32, D_ = 1024, NIN_ = 6144, FF_ = 4096;
constexpr int QKVW = 2304, ZBW = 1792, GTW = 2048;
constexpr float NORM_EPS = 1e-6f, GN_EPS = 64e-5f;
constexpr size_t O_Y = 0, O_YS = O_Y + (size_t)M_ * D_, O_KV128P = O_YS + (size_t)MS_ * D_, O_KV512P = O_KV128P + (size_t)NB_ * 128 * 512,
                 O_KV2048P = O_KV512P + (size_t)NB_ * 512 * 512, O_WKVP = O_KV2048P + (size_t)NB_ * 2048 * 512, O_SHIFTP = O_WKVP + (size_t)NB_ * 8 * 4096,
                 O_KV128S = O_SHIFTP + (size_t)NB_ * ZBW, O_KV512S = O_KV128S + (size_t)MS_ * 512, O_KV2048S = O_KV512S + (size_t)MS_ * 512,
                 O_WKVS = O_KV2048S + (size_t)MS_ * 512, O_SHIFTS = O_WKVS + (size_t)MS_ * 8 * 4096, O_END = O_SHIFTS + (size_t)MS_ * ZBW;
constexpr size_t MiB = 1u << 20, KiB = 1u << 10;
constexpr size_t WS_CTL = 0, CTL_ZERO_BYTES = 1 * MiB;
constexpr size_t CTL_SS1 = 64 * KiB, CTL_SS1S = 128 * KiB, CTL_SS2 = 192 * KiB, CTL_SS2S = 256 * KiB, CTL_BAR = 512 * KiB;
constexpr size_t WS_WIN = 2 * MiB, WS_WA = 14 * MiB, WS_WB = 14 * MiB + 512 * KiB, WS_WO = 16 * MiB, WS_WUP = 18 * MiB, WS_WDN = 26 * MiB;
constexpr size_t WS_WL = 34 * MiB, WS_AL = WS_WL + 64 * KiB, WS_GL = WS_WL + 128 * KiB;
constexpr size_t WS_SMALL = 35 * MiB;
constexpr size_t SM_H1S = 0, SM_ZS = 64 * KiB, SM_ATTS = 832 * KiB, SM_RWS = 848 * KiB, SM_MGS = 880 * KiB, SM_X1GS = 944 * KiB, SM_US = 1024 * KiB;
constexpr size_t WS_H1 = 38 * MiB, WS_QKV = 70 * MiB, WS_ZB = 142 * MiB, WS_U = 70 * MiB, WS_GATE = 198 * MiB, WS_OG = 262 * MiB, WS_LSE = 286 * MiB,
                 WS_Y = 287 * MiB, WS_G = 319 * MiB, WS_BON = 351 * MiB, WS_TMP = 287 * MiB, WS_REC = 383 * MiB, WS_ATT = 383 * MiB, WS_RW = 391 * MiB, WS_MG = 407 * MiB, WS_END = 481 * MiB;
constexpr int RING_BYTES = 131072, MISC_OFF = RING_BYTES + 320, LDS_BYTES = 147456;

__device__ __forceinline__ float bf2f(unsigned short h) { return __builtin_bit_cast(float, (unsigned)h << 16); }
__device__ __forceinline__ unsigned f2bf(float f) { unsigned u = __builtin_bit_cast(unsigned, f); return (u + 0x7fffu + ((u >> 16) & 1u)) >> 16; }
__device__ __forceinline__ unsigned pk2(float lo, float hi) { return f2bf(lo) | (f2bf(hi) << 16); }
__device__ __forceinline__ float sigm(float x) { return 1.f / (1.f + __expf(-x)); }
__device__ __forceinline__ void store8bf(bf16_t* p, f32x4 v0, f32x4 v1) { u32x4 w; w.x = cvt_pk_bf16(v0[0], v0[1]); w.y = cvt_pk_bf16(v0[2], v0[3]); w.z = cvt_pk_bf16(v1[0], v1[1]); w.w = cvt_pk_bf16(v1[2], v1[3]); *(u32x4*)p = w; }
__device__ __forceinline__ void store4bf(bf16_t* p, f32x4 v) { u32x2 w; w.x = cvt_pk_bf16(v[0], v[1]); w.y = cvt_pk_bf16(v[2], v[3]); *(u32x2*)p = w; }
__device__ __forceinline__ f32x4 load4bf(const bf16_t* p) { const u32x2 w = *(const u32x2*)p; f32x4 r; r[0] = __builtin_bit_cast(float, w.x << 16); r[1] = __builtin_bit_cast(float, w.x & 0xffff0000u); r[2] = __builtin_bit_cast(float, w.y << 16); r[3] = __builtin_bit_cast(float, w.y & 0xffff0000u); return r; }
template <int CTRL> __device__ __forceinline__ float dppf(float v) { return __builtin_bit_cast(float, __builtin_amdgcn_update_dpp(0, __builtin_bit_cast(int, v), CTRL, 0xF, 0xF, true)); }
__device__ __forceinline__ float red16(float v) { v += dppf<0xB1>(v); v += dppf<0x4E>(v); v += dppf<0x141>(v); v += dppf<0x140>(v); return v; }
__device__ __forceinline__ float red8(float v) { v += dppf<0xB1>(v); v += dppf<0x4E>(v); v += dppf<0x141>(v); return v; }
__device__ __forceinline__ float wave_sum(float v) {
#pragma unroll
    for (int o = 1; o < 64; o <<= 1) v += __shfl_xor(v, o);
    return v;
}
__device__ __forceinline__ float wave_max(float v) {
#pragma unroll
    for (int o = 1; o < 64; o <<= 1) v = fmaxf(v, __shfl_xor(v, o));
    return v;
}

#define XB_TMO      128
#define XB_XCNT(j)  (256  + 64 * (j))
#define XB_XSUB(j)  (1280 + 64 * (j))
#define XB_XGEN(j)  (2304 + 64 * (j))
#define XB_TOP      3328
#define XB_TOPGEN   3392
#define XCD_BAR_WORDS 3456
#define XB_SPIN_CAP (1u << 18)

__device__ __forceinline__ unsigned xb_ld(unsigned* p)              { return __hip_atomic_load(p, __ATOMIC_RELAXED, __HIP_MEMORY_SCOPE_AGENT); }
__device__ __forceinline__ unsigned xb_add(unsigned* p, unsigned v) { return __hip_atomic_fetch_add(p, v, __ATOMIC_RELAXED, __HIP_MEMORY_SCOPE_AGENT); }
__device__ __forceinline__ unsigned xb_xcc_id() { return (unsigned)__builtin_amdgcn_s_getreg((3 << 11) | 20) & 0xFu; }
#define XB_SPIN(cond, bar) do { unsigned _sp = 0; while (cond) { __builtin_amdgcn_s_sleep(1); \
    if ((++_sp & 255u) == 0u) { if (xb_ld(&(bar)[XB_TMO])) break; if (_sp > XB_SPIN_CAP) { atomicAdd(&(bar)[XB_TMO], 1u); break; } } } } while (0)

struct XcdBarrier {
    unsigned* bar; unsigned x;
    volatile LAS unsigned* st;
};

__device__ __forceinline__ XcdBarrier xcd_barrier_post(unsigned* bar, volatile LAS unsigned* st) {
    XcdBarrier b; b.bar = bar; b.x = xb_xcc_id(); b.st = st;
    if (threadIdx.x == 0) (void)xb_add(&bar[XB_XCNT(b.x)], 1u);
    return b;
}
__device__ __forceinline__ void xcd_barrier_complete(unsigned* bar, unsigned x, unsigned& nloc, unsigned& nx) {
    const unsigned G = gridDim.x * gridDim.y * gridDim.z;
    unsigned sum, cnt, mine, sp = 0u;
    for (;;) {
        sum = 0u; cnt = 0u; mine = 0u;
#pragma unroll
        for (unsigned j = 0; j < 16; ++j) { const unsigned c = xb_ld(&bar[XB_XCNT(j)]); sum += c; cnt += (c > 0u) ? 1u : 0u; mine = (j == x) ? c : mine; }
        if (sum == G) break;
        __builtin_amdgcn_s_sleep(1);
        if ((++sp & 255u) == 0u) { if (xb_ld(&bar[XB_TMO])) break; if (sp > XB_SPIN_CAP) { atomicAdd(&bar[XB_TMO], 1u); break; } }
    }
    nloc = mine > 0u ? mine : 1u; nx = cnt > 0u ? cnt : 1u;
}

__device__ __forceinline__ void xcd_barrier(const XcdBarrier& b) {
    asm volatile("s_waitcnt vmcnt(0)" ::: "memory");
    __syncthreads();
    if (threadIdx.x == 0) {
        unsigned* bar = b.bar;
        __builtin_amdgcn_s_waitcnt(0);
        unsigned nloc = b.st[0], nx = b.st[1];
        if (nloc == 0u) { xcd_barrier_complete(bar, b.x, nloc, nx); b.st[0] = nloc; b.st[1] = nx; }
        const unsigned old = xb_add(&bar[XB_XSUB(b.x)], 1u);
        const unsigned gen = old / nloc;
        if (old + 1u == (gen + 1u) * nloc) {
            __builtin_amdgcn_fence(__ATOMIC_RELEASE, "agent");
            asm volatile("s_waitcnt vmcnt(0)" ::: "memory");
            const unsigned og = xb_add(&bar[XB_TOP], 1u);
            const unsigned tg = og / nx;
            if (og + 1u == (tg + 1u) * nx) xb_add(&bar[XB_TOPGEN], 1u);
            else XB_SPIN(xb_ld(&bar[XB_TOPGEN]) == tg, bar);
            __builtin_amdgcn_fence(__ATOMIC_ACQUIRE, "agent");
            xb_add(&bar[XB_XGEN(b.x)], 1u);
            asm volatile("s_waitcnt vmcnt(0)" ::: "memory");
        } else {
            XB_SPIN(xb_ld(&bar[XB_XGEN(b.x)]) == gen, bar);
            __builtin_amdgcn_fence(__ATOMIC_ACQUIRE, "agent");
            asm volatile("s_waitcnt vmcnt(0)" ::: "memory");
        }
    }
    __syncthreads();
}

struct EpiZ {
    static constexpr bool PERM = true, AFTER_DRAIN = false;
    bf16_t* QKV; bf16_t* ZB; bf16_t* GATE; const float* b_gate; float* out;
    __device__ __forceinline__ void operator()(const f32x4 (&acc)[2][2][4][2], const Unit& u, int wr, int wc, int fr, int fq) const {
        const int pn = u.pn;
#pragma unroll
        for (int ai = 0; ai < 2; ++ai)
#pragma unroll
            for (int m = 0; m < 4; ++m) {
                const int row = u.pm * 256 + ai * 128 + wr * 64 + m * 16 + fr; const int b = row >> 11, t = row & 2047;
#pragma unroll
                for (int bj = 0; bj < 2; ++bj) {
                    const int col = pn * 256 + bj * 128 + wc * 32 + 8 * fq;
                    const f32x4 v0 = acc[ai][bj][m][0], v1 = acc[ai][bj][m][1];
                    if (pn < 9) {
                        store8bf(QKV + (size_t)row * QKVW + col, v0, v1);
                        if (col >= 768) {
                            const int kvsel = col >= 1536 ? 1 : 0; const int cc = col - 768 - kvsel * 768; const int head = cc >> 6, g = head >> 2, hs = head & 3, d = cc & 63;
                            const int rows_g = 128 << (2 * g); const int j = t - (T_ - rows_g);
                            if (j >= 0) { float* dst = out + (g == 0 ? O_KV128P : (g == 1 ? O_KV512P : O_KV2048P)) + ((size_t)(b * rows_g + j) * 2 + kvsel) * 256 + hs * 64 + d; *(f32x4*)dst = v0; *(f32x4*)(dst + 4) = v1; }
                        }
                    } else if (pn < 16) {
                        const int c = col - QKVW; store8bf(ZB + (size_t)row * ZBW + c, v0, v1);
                        if (t == T_ - 1) { float* dst = out + O_SHIFTP + (size_t)b * ZBW + c; *(f32x4*)dst = v0; *(f32x4*)(dst + 4) = v1; }
                    } else {
                        const int c = col - 4096; const f32x4 b0 = *(const f32x4*)(b_gate + c), b1 = *(const f32x4*)(b_gate + c + 4); f32x4 g0, g1;
#pragma unroll
                        for (int e = 0; e < 4; ++e) { g0[e] = sigm(v0[e] + b0[e]); g1[e] = sigm(v1[e] + b1[e]); }
                        store8bf(GATE + (size_t)row * GTW + c, g0, g1);
                    }
                }
            }
    }
};
struct EpiPA {
    static constexpr bool PERM = false, AFTER_DRAIN = false;
    const bf16_t* GATE; float* TMP;
    __device__ __forceinline__ void operator()(const f32x4 (&acc)[2][2][4][2], const Unit& u, int wr, int wc, int fr, int fq) const {
#pragma unroll
        for (int ai = 0; ai < 2; ++ai)
#pragma unroll
            for (int m = 0; m < 4; ++m) { const int row = u.pm * 256 + ai * 128 + wr * 64 + m * 16 + fr;
#pragma unroll
                for (int bj = 0; bj < 2; ++bj)
#pragma unroll
                    for (int n = 0; n < 2; ++n) { const int col = u.pn * 256 + bj * 128 + wc * 32 + 16 * n + 4 * fq;
                        const f32x4 ga = load4bf(GATE + (size_t)row * GTW + col); *(f32x4*)(TMP + (size_t)row * D_ + col) = ga * acc[ai][bj][m][n]; }
                asm volatile("" ::: "memory"); }
    }
};
struct EpiPB {
    static constexpr bool PERM = false, AFTER_DRAIN = false;
    const bf16_t* GATE; const float* TMP; bf16_t* MG;
    __device__ __forceinline__ void operator()(const f32x4 (&acc)[2][2][4][2], const Unit& u, int wr, int wc, int fr, int fq) const {
#pragma unroll
        for (int ai = 0; ai < 2; ++ai)
#pragma unroll
            for (int m = 0; m < 4; ++m) { const int row = u.pm * 256 + ai * 128 + wr * 64 + m * 16 + fr;
#pragma unroll
                for (int bj = 0; bj < 2; ++bj)
#pragma unroll
                    for (int n = 0; n < 2; ++n) { const int col = u.pn * 256 + bj * 128 + wc * 32 + 16 * n + 4 * fq;
                        const f32x4 gb = load4bf(GATE + (size_t)row * GTW + D_ + col); const f32x4 t = *(const f32x4*)(TMP + (size_t)row * D_ + col);
                        store4bf(MG + (size_t)row * D_ + col, t + gb * acc[ai][bj][m][n]); }
                asm volatile("" ::: "memory"); }
    }
};
template <bool WRITE_XG> struct EpiRes {
    static constexpr bool PERM = false, AFTER_DRAIN = false;
    const float* xin; float* xo; bf16_t* XG; const float* g; float* SS;
    __device__ __forceinline__ void operator()(const f32x4 (&acc)[2][2][4][2], const Unit& u, int wr, int wc, int fr, int fq) const {
#pragma unroll
        for (int ai = 0; ai < 2; ++ai)
#pragma unroll
            for (int m = 0; m < 4; ++m) { const int row = u.pm * 256 + ai * 128 + wr * 64 + m * 16 + fr; float ss = 0.f;
#pragma unroll
                for (int bj = 0; bj < 2; ++bj)
#pragma unroll
                    for (int n = 0; n < 2; ++n) { const int col = u.pn * 256 + bj * 128 + wc * 32 + 16 * n + 4 * fq;
                        const f32x4 x1 = *(const f32x4*)(xin + (size_t)row * D_ + col) + acc[ai][bj][m][n];
                        *(f32x4*)(xo + (size_t)row * D_ + col) = x1; ss += (x1[0] * x1[0] + x1[1] * x1[1]) + (x1[2] * x1[2] + x1[3] * x1[3]);
                        if (WRITE_XG) { const f32x4 gg = *(const f32x4*)(g + col); store4bf(XG + (size_t)row * D_ + col, x1 * gg); } }
                ss += __shfl_xor(ss, 16); ss += __shfl_xor(ss, 32);
                if (fq == 0) atomicAdd(SS + row, ss);
                asm volatile("" ::: "memory"); }
    }
};
struct EpiUp {
    static constexpr bool PERM = true, AFTER_DRAIN = false;
    const float* SS; bf16_t* U;
    __device__ __forceinline__ void operator()(const f32x4 (&acc)[2][2][4][2], const Unit& u, int wr, int wc, int fr, int fq) const {
#pragma unroll
        for (int ai = 0; ai < 2; ++ai)
#pragma unroll
            for (int m = 0; m < 4; ++m) { const int row = u.pm * 256 + ai * 128 + wr * 64 + m * 16 + fr; const float rs = rsqrtf(SS[row] * (1.f / D_) + NORM_EPS);
#pragma unroll
                for (int bj = 0; bj < 2; ++bj) { const int col = u.pn * 256 + bj * 128 + wc * 32 + 8 * fq; f32x4 v0 = acc[ai][bj][m][0] * rs, v1 = acc[ai][bj][m][1] * rs;
#pragma unroll
                    for (int e = 0; e < 4; ++e) { const float a = fmaxf(v0[e], 0.f), b = fmaxf(v1[e], 0.f); v0[e] = a * a; v1[e] = b * b; }
                    store8bf(U + (size_t)row * FF_ + col, v0, v1); } }
    }
};

struct SP { float* ZS; const float* b_gate; float* out; const float* xs; const float* g2; bf16_t* MGS; bf16_t* X1GS; bf16_t* US; float* SS1S; float* SS2S; };
template <int MODE> __device__ __forceinline__ void sample_gemm(LAS unsigned char* lds, const bf16_t* A1, int K1, const bf16_t* B1, const bf16_t* A2, int K2, const bf16_t* B2, int N, const SP p) {
    const int tid = threadIdx.x, wid = tid >> 6, lane = tid & 63, r = lane & 31, hh = lane >> 5;
    LAS float* P = (LAS float*)lds;
    for (int tile = blockIdx.x; tile < N / 32; tile += gridDim.x) {
        const int n0 = tile * 32;
        f32x16 acc1, acc2;
#pragma unroll
        for (int i = 0; i < 16; ++i) { acc1[i] = 0.f; acc2[i] = 0.f; }
        { const int kw = K1 / 8; const bf16_t* ap = A1 + (size_t)r * K1 + wid * kw + 8 * hh; const bf16_t* bp = B1 + (size_t)(n0 + r) * K1 + wid * kw + 8 * hh;
#pragma unroll 4
          for (int k = 0; k < kw; k += 16) { const bf16x8 a = *(const bf16x8*)(ap + k), b = *(const bf16x8*)(bp + k); acc1 = __builtin_amdgcn_mfma_f32_32x32x16_bf16(a, b, acc1, 0, 0, 0); } }
        if (K2 > 0) { const int kw = K2 / 8; const bf16_t* ap = A2 + (size_t)r * K2 + wid * kw + 8 * hh; const bf16_t* bp = B2 + (size_t)(n0 + r) * K2 + wid * kw + 8 * hh;
#pragma unroll 4
          for (int k = 0; k < kw; k += 16) { const bf16x8 a = *(const bf16x8*)(ap + k), b = *(const bf16x8*)(bp + k); acc2 = __builtin_amdgcn_mfma_f32_32x32x16_bf16(a, b, acc2, 0, 0, 0); } }
#pragma unroll
        for (int reg = 0; reg < 16; ++reg) { const int row = (reg & 3) + 8 * (reg >> 2) + 4 * hh; P[wid * 1024 + row * 32 + r] = acc1[reg]; if (K2 > 0) P[8192 + wid * 1024 + row * 32 + r] = acc2[reg]; }
        __syncthreads();
        const int row = tid >> 4, c2 = (tid & 15) * 2, col = n0 + c2;
        float s1a = 0.f, s1b = 0.f, s2a = 0.f, s2b = 0.f;
#pragma unroll
        for (int w = 0; w < 8; ++w) { s1a += P[w * 1024 + row * 32 + c2]; s1b += P[w * 1024 + row * 32 + c2 + 1]; if (K2 > 0) { s2a += P[8192 + w * 1024 + row * 32 + c2]; s2b += P[8192 + w * 1024 + row * 32 + c2 + 1]; } }
        if (MODE == 0) {
            p.ZS[(size_t)row * NIN_ + col] = s1a; p.ZS[(size_t)row * NIN_ + col + 1] = s1b;
            if (col >= 768 && col < QKVW) { const int kvsel = col >= 1536 ? 1 : 0; const int cc = col - 768 - kvsel * 768; const int head = cc >> 6, g = head >> 2, hs = head & 3, d = cc & 63;
                float* dst = p.out + (g == 0 ? O_KV128S : (g == 1 ? O_KV512S : O_KV2048S)) + ((size_t)row * 2 + kvsel) * 256 + hs * 64 + d; dst[0] = s1a; dst[1] = s1b; }
            else if (col >= QKVW && col < 4096) { float* dst = p.out + O_SHIFTS + (size_t)row * ZBW + (col - QKVW); dst[0] = s1a; dst[1] = s1b; }
        } else if (MODE == 1) {
            const float* zg = p.ZS + (size_t)row * NIN_ + 4096;
            const float ga0 = sigm(zg[col] + p.b_gate[col]), ga1 = sigm(zg[col + 1] + p.b_gate[col + 1]), gb0 = sigm(zg[D_ + col] + p.b_gate[D_ + col]), gb1 = sigm(zg[D_ + col + 1] + p.b_gate[D_ + col + 1]);
            *(unsigned*)(p.MGS + (size_t)row * D_ + col) = pk2(ga0 * s1a + gb0 * s2a, ga1 * s1b + gb1 * s2b);
        } else if (MODE == 2 || MODE == 4) {
            const float* xin = (MODE == 2) ? p.xs : (p.out + O_YS); float* xo = p.out + O_YS;
            const float x0 = xin[(size_t)row * D_ + col] + s1a, x1 = xin[(size_t)row * D_ + col + 1] + s1b;
            xo[(size_t)row * D_ + col] = x0; xo[(size_t)row * D_ + col + 1] = x1;
            if (MODE == 2) *(unsigned*)(p.X1GS + (size_t)row * D_ + col) = pk2(x0 * p.g2[col], x1 * p.g2[col + 1]);
            float ss = x0 * x0 + x1 * x1; ss = red16(ss);
            if ((tid & 15) == 0) atomicAdd((MODE == 2 ? p.SS1S : p.SS2S) + row, ss);
        } else if (MODE == 3) {
            const float rs = rsqrtf(p.SS1S[row] * (1.f / D_) + NORM_EPS); const float a = fmaxf(rs * s1a, 0.f), b = fmaxf(rs * s1b, 0.f);
            *(unsigned*)(p.US + (size_t)row * FF_ + col) = pk2(a * a, b * b);
        }
        __syncthreads();
    }
}

__device__ __forceinline__ void p0_transpose_item(const float* W, int K, int N, bf16_t* WT, LAS float* scr, int item, int lane) {
    const int nblk = N / 32, kb = item / nblk, nb = item % nblk, k0 = 64 * kb, n0 = 32 * nb;
#pragma unroll 8
    for (int i = 0; i < 32; ++i) { const int kk = 2 * i + (lane >> 5); scr[kk * 33 + (lane & 31)] = W[(size_t)(k0 + kk) * N + n0 + (lane & 31)]; }
    asm volatile("s_waitcnt lgkmcnt(0)" ::: "memory");
    const int c = lane & 7;
#pragma unroll
    for (int j = 0; j < 4; ++j) { const int n = (lane >> 3) + 8 * j; const LAS float* s = scr + (8 * c) * 33 + n;
        u32x4 o; o.x = pk2(s[0 * 33], s[1 * 33]); o.y = pk2(s[2 * 33], s[3 * 33]); o.z = pk2(s[4 * 33], s[5 * 33]); o.w = pk2(s[6 * 33], s[7 * 33]);
        *(u32x4*)(WT + (size_t)(n0 + n) * K + k0 + 8 * c) = o; }
    asm volatile("s_waitcnt lgkmcnt(0)" ::: "memory");
}
__device__ __forceinline__ void rms_row_to_bf16(const float* xrow, const float* g, bf16_t* orow, int lane) {
    f32x4 v[4]; float s = 0.f;
#pragma unroll
    for (int j = 0; j < 4; ++j) { v[j] = *((const f32x4*)xrow + lane + 64 * j); s += (v[j][0] * v[j][0] + v[j][1] * v[j][1]) + (v[j][2] * v[j][2] + v[j][3] * v[j][3]); }
    const float rs = rsqrtf(wave_sum(s) * (1.f / D_) + NORM_EPS);
#pragma unroll
    for (int j = 0; j < 4; ++j) { const f32x4 gg = *((const f32x4*)g + lane + 64 * j); store4bf(orow + 4 * (lane + 64 * j), v[j] * rs * gg); }
}

constexpr int AT_KS = 0, AT_VT = 36864, AT_PS = 72704;
__device__ __forceinline__ void attn_unit(LAS unsigned char* lds, int item, const bf16_t* QKV, bf16_t* OG, float* LSE) {
    const int tid = threadIdx.x, wid = tid >> 6, lane = tid & 63, fr = lane & 15, fq = lane >> 4;
    const int blk = item & 15, hs = (item >> 4) & 3, g = (item >> 6) % 3, b = item / 192;
    const int dsh = 2 * g, dil = 1 << dsh, nbk = 16 >> dsh, r = blk / nbk, n = blk % nbk, h = g * 4 + hs;
    const float slope = exp2f(-8.0f * (float)(h + 1) / 12.0f);
    const bf16_t* base = QKV + (size_t)b * T_ * QKVW;
    LAS unsigned char* Ks = lds + AT_KS; LAS unsigned char* Vt = lds + AT_VT; LAS unsigned char* Ps = lds + AT_PS + wid * (16 * 336);
#pragma unroll
    for (int i = 0; i < 4; ++i) { const int c = tid + 512 * i, row = c >> 3, part = c & 7; const int e = (n - 1) * 128 + row;
        u32x4 v = (u32x4){0u, 0u, 0u, 0u}; if (e >= 0) v = *(const u32x4*)(base + (size_t)((e << dsh) + r) * QKVW + 768 + h * 64 + part * 8);
        *(LAS u32x4*)(Ks + row * 144 + part * 16) = v; }
#pragma unroll
    for (int i = 0; i < 4; ++i) { const int key = tid & 255, part = (tid >> 8) + 2 * i; const int e = (n - 1) * 128 + key;
        u32x4 v = (u32x4){0u, 0u, 0u, 0u}; if (e >= 0) v = *(const u32x4*)(base + (size_t)((e << dsh) + r) * QKVW + 1536 + h * 64 + part * 8);
        LAS unsigned short* dst = (LAS unsigned short*)(Vt + (part * 8) * 560 + key * 2);
        dst[0 * 280] = (unsigned short)(v.x & 0xffff); dst[1 * 280] = (unsigned short)(v.x >> 16); dst[2 * 280] = (unsigned short)(v.y & 0xffff); dst[3 * 280] = (unsigned short)(v.y >> 16);
        dst[4 * 280] = (unsigned short)(v.z & 0xffff); dst[5 * 280] = (unsigned short)(v.z >> 16); dst[6 * 280] = (unsigned short)(v.w & 0xffff); dst[7 * 280] = (unsigned short)(v.w >> 16); }
    for (int idx = tid; idx < 64 * 12; idx += 512) { const int d = idx / 12, k2 = idx % 12; *(LAS unsigned*)(Vt + d * 560 + (256 + 2 * k2) * 2) = 0u; }
    const int qi = 16 * wid + fr; const int tq = ((n * 128 + qi) << dsh) + r;
    const bf16x8 qa0 = *(const bf16x8*)(base + (size_t)tq * QKVW + h * 64 + 8 * fq), qa1 = *(const bf16x8*)(base + (size_t)tq * QKVW + h * 64 + 32 + 8 * fq);
    __syncthreads();
    f32x4 s[10];
    float mx[4] = {-3.0e38f, -3.0e38f, -3.0e38f, -3.0e38f};
#pragma unroll
    for (int jt = 0; jt < 10; ++jt) {
        const int jtile = wid + jt; f32x4 a = (f32x4){0.f, 0.f, 0.f, 0.f};
        if (jtile < 16) {
            const bf16x8 k0 = *(const LAS bf16x8*)(Ks + (jtile * 16 + fr) * 144 + fq * 16), k1 = *(const LAS bf16x8*)(Ks + (jtile * 16 + fr) * 144 + 64 + fq * 16);
            a = __builtin_amdgcn_mfma_f32_16x16x32_bf16(qa0, k0, a, 0, 0, 0); a = __builtin_amdgcn_mfma_f32_16x16x32_bf16(qa1, k1, a, 0, 0, 0);
        }
        const int j = jtile * 16 + fr;
#pragma unroll
        for (int e = 0; e < 4; ++e) { const int i = 16 * wid + 4 * fq + e; const int delta = 128 + i - j;
            const bool valid = (jtile < 16) && (delta >= 0) && (delta <= 128) && (n > 0 || j >= 128);
            const float sc = valid ? (a[e] * 0.125f - slope * (float)(delta << dsh)) : -1.0e30f; a[e] = sc; mx[e] = fmaxf(mx[e], sc); }
        s[jt] = a;
    }
    float lsum[4];
#pragma unroll
    for (int e = 0; e < 4; ++e) { float m = mx[e]; m = fmaxf(m, __shfl_xor(m, 1)); m = fmaxf(m, __shfl_xor(m, 2)); m = fmaxf(m, __shfl_xor(m, 4)); m = fmaxf(m, __shfl_xor(m, 8)); mx[e] = m; lsum[e] = 0.f; }
#pragma unroll
    for (int jt = 0; jt < 10; ++jt)
#pragma unroll
        for (int e = 0; e < 4; ++e) { const float p = __expf(s[jt][e] - mx[e]); lsum[e] += p; *(LAS unsigned short*)(Ps + (4 * fq + e) * 336 + (jt * 16 + fr) * 2) = (unsigned short)f2bf(p); }
#pragma unroll
    for (int e = 0; e < 4; ++e) { float l = lsum[e]; l += __shfl_xor(l, 1); l += __shfl_xor(l, 2); l += __shfl_xor(l, 4); l += __shfl_xor(l, 8); lsum[e] = l; }
    asm volatile("s_waitcnt lgkmcnt(0)" ::: "memory");
    f32x4 o[4];
#pragma unroll
    for (int nt = 0; nt < 4; ++nt) o[nt] = (f32x4){0.f, 0.f, 0.f, 0.f};
#pragma unroll
    for (int ks = 0; ks < 5; ++ks) {
        const bf16x8 pa = *(const LAS bf16x8*)(Ps + fr * 336 + (32 * ks + 8 * fq) * 2);
#pragma unroll
        for (int nt = 0; nt < 4; ++nt) { const bf16x8 vb = *(const LAS bf16x8*)(Vt + (nt * 16 + fr) * 560 + (16 * wid + 32 * ks + 8 * fq) * 2); o[nt] = __builtin_amdgcn_mfma_f32_16x16x32_bf16(pa, vb, o[nt], 0, 0, 0); }
    }
#pragma unroll
    for (int e = 0; e < 4; ++e) { const int i = 16 * wid + 4 * fq + e; const int t = ((n * 128 + i) << dsh) + r; const size_t row = (size_t)b * T_ + t; const float inv = 1.f / lsum[e];
#pragma unroll
        for (int nt = 0; nt < 4; ++nt) OG[row * 768 + h * 64 + nt * 16 + fr] = (bf16_t)f2bf(o[nt][e] * inv);
        if (fr == 0) LSE[row * 12 + h] = mx[e] + __logf(lsum[e]); }
    __syncthreads();
}

__device__ __forceinline__ void sample_attn(LAS unsigned char* lds, int b, const float* ZS, const float* c128, const float* c512, const float* c2048, bf16_t* ATTS) {
    const int tid = threadIdx.x, wid = tid >> 6, lane = tid & 63;
    LAS float* qs = (LAS float*)lds;
    LAS float* sc = qs + 256;
    LAS float* og = sc + 4 * 132;
    LAS float* ls = og + 768;
    LAS float* lsm = ls + 12;
    const float* z = ZS + (size_t)b * NIN_;
    for (int g = 0; g < 3; ++g) {
        const int dsh = 2 * g, Lb = 128 << dsh; const float* cache = g == 0 ? c128 : (g == 1 ? c512 : c2048);
        const float* cb = cache + (size_t)b * Lb * 512;
        if (tid < 256) qs[tid] = z[g * 256 + tid];
        __syncthreads();
        { const int hs = tid >> 7, mi = tid & 127, m = mi + 1; const float slope = exp2f(-8.0f * (float)(g * 4 + hs + 1) / 12.0f);
          const float* kr = cb + (size_t)(Lb - (m << dsh)) * 512 + hs * 64; float d = 0.f;
#pragma unroll
          for (int i = 0; i < 16; ++i) { const f32x4 kv = *(const f32x4*)(kr + 4 * i); const f32x4 qv = *(const LAS f32x4*)(qs + hs * 64 + 4 * i); d += (kv[0] * qv[0] + kv[1] * qv[1]) + (kv[2] * qv[2] + kv[3] * qv[3]); }
          sc[hs * 132 + m] = d * 0.125f - slope * (float)(m << dsh);
          if (mi == 0) { const float* kn = z + 768 + (g * 4 + hs) * 64; float d0 = 0.f; for (int i = 0; i < 64; ++i) d0 += kn[i] * qs[hs * 64 + i]; sc[hs * 132] = d0 * 0.125f; } }
        __syncthreads();
        if (wid < 4) { const int hs = wid; float v0 = sc[hs * 132 + lane], v1 = sc[hs * 132 + 64 + lane], v2 = lane == 0 ? sc[hs * 132 + 128] : -3.0e38f;
            const float mxx = wave_max(fmaxf(fmaxf(v0, v1), v2)); const float p0 = __expf(v0 - mxx), p1 = __expf(v1 - mxx), p2 = lane == 0 ? __expf(v2 - mxx) : 0.f;
            const float l = wave_sum(p0 + p1 + p2); sc[hs * 132 + lane] = p0; sc[hs * 132 + 64 + lane] = p1; if (lane == 0) { sc[hs * 132 + 128] = p2; ls[g * 4 + hs] = mxx + __logf(l); lsm[hs] = l; } }
        __syncthreads();
        { const int hs = tid >> 7, d = (tid >> 1) & 63, half = tid & 1; float acc = 0.f;
          const int m0 = half ? 65 : 0, m1 = half ? 129 : 65;
          for (int m = m0; m < m1; ++m) { const float vv = (m == 0) ? z[1536 + (g * 4 + hs) * 64 + d] : cb[(size_t)(Lb - (m << dsh)) * 512 + 256 + hs * 64 + d]; acc += sc[hs * 132 + m] * vv; }
          acc += __shfl_xor(acc, 1);
          if (half == 0) og[(g * 4 + hs) * 64 + d] = acc / lsm[hs]; }
        __syncthreads();
    }
    if (tid < 256) { const int hs = tid >> 6, d = tid & 63; const float l0 = ls[hs], l1 = ls[4 + hs], l2 = ls[8 + hs]; const float mm = fmaxf(l0, fmaxf(l1, l2));
        const float w0 = __expf(l0 - mm), w1 = __expf(l1 - mm), w2 = __expf(l2 - mm); const float inv = 1.f / (w0 + w1 + w2);
        ATTS[(size_t)b * 256 + tid] = (bf16_t)f2bf((w0 * og[hs * 64 + d] + w1 * og[(4 + hs) * 64 + d] + w2 * og[(8 + hs) * 64 + d]) * inv); }
    __syncthreads();
}

struct RwW { const float *mu, *w0, *a0, *k_k, *k_a, *r_k, *gn_g, *gn_b, *wl, *al, *gl; };
__device__ __forceinline__ float decay_of(float w0c, float wl) { const float x = -(w0c + wl); const float sp = fmaxf(x, 0.f) + log1pf(__expf(-fabsf(x))); return __expf(-__expf(-sp - 0.5f)); }

__device__ __forceinline__ void sample_rwkv(LAS unsigned char* lds, int item, const float* ZS, const float* state_wkv, const float* state_shift, const RwW w, float* out, bf16_t* RWS) {
    const int tid = threadIdx.x, wid = tid >> 6, lane = tid & 63; const int b = item >> 3, h = item & 7;
    LAS float* xr = (LAS float*)lds; LAS float* xk = xr + 64; LAS float* xv = xk + 64; LAS float* lw = xv + 64; LAS float* la = lw + 64; LAS float* lg = la + 64;
    LAS float* pw = lg + 128; LAS float* pa = pw + 64; LAS float* pg = pa + 64;
    LAS float* sR = pg + 64; LAS float* sW = sR + 64; LAS float* sK = sW + 64; LAS float* sV = sK + 64; LAS float* sA = sV + 64; LAS float* sB = sA + 64; LAS float* sG = sB + 64; LAS float* sY = sG + 64; LAS float* sC = sY + 64;
    const float* zb = ZS + (size_t)b * NIN_ + QKVW; const float* pv = state_shift + (size_t)b * ZBW;
    if (tid < 448) { int col; if (tid < 192) col = (tid >> 6) * 512 + h * 64 + (tid & 63); else col = 1536 + (tid - 192);
        const float cur = zb[col], prv = pv[col]; const float mx = cur + (prv - cur) * w.mu[col];
        if (tid < 64) xr[tid] = mx; else if (tid < 128) xk[tid - 64] = mx; else if (tid < 192) xv[tid - 128] = mx; else if (tid < 256) lw[tid - 192] = tanhf(mx); else if (tid < 320) la[tid - 256] = mx; else lg[tid - 320] = sigm(mx); }
    __syncthreads();
    if (tid < 192) { const int which = tid >> 6, nn = tid & 63, c = h * 64 + nn; float acc = 0.f;
        if (which == 0) { for (int j = 0; j < 64; ++j) acc += lw[j] * w.wl[j * 512 + c]; pw[nn] = acc; }
        else if (which == 1) { for (int j = 0; j < 64; ++j) acc += la[j] * w.al[j * 512 + c]; pa[nn] = acc; }
        else { for (int j = 0; j < 128; ++j) acc += lg[j] * w.gl[j * 512 + c]; pg[nn] = acc; } }
    __syncthreads();
    if (wid == 0) { const int c = h * 64 + lane; const float r = xr[lane], k = xk[lane], v = xv[lane];
        const float dec = decay_of(w.w0[c], pw[lane]); const float a = sigm(w.a0[c] + pa[lane]);
        const float kkr = k * w.k_k[c]; const float nrm = fmaxf(sqrtf(wave_sum(kkr * kkr)), 1e-12f); const float kk = kkr / nrm;
        const float kp = k * (1.f + (a - 1.f) * w.k_a[c]); const float cs = wave_sum(r * kp * w.r_k[c]);
        sR[lane] = r; sW[lane] = dec; sK[lane] = kp; sV[lane] = v; sA[lane] = -kk; sB[lane] = kk * a; sG[lane] = pg[lane]; if (lane == 0) sC[0] = cs; }
    __syncthreads();
    { const int row = tid >> 3, kq = tid & 7; const float* S0 = state_wkv + ((size_t)(b * 8 + h) * 64 + row) * 64 + 8 * kq; float s[8];
      const f32x4 s0 = *(const f32x4*)S0, s1 = *(const f32x4*)(S0 + 4); s[0] = s0[0]; s[1] = s0[1]; s[2] = s0[2]; s[3] = s0[3]; s[4] = s1[0]; s[5] = s1[1]; s[6] = s1[2]; s[7] = s1[3];
      float dot = 0.f;
#pragma unroll
      for (int i = 0; i < 8; ++i) dot += s[i] * sA[8 * kq + i];
      const float sa = red8(dot); const float vv = sV[row]; float yp = 0.f;
#pragma unroll
      for (int i = 0; i < 8; ++i) { s[i] = s[i] * sW[8 * kq + i] + sa * sB[8 * kq + i] + vv * sK[8 * kq + i]; yp += s[i] * sR[8 * kq + i]; }
      const float y = red8(yp); float* So = out + O_WKVS + ((size_t)(b * 8 + h) * 64 + row) * 64 + 8 * kq;
      *(f32x4*)So = (f32x4){s[0], s[1], s[2], s[3]}; *(f32x4*)(So + 4) = (f32x4){s[4], s[5], s[6], s[7]};
      if (kq == 0) sY[row] = y; }
    __syncthreads();
    if (wid == 0) { const int c = h * 64 + lane; const float y = sY[lane]; const float mu = wave_sum(y) * (1.f / 64.f); const float dv = y - mu; const float var = wave_sum(dv * dv) * (1.f / 64.f);
        const float yn = dv * rsqrtf(var + GN_EPS) * w.gn_g[c] + w.gn_b[c]; RWS[(size_t)b * 512 + c] = (bf16_t)f2bf((yn + sC[0] * sV[lane]) * sG[lane]); }
    __syncthreads();
}

constexpr int RC_P = 0, RC_P2 = 2048, RC_Q = 4096, RC_Q2 = 5120, RC_BK = 6144, RC_VT = 10240, RC_DC = 12288, RC_BYTES = 12544;
constexpr int PS = 68;
constexpr int PR_XR = 0, PR_XK = 8704, PR_XV = 17408, PR_PW = 26112, PR_PA = 34816, PR_PG = 43520, PR_LW = 52224, PR_LA = 56832, PR_LG = 61440, PR_GM = 70144, PR_TM = 80384, PR_PP = 82944, PR_QQ = 91648;
__device__ __forceinline__ void prep_item(LAS unsigned char* lds, int item, const bf16_t* ZB, const RwW w, const bf16_t* WlT, const bf16_t* AlT, const bf16_t* GlT, float* G, float* BON, unsigned char* REC) {
    const int tid = threadIdx.x, wid = tid >> 6, lane = tid & 63, fr = lane & 15, fq = lane >> 4;
    const int bh = item >> 6, c32 = item & 63, b = bh >> 3, h = bh & 7, t0 = c32 * 32;
    LAS float* XR = (LAS float*)(lds + PR_XR); LAS float* XK = (LAS float*)(lds + PR_XK); LAS float* XV = (LAS float*)(lds + PR_XV);
    LAS float* PW = (LAS float*)(lds + PR_PW); LAS float* PA = (LAS float*)(lds + PR_PA); LAS float* PG = (LAS float*)(lds + PR_PG);
    LAS unsigned char* LW = lds + PR_LW; LAS unsigned char* LA = lds + PR_LA; LAS unsigned char* LG = lds + PR_LG;
    LAS float* GM = (LAS float*)(lds + PR_GM); LAS float* TM = (LAS float*)(lds + PR_TM); LAS float* PP = (LAS float*)(lds + PR_PP); LAS float* QQ = (LAS float*)(lds + PR_QQ);
    const int ttile = wid >> 2, ntile = wid & 3; const int ncol = h * 64 + ntile * 16 + fr;
    const int tt = tid >> 4, q = tid & 15, c0 = h * 64 + 4 * q;
    { const int t = t0 + tt; const bf16_t* cur = ZB + ((size_t)b * T_ + t) * ZBW; const bf16_t* prv = cur - ZBW; const bool hp = t > 0;
      const f32x4 z4 = (f32x4){0.f, 0.f, 0.f, 0.f};
      f32x4 cr = load4bf(cur + c0), ck = load4bf(cur + 512 + c0), cv = load4bf(cur + 1024 + c0), cw = load4bf(cur + 1536 + 4 * q), ca = load4bf(cur + 1600 + 4 * q), cg0 = load4bf(cur + 1664 + 8 * q), cg1 = load4bf(cur + 1668 + 8 * q);
      f32x4 pr = hp ? load4bf(prv + c0) : z4, pk = hp ? load4bf(prv + 512 + c0) : z4, pv = hp ? load4bf(prv + 1024 + c0) : z4, pw = hp ? load4bf(prv + 1536 + 4 * q) : z4, pa = hp ? load4bf(prv + 1600 + 4 * q) : z4,
            pg0 = hp ? load4bf(prv + 1664 + 8 * q) : z4, pg1 = hp ? load4bf(prv + 1668 + 8 * q) : z4;
      const f32x4 mu_r = *(const f32x4*)(w.mu + c0), mu_k = *(const f32x4*)(w.mu + 512 + c0), mu_v = *(const f32x4*)(w.mu + 1024 + c0);
      const f32x4 mu_w = *(const f32x4*)(w.mu + 1536 + 4 * q), mu_a = *(const f32x4*)(w.mu + 1600 + 4 * q), mu_g0 = *(const f32x4*)(w.mu + 1664 + 8 * q), mu_g1 = *(const f32x4*)(w.mu + 1668 + 8 * q);
      cr = cr + (pr - cr) * mu_r; ck = ck + (pk - ck) * mu_k; cv = cv + (pv - cv) * mu_v; cw = cw + (pw - cw) * mu_w; ca = ca + (pa - ca) * mu_a; cg0 = cg0 + (pg0 - cg0) * mu_g0; cg1 = cg1 + (pg1 - cg1) * mu_g1;
      *(LAS f32x4*)(XR + tt * PS + 4 * q) = cr; *(LAS f32x4*)(XK + tt * PS + 4 * q) = ck; *(LAS f32x4*)(XV + tt * PS + 4 * q) = cv;
      u32x2 o; o.x = pk2(tanhf(cw[0]), tanhf(cw[1])); o.y = pk2(tanhf(cw[2]), tanhf(cw[3])); *(LAS u32x2*)(LW + tt * 144 + 8 * q) = o;
      o.x = pk2(ca[0], ca[1]); o.y = pk2(ca[2], ca[3]); *(LAS u32x2*)(LA + tt * 144 + 8 * q) = o;
      u32x4 o4; o4.x = pk2(sigm(cg0[0]), sigm(cg0[1])); o4.y = pk2(sigm(cg0[2]), sigm(cg0[3])); o4.z = pk2(sigm(cg1[0]), sigm(cg1[1])); o4.w = pk2(sigm(cg1[2]), sigm(cg1[3])); *(LAS u32x4*)(LG + tt * 272 + 16 * q) = o4; }
    __syncthreads();
    { f32x4 wl = (f32x4){0.f, 0.f, 0.f, 0.f}, al = wl, gl = wl;
#pragma unroll
      for (int ks = 0; ks < 2; ++ks) { const bf16x8 aw = *(const LAS bf16x8*)(LW + (ttile * 16 + fr) * 144 + 64 * ks + 16 * fq), aa = *(const LAS bf16x8*)(LA + (ttile * 16 + fr) * 144 + 64 * ks + 16 * fq);
          const bf16x8 bw = *(const bf16x8*)(WlT + (size_t)ncol * 64 + 32 * ks + 8 * fq), ba = *(const bf16x8*)(AlT + (size_t)ncol * 64 + 32 * ks + 8 * fq);
          wl = __builtin_amdgcn_mfma_f32_16x16x32_bf16(aw, bw, wl, 0, 0, 0); al = __builtin_amdgcn_mfma_f32_16x16x32_bf16(aa, ba, al, 0, 0, 0); }
#pragma unroll
      for (int ks = 0; ks < 4; ++ks) { const bf16x8 ag = *(const LAS bf16x8*)(LG + (ttile * 16 + fr) * 272 + 64 * ks + 16 * fq); const bf16x8 bg = *(const bf16x8*)(GlT + (size_t)ncol * 128 + 32 * ks + 8 * fq);
          gl = __builtin_amdgcn_mfma_f32_16x16x32_bf16(ag, bg, gl, 0, 0, 0); }
#pragma unroll
      for (int e = 0; e < 4; ++e) { const int tr = ttile * 16 + 4 * fq + e, nc = ntile * 16 + fr; PW[tr * PS + nc] = wl[e]; PA[tr * PS + nc] = al[e]; PG[tr * PS + nc] = gl[e]; } }
    __syncthreads();
    { const f32x4 c_w0 = *(const f32x4*)(w.w0 + c0), c_a0 = *(const f32x4*)(w.a0 + c0), c_kk = *(const f32x4*)(w.k_k + c0), c_ka = *(const f32x4*)(w.k_a + c0), c_rk = *(const f32x4*)(w.r_k + c0);
      const f32x4 wl = *(LAS f32x4*)(PW + tt * PS + 4 * q), al = *(LAS f32x4*)(PA + tt * PS + 4 * q), gl = *(LAS f32x4*)(PG + tt * PS + 4 * q);
      const f32x4 r4 = *(LAS f32x4*)(XR + tt * PS + 4 * q), k4 = *(LAS f32x4*)(XK + tt * PS + 4 * q), v4 = *(LAS f32x4*)(XV + tt * PS + 4 * q);
      f32x4 dec, a4, kkr, kp; float ssq = 0.f, cs = 0.f;
#pragma unroll
      for (int e = 0; e < 4; ++e) { dec[e] = decay_of(c_w0[e], wl[e]); a4[e] = sigm(c_a0[e] + al[e]); kkr[e] = k4[e] * c_kk[e]; ssq += kkr[e] * kkr[e]; kp[e] = k4[e] * (1.f + (a4[e] - 1.f) * c_ka[e]); cs += r4[e] * kp[e] * c_rk[e]; }
      ssq = red16(ssq); cs = red16(cs); const float inv = 1.f / fmaxf(sqrtf(ssq), 1e-12f);
      const f32x4 kk = kkr * inv;
      *(LAS f32x4*)(PW + tt * PS + 4 * q) = dec; *(LAS f32x4*)(PA + tt * PS + 4 * q) = -kk; *(LAS f32x4*)(PG + tt * PS + 4 * q) = kk * a4; *(LAS f32x4*)(XK + tt * PS + 4 * q) = kp;
      const size_t off = ((size_t)b * T_ + t0 + tt) * 512 + c0; *(f32x4*)(G + off) = gl; *(f32x4*)(BON + off) = v4 * cs; }
    __syncthreads();
    unsigned char* rec0 = REC + (size_t)(bh * 128 + c32 * 2) * RC_BYTES;
    if (tid < 128) { const int s = tid >> 6, k = tid & 63; float Dc = 1.f;
#pragma unroll
        for (int t = 0; t < 16; ++t) { const int o = (s * 16 + t) * PS + k; const float wv = PW[o], av = PA[o], bv = PG[o], kv = XK[o], rv = XR[o];
            PA[o] = av * Dc; Dc *= wv; const float inv = 1.f / Dc; PG[o] = bv * inv; XK[o] = kv * inv; XR[o] = rv * Dc; }
        *(float*)(rec0 + (size_t)s * RC_BYTES + RC_DC + 4 * k) = Dc; }
    __syncthreads();
    const int s = wid >> 2;
    unsigned char* rec = rec0 + (size_t)s * RC_BYTES;
    { const int which = wid & 3; const LAS float* X = (which < 2) ? PA : XR; const LAS float* Yv = (which & 1) ? XK : PG;
      f32x4 acc = (f32x4){0.f, 0.f, 0.f, 0.f};
#pragma unroll
      for (int m = 0; m < 4; ++m) { const f32x4 xa = *(const LAS f32x4*)(X + (s * 16 + fr) * PS + 16 * m + 4 * fq), yb = *(const LAS f32x4*)(Yv + (s * 16 + fr) * PS + 16 * m + 4 * fq);
#pragma unroll
          for (int j = 0; j < 4; ++j) acc = __builtin_amdgcn_mfma_f32_16x16x4f32(xa[j], yb[j], acc, 0, 0, 0); }
#pragma unroll
      for (int e = 0; e < 4; ++e) { const int t = 4 * fq + e; const bool keep = (which < 2) ? (fr < t) : (fr <= t); GM[((s * 4 + which) * 16 + t) * 20 + fr] = keep ? acc[e] : 0.f; } }
    __syncthreads();
    if (wid == 0 && lane < 32) { const int ss = lane >> 4, j = lane & 15; float x[16];
#pragma unroll
        for (int t = 0; t < 16; ++t) { float sum = (t == j) ? 1.f : 0.f; const LAS float* Lr = GM + ((ss * 4 + 0) * 16 + t) * 20;
#pragma unroll
            for (int i = 0; i < t; ++i) sum += Lr[i] * x[i];
            x[t] = sum; TM[(ss * 16 + t) * 20 + j] = sum; } }
    __syncthreads();
    { const f32x4 ta = *(const LAS f32x4*)(TM + (s * 16 + fr) * 20 + 4 * fq); f32x4 acc = (f32x4){0.f, 0.f, 0.f, 0.f};
#pragma unroll
      for (int j = 0; j < 4; ++j) acc = __builtin_amdgcn_mfma_f32_16x16x4f32(ta[j], PA[(s * 16 + 4 * fq + j) * PS + ntile * 16 + fr], acc, 0, 0, 0);
#pragma unroll
      for (int e = 0; e < 4; ++e) { const int t = 4 * fq + e, k = ntile * 16 + fr; PP[(s * 16 + t) * PS + k] = acc[e];
          *(bf16_t*)(rec + RC_P + t * 128 + ((((k >> 3) ^ ((t >> 1) & 7))) << 4) + (k & 7) * 2) = (bf16_t)f2bf(acc[e]); }
      if (ntile == 0) { f32x4 aq = (f32x4){0.f, 0.f, 0.f, 0.f};
#pragma unroll
          for (int j = 0; j < 4; ++j) aq = __builtin_amdgcn_mfma_f32_16x16x4f32(ta[j], GM[((s * 4 + 1) * 16 + 4 * fq + j) * 20 + fr], aq, 0, 0, 0);
#pragma unroll
          for (int e = 0; e < 4; ++e) { const int t = 4 * fq + e; QQ[(s * 16 + t) * 20 + fr] = aq[e];
              *(bf16_t*)(rec + RC_Q + t * 64 + ((((fr >> 3)) ^ ((t >> 2) & 3)) << 4) + (fr & 7) * 2) = (bf16_t)f2bf(aq[e]);
              *(bf16_t*)(rec + RC_Q + t * 64 + (((2 + (fr >> 3)) ^ ((t >> 2) & 3)) << 4) + (fr & 7) * 2) = (bf16_t)0; } } }
    __syncthreads();
    { const f32x4 ma = *(const LAS f32x4*)(GM + ((s * 4 + 2) * 16 + fr) * 20 + 4 * fq); f32x4 acc;
#pragma unroll
      for (int e = 0; e < 4; ++e) acc[e] = XR[(s * 16 + 4 * fq + e) * PS + ntile * 16 + fr];
#pragma unroll
      for (int j = 0; j < 4; ++j) acc = __builtin_amdgcn_mfma_f32_16x16x4f32(ma[j], PP[(s * 16 + 4 * fq + j) * PS + ntile * 16 + fr], acc, 0, 0, 0);
#pragma unroll
      for (int e = 0; e < 4; ++e) { const int t = 4 * fq + e, k = ntile * 16 + fr; *(bf16_t*)(rec + RC_P2 + t * 128 + ((((k >> 3) ^ ((t >> 1) & 7))) << 4) + (k & 7) * 2) = (bf16_t)f2bf(acc[e]); }
      if (ntile == 0) { f32x4 aq;
#pragma unroll
          for (int e = 0; e < 4; ++e) aq[e] = GM[((s * 4 + 3) * 16 + 4 * fq + e) * 20 + fr];
#pragma unroll
          for (int j = 0; j < 4; ++j) aq = __builtin_amdgcn_mfma_f32_16x16x4f32(ma[j], QQ[(s * 16 + 4 * fq + j) * 20 + fr], aq, 0, 0, 0);
#pragma unroll
          for (int e = 0; e < 4; ++e) { const int t = 4 * fq + e;
              *(bf16_t*)(rec + RC_Q2 + t * 64 + ((((fr >> 3)) ^ ((t >> 2) & 3)) << 4) + (fr & 7) * 2) = (bf16_t)f2bf(aq[e]);
              *(bf16_t*)(rec + RC_Q2 + t * 64 + (((2 + (fr >> 3)) ^ ((t >> 2) & 3)) << 4) + (fr & 7) * 2) = (bf16_t)0; } } }
    if (tid < 256) { const int ss = tid >> 7, k = (tid >> 1) & 63, half = tid & 1; const LAS float* src = half ? XK : PG; unsigned char* rr = rec0 + (size_t)ss * RC_BYTES + RC_BK + k * 64;
#pragma unroll
        for (int c = 0; c < 2; ++c) { u32x4 o; const LAS float* p = src + (ss * 16 + 8 * c) * PS + k;
            o.x = pk2(p[0], p[PS]); o.y = pk2(p[2 * PS], p[3 * PS]); o.z = pk2(p[4 * PS], p[5 * PS]); o.w = pk2(p[6 * PS], p[7 * PS]);
            *(u32x4*)(rr + (((half * 2 + c) ^ ((k >> 2) & 3)) << 4)) = o; } }
    else if (tid < 384) { const int ss = (tid - 256) >> 6, v = tid & 63; unsigned char* rr = rec0 + (size_t)ss * RC_BYTES + RC_VT + v * 32;
#pragma unroll
        for (int c = 0; c < 2; ++c) { u32x4 o; const LAS float* p = XV + (ss * 16 + 8 * c) * PS + v;
            o.x = pk2(p[0], p[PS]); o.y = pk2(p[2 * PS], p[3 * PS]); o.z = pk2(p[4 * PS], p[5 * PS]); o.w = pk2(p[6 * PS], p[7 * PS]);
            *(u32x4*)(rr + c * 16) = o; } }
    __syncthreads();
}

struct Ops { bf16x8 P0, P1, P20, P21, Q, Q2, VT, BK0, BK1, BK2, BK3; f32x4 DC0, DC1, DC2, DC3; };
__device__ __forceinline__ void load_ops(Ops& o, const unsigned char* rec, int fr, int fq, int v0) {
    const int sw8 = (fr >> 1) & 7, sw4 = (fr >> 2) & 3;
    o.P0 = *(const bf16x8*)(rec + RC_P + fr * 128 + ((fq ^ sw8) << 4)); o.P1 = *(const bf16x8*)(rec + RC_P + fr * 128 + (((4 + fq) ^ sw8) << 4));
    o.P20 = *(const bf16x8*)(rec + RC_P2 + fr * 128 + ((fq ^ sw8) << 4)); o.P21 = *(const bf16x8*)(rec + RC_P2 + fr * 128 + (((4 + fq) ^ sw8) << 4));
    o.Q = *(const bf16x8*)(rec + RC_Q + fr * 64 + ((fq ^ sw4) << 4)); o.Q2 = *(const bf16x8*)(rec + RC_Q2 + fr * 64 + ((fq ^ sw4) << 4));
    o.VT = *(const bf16x8*)(rec + RC_VT + (v0 + fr) * 32 + (fq & 1) * 16);
    o.BK0 = *(const bf16x8*)(rec + RC_BK + (fr) * 64 + ((fq ^ sw4) << 4)); o.BK1 = *(const bf16x8*)(rec + RC_BK + (16 + fr) * 64 + ((fq ^ sw4) << 4));
    o.BK2 = *(const bf16x8*)(rec + RC_BK + (32 + fr) * 64 + ((fq ^ sw4) << 4)); o.BK3 = *(const bf16x8*)(rec + RC_BK + (48 + fr) * 64 + ((fq ^ sw4) << 4));
    o.DC0 = *(const f32x4*)(rec + RC_DC + (4 * fq) * 4); o.DC1 = *(const f32x4*)(rec + RC_DC + (16 + 4 * fq) * 4); o.DC2 = *(const f32x4*)(rec + RC_DC + (32 + 4 * fq) * 4); o.DC3 = *(const f32x4*)(rec + RC_DC + (48 + 4 * fq) * 4);
}
__device__ __forceinline__ void hilo_store(LAS unsigned char* Shi, LAS unsigned char* Slo, int fr, int fq, int mt, f32x4 sv) {
    u32x2 hi, lo; hi.x = pk2(sv[0], sv[1]); hi.y = pk2(sv[2], sv[3]);
    const float r0 = sv[0] - __builtin_bit_cast(float, hi.x << 16), r1 = sv[1] - __builtin_bit_cast(float, hi.x & 0xffff0000u), r2 = sv[2] - __builtin_bit_cast(float, hi.y << 16), r3 = sv[3] - __builtin_bit_cast(float, hi.y & 0xffff0000u);
    lo.x = pk2(r0, r1); lo.y = pk2(r2, r3);
    *(LAS u32x2*)(Shi + fr * 144 + (16 * mt + 4 * fq) * 2) = hi; *(LAS u32x2*)(Slo + fr * 144 + (16 * mt + 4 * fq) * 2) = lo;
}
__device__ __forceinline__ void seq_step(const Ops& o, f32x4 (&st)[4], LAS unsigned char* Shi, LAS unsigned char* Slo, LAS unsigned char* Ul, int fr, int fq, float* yrow) {
    hilo_store(Shi, Slo, fr, fq, 0, st[0]); hilo_store(Shi, Slo, fr, fq, 1, st[1]); hilo_store(Shi, Slo, fr, fq, 2, st[2]); hilo_store(Shi, Slo, fr, fq, 3, st[3]);
    asm volatile("s_waitcnt lgkmcnt(0)" ::: "memory");
    const bf16x8 sh0 = *(const LAS bf16x8*)(Shi + fr * 144 + 16 * fq), sh1 = *(const LAS bf16x8*)(Shi + fr * 144 + 64 + 16 * fq), sl0 = *(const LAS bf16x8*)(Slo + fr * 144 + 16 * fq), sl1 = *(const LAS bf16x8*)(Slo + fr * 144 + 64 + 16 * fq);
    const bf16x8 zero8 = (bf16x8){0, 0, 0, 0, 0, 0, 0, 0}; const bf16x8 vq = (fq < 2) ? o.VT : zero8;
    f32x4 ut = (f32x4){0.f, 0.f, 0.f, 0.f}, yt = ut;
    ut = __builtin_amdgcn_mfma_f32_16x16x32_bf16(o.P0, sh0, ut, 0, 0, 0); yt = __builtin_amdgcn_mfma_f32_16x16x32_bf16(o.P20, sh0, yt, 0, 0, 0);
    ut = __builtin_amdgcn_mfma_f32_16x16x32_bf16(o.P1, sh1, ut, 0, 0, 0); yt = __builtin_amdgcn_mfma_f32_16x16x32_bf16(o.P21, sh1, yt, 0, 0, 0);
    ut = __builtin_amdgcn_mfma_f32_16x16x32_bf16(o.P0, sl0, ut, 0, 0, 0); yt = __builtin_amdgcn_mfma_f32_16x16x32_bf16(o.P20, sl0, yt, 0, 0, 0);
    ut = __builtin_amdgcn_mfma_f32_16x16x32_bf16(o.P1, sl1, ut, 0, 0, 0); yt = __builtin_amdgcn_mfma_f32_16x16x32_bf16(o.P21, sl1, yt, 0, 0, 0);
    ut = __builtin_amdgcn_mfma_f32_16x16x32_bf16(o.Q, vq, ut, 0, 0, 0); yt = __builtin_amdgcn_mfma_f32_16x16x32_bf16(o.Q2, vq, yt, 0, 0, 0);
    { u32x2 uu; uu.x = pk2(ut[0], ut[1]); uu.y = pk2(ut[2], ut[3]); *(LAS u32x2*)(Ul + fr * 48 + 8 * fq) = uu; }
#pragma unroll
    for (int e = 0; e < 4; ++e) yrow[(size_t)(4 * fq + e) * 512] = yt[e];
    asm volatile("s_waitcnt lgkmcnt(0)" ::: "memory");
    const bf16x8 uf = *(const LAS bf16x8*)(Ul + fr * 48 + 16 * (fq & 1)); const bf16x8 uv = (fq < 2) ? uf : o.VT;
    st[0] = __builtin_amdgcn_mfma_f32_16x16x32_bf16(o.BK0, uv, st[0], 0, 0, 0); st[1] = __builtin_amdgcn_mfma_f32_16x16x32_bf16(o.BK1, uv, st[1], 0, 0, 0);
    st[2] = __builtin_amdgcn_mfma_f32_16x16x32_bf16(o.BK2, uv, st[2], 0, 0, 0); st[3] = __builtin_amdgcn_mfma_f32_16x16x32_bf16(o.BK3, uv, st[3], 0, 0, 0);
    st[0] = st[0] * o.DC0; st[1] = st[1] * o.DC1; st[2] = st[2] * o.DC2; st[3] = st[3] * o.DC3;
}
__device__ __forceinline__ void seq_unit(LAS unsigned char* lds, int bh, int wv, const unsigned char* REC, float* Y, float* out) {
    const int lane = threadIdx.x & 63, fr = lane & 15, fq = lane >> 4, v0 = wv * 16, b = bh >> 3, h = bh & 7;
    LAS unsigned char* Shi = lds + wv * 5376; LAS unsigned char* Slo = Shi + 2304; LAS unsigned char* Ul = Slo + 2304;
    f32x4 st[4];
#pragma unroll
    for (int i = 0; i < 4; ++i) st[i] = (f32x4){0.f, 0.f, 0.f, 0.f};
    const unsigned char* rec = REC + (size_t)bh * 128 * RC_BYTES;
    float* ybase = Y + (size_t)b * T_ * 512 + h * 64 + v0 + fr;
    Ops A, B; load_ops(A, rec, fr, fq, v0);
    for (int c = 0; c < 128; c += 2) {
        load_ops(B, rec + (size_t)(c + 1) * RC_BYTES, fr, fq, v0);
        seq_step(A, st, Shi, Slo, Ul, fr, fq, ybase + (size_t)(c * 16) * 512);
        if (c + 2 < 128) load_ops(A, rec + (size_t)(c + 2) * RC_BYTES, fr, fq, v0);
        seq_step(B, st, Shi, Slo, Ul, fr, fq, ybase + (size_t)((c + 1) * 16) * 512);
    }
#pragma unroll
    for (int mt = 0; mt < 4; ++mt) *(f32x4*)(out + O_WKVP + ((size_t)(b * 8 + h) * 64 + v0 + fr) * 64 + 16 * mt + 4 * fq) = st[mt];
}

struct Args { const float* in[28]; float* out; unsigned char* ws; int ph_lo, ph_hi; };
constexpr int N_PH = 10;

__global__ void __launch_bounds__(512, 2) fwd_kernel(Args args) {
    extern __shared__ __attribute__((aligned(16))) unsigned char lds_raw[];
    LAS unsigned char* lds = (LAS unsigned char*)lds_raw;
    const int tid = threadIdx.x, lane = tid & 63, wid = __builtin_amdgcn_readfirstlane(tid >> 6);
    const int G = gridDim.x, bx = blockIdx.x;
    const int gw = bx * 8 + wid, NGW = G * 8;
    unsigned char* ws = args.ws; float* out = args.out;
    const float* x = args.in[0]; const float* xs = args.in[1];
    unsigned* ctl = (unsigned*)(ws + WS_CTL);
    float* SS1 = (float*)(ws + CTL_SS1); float* SS1S = (float*)(ws + CTL_SS1S); float* SS2 = (float*)(ws + CTL_SS2); float* SS2S = (float*)(ws + CTL_SS2S);
    bf16_t* WinT = (bf16_t*)(ws + WS_WIN); bf16_t* WaT = (bf16_t*)(ws + WS_WA); bf16_t* WbT = (bf16_t*)(ws + WS_WB); bf16_t* WoT = (bf16_t*)(ws + WS_WO); bf16_t* WupT = (bf16_t*)(ws + WS_WUP); bf16_t* WdnT = (bf16_t*)(ws + WS_WDN);
    bf16_t* WlT = (bf16_t*)(ws + WS_WL); bf16_t* AlT = (bf16_t*)(ws + WS_AL); bf16_t* GlT = (bf16_t*)(ws + WS_GL);
    unsigned char* sm = ws + WS_SMALL;
    bf16_t* H1S = (bf16_t*)(sm + SM_H1S); float* ZS = (float*)(sm + SM_ZS); bf16_t* ATTS = (bf16_t*)(sm + SM_ATTS); bf16_t* RWS = (bf16_t*)(sm + SM_RWS); bf16_t* MGS = (bf16_t*)(sm + SM_MGS); bf16_t* X1GS = (bf16_t*)(sm + SM_X1GS); bf16_t* US = (bf16_t*)(sm + SM_US);
    bf16_t* H1 = (bf16_t*)(ws + WS_H1); bf16_t* QKV = (bf16_t*)(ws + WS_QKV); bf16_t* ZB = (bf16_t*)(ws + WS_ZB); bf16_t* U = (bf16_t*)(ws + WS_U); bf16_t* GATE = (bf16_t*)(ws + WS_GATE);
    bf16_t* OG = (bf16_t*)(ws + WS_OG); float* LSE = (float*)(ws + WS_LSE); bf16_t* ATT = (bf16_t*)(ws + WS_ATT); bf16_t* RW = (bf16_t*)(ws + WS_RW); bf16_t* MG = (bf16_t*)(ws + WS_MG);
    float* Yb = (float*)(ws + WS_Y); float* Gb = (float*)(ws + WS_G); float* BON = (float*)(ws + WS_BON); float* TMP = (float*)(ws + WS_TMP);
    SP sp; sp.ZS = ZS; sp.b_gate = args.in[9]; sp.out = out; sp.xs = xs; sp.g2 = args.in[24]; sp.MGS = MGS; sp.X1GS = X1GS; sp.US = US; sp.SS1S = SS1S; sp.SS2S = SS2S;
    const int lo = args.ph_lo, hi = args.ph_hi;
    if (tid < 32) ((volatile LAS unsigned*)(lds + MISC_OFF))[tid] = 0u;
    __syncthreads();
    if (lo < 0) cg::this_grid().sync();
    XcdBarrier xbar = xcd_barrier_post((unsigned*)(ws + CTL_BAR), (volatile LAS unsigned*)(lds + MISC_OFF) + 8);
#ifndef MK_ONLY
#define MK_ONLY -1
#endif
#define IN(k) ((MK_ONLY < 0 || MK_ONLY == (k)) && lo <= (k) && (k) < hi)
#define SEAM(k) do { if (IN(k) && IN((k) + 1)) { xcd_barrier(xbar); } } while (0)

    if (IN(0)) {
        LAS float* scr = (LAS float*)(lds + wid * 16384);
        constexpr int I_IN = 16 * 192, I_A = 4 * 32, I_B = 8 * 32, I_O = 16 * 32, I_UP = 16 * 128, I_DN = 64 * 32, I_WL = 16, I_AL = 16, I_GL = 32;
        constexpr int NITEMS = I_IN + I_A + I_B + I_O + I_UP + I_DN + I_WL + I_AL + I_GL;
        for (int it = gw; it < NITEMS; it += NGW) {
            int r = it;
            if (r < I_IN) { p0_transpose_item(args.in[8], 1024, 6144, WinT, scr, r, lane); continue; } r -= I_IN;
            if (r < I_A) { p0_transpose_item(args.in[21], 256, 1024, WaT, scr, r, lane); continue; } r -= I_A;
            if (r < I_B) { p0_transpose_item(args.in[22], 512, 1024, WbT, scr, r, lane); continue; } r -= I_B;
            if (r < I_O) { p0_transpose_item(args.in[23], 1024, 1024, WoT, scr, r, lane); continue; } r -= I_O;
            if (r < I_UP) { p0_transpose_item(args.in[25], 1024, 4096, WupT, scr, r, lane); continue; } r -= I_UP;
            if (r < I_DN) { p0_transpose_item(args.in[26], 4096, 1024, WdnT, scr, r, lane); continue; } r -= I_DN;
            if (r < I_WL) { p0_transpose_item(args.in[12], 64, 512, WlT, scr, r, lane); continue; } r -= I_WL;
            if (r < I_AL) { p0_transpose_item(args.in[14], 64, 512, AlT, scr, r, lane); continue; } r -= I_AL;
            p0_transpose_item(args.in[15], 128, 512, GlT, scr, r, lane);
        }
        for (int m = gw; m < M_ + MS_; m += NGW) { if (m < M_) rms_row_to_bf16(x + (size_t)m * D_, args.in[7], H1 + (size_t)m * D_, lane); else rms_row_to_bf16(xs + (size_t)(m - M_) * D_, args.in[7], H1S + (size_t)(m - M_) * D_, lane); }
        __syncthreads();
    }
    SEAM(0);
    if (IN(1)) {
        pg8::Gemm g{H1, WinT, M_, NIN_, D_}; pg8::StaticOrder S; S.init(M_, NIN_, G, bx);
        EpiZ E{QKV, ZB, GATE, args.in[9], out};
        pg8::gemm_phase<EpiZ, pg8::StaticOrder, true, true>(lds, g, S, E);
        sample_gemm<0>(lds, H1S, D_, WinT, nullptr, 0, nullptr, NIN_, sp);
    }
    SEAM(1);
    RwW w; w.mu = args.in[10]; w.w0 = args.in[11]; w.wl = args.in[12]; w.a0 = args.in[13]; w.al = args.in[14]; w.gl = args.in[15]; w.k_k = args.in[16]; w.k_a = args.in[17]; w.r_k = args.in[18]; w.gn_g = args.in[19]; w.gn_b = args.in[20];
    unsigned char* REC = ws + WS_REC;
    if (IN(2)) {
        for (int it = bx; it < 4096; it += G) prep_item(lds, it, ZB, w, WlT, AlT, GlT, Gb, BON, REC);
    }
    SEAM(2);
    if (IN(3)) {
        if (bx < 64 && wid < 4) seq_unit(lds, bx, wid, REC, Yb, out);
        __syncthreads();
        volatile LAS int* qslot = (volatile LAS int*)(lds + MISC_OFF);
        constexpr int NQ = 32 + 256 + 1536;
        for (;;) {
            if (tid == 0) *qslot = (int)atomicAdd(ctl, 1u);
            __syncthreads(); const int item = *qslot; __syncthreads();
            if (item >= NQ) break;
            if (item < 32) sample_attn(lds, item, ZS, args.in[2], args.in[3], args.in[4], ATTS);
            else if (item < 288) sample_rwkv(lds, item - 32, ZS, args.in[5], args.in[6], w, out, RWS);
            else attn_unit(lds, item - 288, QKV, OG, LSE);
        }
    }
    SEAM(3);
    if (IN(4)) {
        const float* gn_g = args.in[19]; const float* gn_b = args.in[20];
        for (int m = gw; m < M_; m += NGW) {
            { const int hs = lane >> 4; const float l0 = LSE[(size_t)m * 12 + hs], l1 = LSE[(size_t)m * 12 + 4 + hs], l2 = LSE[(size_t)m * 12 + 8 + hs]; const float mm = fmaxf(l0, fmaxf(l1, l2));
              const float w0 = __expf(l0 - mm), w1 = __expf(l1 - mm), w2 = __expf(l2 - mm); const float inv = 1.f / (w0 + w1 + w2);
              const f32x4 o0 = load4bf(OG + (size_t)m * 768 + 4 * lane), o1 = load4bf(OG + (size_t)m * 768 + 256 + 4 * lane), o2 = load4bf(OG + (size_t)m * 768 + 512 + 4 * lane);
              store4bf(ATT + (size_t)m * 256 + 4 * lane, (o0 * w0 + o1 * w1 + o2 * w2) * inv); }
            { const size_t off = (size_t)m * 512 + 8 * lane; const f32x4 y0 = *(const f32x4*)(Yb + off), y1 = *(const f32x4*)(Yb + off + 4);
              const float mu = red8((y0[0] + y0[1]) + (y0[2] + y0[3]) + (y1[0] + y1[1]) + (y1[2] + y1[3])) * (1.f / 64.f); const f32x4 d0 = y0 - mu, d1 = y1 - mu;
              const float var = red8((d0[0] * d0[0] + d0[1] * d0[1]) + (d0[2] * d0[2] + d0[3] * d0[3]) + (d1[0] * d1[0] + d1[1] * d1[1]) + (d1[2] * d1[2] + d1[3] * d1[3])) * (1.f / 64.f); const float rstd = rsqrtf(var + GN_EPS);
              const f32x4 g0 = *(const f32x4*)(gn_g + 8 * lane), g1 = *(const f32x4*)(gn_g + 8 * lane + 4), b0 = *(const f32x4*)(gn_b + 8 * lane), b1 = *(const f32x4*)(gn_b + 8 * lane + 4);
              const f32x4 bo0 = *(const f32x4*)(BON + off), bo1 = *(const f32x4*)(BON + off + 4), gg0 = *(const f32x4*)(Gb + off), gg1 = *(const f32x4*)(Gb + off + 4);
              store8bf(RW + off, (d0 * rstd * g0 + b0 + bo0) * gg0, (d1 * rstd * g1 + b1 + bo1) * gg1); }
        }
    }
    SEAM(4);
    if (IN(5)) {
        pg8::StaticOrder S; S.init(M_, D_, G, bx);
        int ka = 256, kb = 512; asm volatile("" : "+s"(ka), "+s"(kb));
        { pg8::Gemm g{ATT, WaT, M_, D_, ka}; EpiPA E{GATE, TMP}; pg8::gemm_phase<EpiPA, pg8::StaticOrder, true, true>(lds, g, S, E); }
        { pg8::Gemm g{RW, WbT, M_, D_, kb}; EpiPB E{GATE, TMP, MG}; pg8::gemm_phase<EpiPB, pg8::StaticOrder, true, true>(lds, g, S, E); }
        sample_gemm<1>(lds, ATTS, 256, WaT, RWS, 512, WbT, D_, sp);
    }
    SEAM(5);
    if (IN(6)) {
        pg8::Gemm g{MG, WoT, M_, D_, D_}; pg8::StaticOrder S; S.init(M_, D_, G, bx);
        EpiRes<true> E{x, out + O_Y, H1, args.in[24], SS1};
        pg8::gemm_phase<EpiRes<true>, pg8::StaticOrder, true, true>(lds, g, S, E);
        sample_gemm<2>(lds, MGS, D_, WoT, nullptr, 0, nullptr, D_, sp);
    }
    SEAM(6);
    if (IN(7)) {
        pg8::Gemm g{H1, WupT, M_, FF_, D_}; pg8::StaticOrder S; S.init(M_, FF_, G, bx);
        EpiUp E{SS1, U};
        pg8::gemm_phase<EpiUp, pg8::StaticOrder, true, true>(lds, g, S, E);
        sample_gemm<3>(lds, X1GS, D_, WupT, nullptr, 0, nullptr, FF_, sp);
    }
    SEAM(7);
    if (IN(8)) {
        pg8::Gemm g{U, WdnT, M_, D_, FF_}; pg8::StaticOrder S; S.init(M_, D_, G, bx);
        EpiRes<false> E{out + O_Y, out + O_Y, nullptr, nullptr, SS2};
        pg8::gemm_phase<EpiRes<false>, pg8::StaticOrder, true, true>(lds, g, S, E);
        sample_gemm<4>(lds, US, FF_, WdnT, nullptr, 0, nullptr, D_, sp);
    }
    SEAM(8);
    if (IN(9)) {
        const float* gf = args.in[27];
        for (int m = gw; m < M_ + MS_; m += NGW) {
            float* row = (m < M_) ? (out + O_Y + (size_t)m * D_) : (out + O_YS + (size_t)(m - M_) * D_); const float ss = (m < M_) ? SS2[m] : SS2S[m - M_];
            const float rs = rsqrtf(ss * (1.f / D_) + NORM_EPS);
#pragma unroll
            for (int j = 0; j < 4; ++j) { f32x4* p = (f32x4*)row + lane + 64 * j; const f32x4 gg = *((const f32x4*)gf + lane + 64 * j); *p = *p * rs * gg; }
        }
    }
#undef IN
#undef SEAM
}
}

#ifndef MK_N_LAUNCHES
#define MK_N_LAUNCHES 1
#endif
extern "C" void kernel_launch(void* const* d_in, const int* in_sizes, int n_in, void* d_out, int out_size, void* d_ws, size_t ws_size, hipStream_t stream) {
    static int grid = 0;
    if (grid == 0) {
        if (n_in != 28 || (size_t)out_size != mk::O_END || ws_size < mk::WS_END) { fprintf(stderr, "kernel_launch: unexpected shapes: n_in %d out %d ws %zu\n", n_in, out_size, ws_size); grid = -1; return; }
        int dev = 0, cus = 0, per_cu = 0;
        if (hipGetDevice(&dev) != hipSuccess || hipDeviceGetAttribute(&cus, hipDeviceAttributeMultiprocessorCount, dev) != hipSuccess) { grid = -1; return; }
        if (hipFuncSetAttribute((const void*)mk::fwd_kernel, hipFuncAttributeMaxDynamicSharedMemorySize, mk::LDS_BYTES) != hipSuccess) { fprintf(stderr, "kernel_launch: hipFuncSetAttribute failed\n"); grid = -1; return; }
        if (hipOccupancyMaxActiveBlocksPerMultiprocessor(&per_cu, (const void*)mk::fwd_kernel, 512, mk::LDS_BYTES) != hipSuccess || per_cu < 1) { fprintf(stderr, "kernel_launch: occupancy query says %d\n", per_cu); }
        (void)hipGetLastError();
        grid = cus;
    }
    if (grid < 0) return;
    (void)hipMemsetAsync((char*)d_ws + mk::WS_CTL, 0, mk::CTL_ZERO_BYTES, stream);
    mk::Args a{};
    for (int i = 0; i < 28; ++i) a.in[i] = (const float*)d_in[i];
    a.out = (float*)d_out; a.ws = (unsigned char*)d_ws;
    if (MK_N_LAUNCHES == 1) {
        a.ph_lo = 0; a.ph_hi = mk::N_PH;
        void* params[] = {&a};
        hipError_t e = hipLaunchCooperativeKernel((const void*)mk::fwd_kernel, dim3(grid), dim3(512), params, mk::LDS_BYTES, stream);
        if (e != hipSuccess) fprintf(stderr, "cooperative launch failed: %s (grid %d)\n", hipGetErrorString(e), grid);
    } else {
        for (int ph = 0; ph < mk::N_PH; ++ph) { a.ph_lo = ph; a.ph_hi = ph + 1; hipLaunchKernelGGL(mk::fwd_kernel, dim3(grid), dim3(512), mk::LDS_BYTES, stream, a); }
    }
}
```

```cpp
#include <hip/hip_runtime.h>
#include <hip/hip_cooperative_groups.h>
#include <cstdio>
#include <cstdint>
namespace cg = cooperative_groups;
namespace pg8 {
#define PG8_LAS __attribute__((address_space(3)))
typedef unsigned short bf16_t;
typedef short bf16x8 __attribute__((ext_vector_type(8)));
typedef float f32x4 __attribute__((ext_vector_type(4)));
typedef unsigned u32x4 __attribute__((ext_vector_type(4)));
constexpr int BM = 256, BK = 64, HALF = 128, HTB = HALF * BK * 2  , STAGE_BYTES = 8 * HTB, NXCD = 8, WGM = 8;

__host__ __device__ __forceinline__ int lds_byte(int r, int c) { const int st = (r >> 4) * 2 + (c >> 5), rr = r & 15, cc = c & 31, ob = rr * 64 + cc * 2; return st * 1024 + (ob ^ (((ob >> 9) & 1) << 5)); }
__host__ __device__ __forceinline__ void stage_rc(int b, int& R, int& C) { const int st = b / 1024, sb = b % 1024, swz = sb ^ (((sb >> 9) & 1) << 5); R = (st >> 1) * 16 + swz / 64; C = (st & 1) * 32 + (swz % 64) / 2; }
__host__ __device__ __forceinline__ int perm32(int rho) { const int n = rho >> 4, i = rho & 15; return 8 * (i >> 2) + 4 * n + (i & 3); }

struct Unit { int pm, pn; };
struct Gemm { const bf16_t* A; const bf16_t* Bt; int M, N, K; };

struct StaticOrder {
    int nM, nN, nwg, G, c;
    __host__ __device__ void init(int M, int N, int G_, int c_) { nM = M / BM; nN = N / BM; nwg = nM * nN; G = G_; c = c_; }
    __host__ __device__ bool next(int i, Unit& u) const {
        const long L = (long)i * G + c; if (L >= nwg) return false;
        int wgid = (int)L; { const int q = nwg / NXCD, r = nwg % NXCD, xcd = wgid % NXCD, off = wgid / NXCD; wgid = (xcd < r ? xcd * (q + 1) : r * (q + 1) + (xcd - r) * q) + off; }
        const int nig = WGM * nN, gid = wgid / nig, fm = gid * WGM, gsz = (nM - fm) < WGM ? (nM - fm) : WGM;
        u.pm = fm + ((wgid % nig) % gsz); u.pn = (wgid % nig) / gsz; return true;
    }
    __device__ __forceinline__ void a_ready(const Unit&) const {}
    __device__ __forceinline__ void done(const Unit&) const {}
};

__device__ __forceinline__ unsigned cvt_pk_bf16(float lo, float hi) { unsigned r; asm volatile("v_cvt_pk_bf16_f32 %0, %1, %2" : "=v"(r) : "v"(lo), "v"(hi)); return r; }
template <class Epi, class Sched, bool ALIGN_EPI = false, bool SP2 = false>
__device__ __forceinline__ void gemm_phase(PG8_LAS unsigned char* lds, const Gemm g, const Sched& S, const Epi& E) {
    const int tid = threadIdx.x, wid = __builtin_amdgcn_readfirstlane(tid >> 6), lane = tid & 63, wr = wid >> 2, wc = wid & 3, fr = lane & 15, fq = lane >> 4;
    const int K = g.K, nt = K / BK;
    unsigned voffA[2], voffB[2];
#pragma unroll
    for (int i = 0; i < 2; ++i) { int R, C; stage_rc(tid * 16 + i * 8192, R, C); const int Rb = Epi::PERM ? ((R & ~31) + perm32(R & 31)) : R;
        voffA[i] = (unsigned)(R * K + C) * 2u; voffB[i] = (unsigned)(Rb * K + C) * 2u; }
    const size_t kstep = (size_t)(BK * 2);
    const size_t hstep = (size_t)HALF * K * 2;
    const size_t tstep = 2 * hstep;
    const unsigned ldsw = (unsigned)wid * 1024u;
    const int aoff = lds_byte(wr * 64 + fr, fq * 8), boff = lds_byte(wc * 32 + fr, fq * 8);
#define PG8_SA(b, h) (((b) * 2 + (h)) * HTB)
#define PG8_SB(b, h) ((4 + (b) * 2 + (h)) * HTB)
#define PG8_STAGE(bufoff, gbase, voff) do { _Pragma("unroll") for (int _i = 0; _i < 2; ++_i) \
        __builtin_amdgcn_global_load_lds((const unsigned*)((const char*)(gbase) + (voff)[_i]), (PG8_LAS unsigned*)(lds + (bufoff) + ldsw + _i * 8192), 16, 0, 0); } while (0)
#define PG8_LDA(dst, b, h) do { _Pragma("unroll") for (int m = 0; m < 4; ++m) _Pragma("unroll") for (int k = 0; k < 2; ++k) dst[m][k] = *(const PG8_LAS bf16x8*)(lds + PG8_SA(b, h) + aoff + m * 2048 + k * 1024); } while (0)
#define PG8_LDB(dst, b, h) do { _Pragma("unroll") for (int n = 0; n < 2; ++n) _Pragma("unroll") for (int k = 0; k < 2; ++k) dst[n][k] = *(const PG8_LAS bf16x8*)(lds + PG8_SB(b, h) + boff + n * 2048 + k * 1024); } while (0)
#define PG8_MMA(ai, bj, At, Bt) do { __builtin_amdgcn_s_setprio(1); _Pragma("unroll") for (int m = 0; m < 4; ++m) _Pragma("unroll") for (int n = 0; n < 2; ++n) _Pragma("unroll") for (int k = 0; k < 2; ++k) \
        acc[ai][bj][m][n] = __builtin_amdgcn_mfma_f32_16x16x32_bf16(Bt[n][k], At[m][k], acc[ai][bj][m][n], 0, 0, 0); __builtin_amdgcn_s_setprio(0); } while (0)
#define PG8_WAIT_V(n) asm volatile("s_waitcnt vmcnt(" #n ")" ::: "memory")
#define PG8_WAIT_L(n) asm volatile("s_waitcnt lgkmcnt(" #n ")" ::: "memory")
#define PG8_BAR __builtin_amdgcn_s_barrier()
#define PG8_SCHED __builtin_amdgcn_sched_barrier(0)
    Unit cur, nxt; int ui = 0;
    if (!S.next(0, cur)) return;
    f32x4 acc[2][2][4][2];
#pragma unroll
    for (int a = 0; a < 2; ++a)
#pragma unroll
        for (int b = 0; b < 2; ++b)
#pragma unroll
            for (int m = 0; m < 4; ++m)
#pragma unroll
                for (int n = 0; n < 2; ++n) acc[a][b][m][n] = (f32x4){0.f, 0.f, 0.f, 0.f};
    bf16x8 At[4][2], B0[2][2], B1[2][2];
    const char* cA = (const char*)g.A + (size_t)cur.pm * tstep; const char* cB = (const char*)g.Bt + (size_t)cur.pn * tstep;
    S.a_ready(cur);
    if constexpr (SP2) {
        PG8_STAGE(PG8_SB(0, 0), cB, voffB); PG8_STAGE(PG8_SB(0, 1), cB + hstep, voffB); PG8_STAGE(PG8_SA(0, 0), cA, voffA); PG8_STAGE(PG8_SA(0, 1), cA + hstep, voffA);
        if (wr == 1) PG8_BAR;
        PG8_WAIT_V(2); PG8_BAR;
        PG8_STAGE(PG8_SB(1, 0), cB + kstep, voffB); PG8_STAGE(PG8_SA(1, 0), cA + kstep, voffA); PG8_STAGE(PG8_SB(1, 1), cB + hstep + kstep, voffB);
        PG8_WAIT_V(6); PG8_BAR;
    } else {
        PG8_STAGE(PG8_SB(0, 0), cB, voffB); PG8_STAGE(PG8_SA(0, 0), cA, voffA); PG8_STAGE(PG8_SB(0, 1), cB + hstep, voffB); PG8_STAGE(PG8_SA(0, 1), cA + hstep, voffA);
        if (wr == 1) PG8_BAR;
        PG8_WAIT_V(4); PG8_BAR;
        PG8_STAGE(PG8_SB(1, 0), cB + kstep, voffB); PG8_STAGE(PG8_SA(1, 0), cA + kstep, voffA); PG8_STAGE(PG8_SB(1, 1), cB + hstep + kstep, voffB);
        PG8_WAIT_V(6); PG8_BAR;
    }
    for (;;) {
        const bool has_next = S.next(ui + 1, nxt);
        const char* nA = has_next ? (const char*)g.A + (size_t)nxt.pm * tstep : cA; const char* nB = has_next ? (const char*)g.Bt + (size_t)nxt.pn * tstep : cB;
        for (int t = 0; t < nt; t += 2) {
            const bool last = (t == nt - 2);
            const char* a1 = cA + (size_t)(t + 1) * kstep;
            const char* a2 = last ? nA : cA + (size_t)(t + 2) * kstep; const char* b2 = last ? nB : cB + (size_t)(t + 2) * kstep;
            const char* a3 = a2 + kstep; const char* b3 = b2 + kstep;
            if (last && has_next) S.a_ready(nxt);
            if constexpr (SP2) {
            PG8_LDB(B0, 0, 0); PG8_LDB(B1, 0, 1); PG8_SCHED; PG8_LDA(At, 0, 0); PG8_STAGE(PG8_SA(1, 1), a1 + hstep, voffA);
            PG8_WAIT_V(8); PG8_WAIT_L(0); PG8_BAR; PG8_MMA(0, 0, At, B0); PG8_MMA(0, 1, At, B1); PG8_BAR; PG8_SCHED;
            PG8_LDA(At, 0, 1); PG8_STAGE(PG8_SB(0, 0), b2, voffB); PG8_STAGE(PG8_SB(0, 1), b2 + hstep, voffB); PG8_STAGE(PG8_SA(0, 0), a2, voffA);
            PG8_WAIT_V(8); PG8_WAIT_L(0); PG8_BAR; PG8_MMA(1, 0, At, B0); PG8_MMA(1, 1, At, B1); PG8_BAR; PG8_SCHED;
            PG8_LDB(B0, 1, 0); PG8_LDB(B1, 1, 1); PG8_SCHED; PG8_LDA(At, 1, 0); PG8_STAGE(PG8_SA(0, 1), a2 + hstep, voffA);
            PG8_WAIT_V(8); PG8_WAIT_L(0); PG8_BAR; PG8_MMA(0, 0, At, B0); PG8_MMA(0, 1, At, B1); PG8_BAR; PG8_SCHED;
            PG8_LDA(At, 1, 1); PG8_STAGE(PG8_SB(1, 0), b3, voffB); PG8_STAGE(PG8_SB(1, 1), b3 + hstep, voffB); PG8_STAGE(PG8_SA(1, 0), a3, voffA);
            PG8_WAIT_V(8); PG8_WAIT_L(0); PG8_BAR; PG8_MMA(1, 0, At, B0); PG8_MMA(1, 1, At, B1); PG8_BAR; PG8_SCHED;
            } else {
            PG8_LDB(B0, 0, 0); PG8_SCHED; PG8_LDA(At, 0, 0); PG8_STAGE(PG8_SA(1, 1), a1 + hstep, voffA);
            PG8_WAIT_L(8); PG8_BAR; PG8_WAIT_L(0); PG8_MMA(0, 0, At, B0); PG8_BAR; PG8_SCHED;
            PG8_LDB(B1, 0, 1); PG8_STAGE(PG8_SB(0, 0), b2, voffB);
            PG8_BAR; PG8_WAIT_L(0); PG8_MMA(0, 1, At, B1); PG8_BAR;
            PG8_LDA(At, 0, 1); PG8_STAGE(PG8_SA(0, 0), a2, voffA);
            PG8_BAR; PG8_WAIT_L(0); PG8_MMA(1, 0, At, B0); PG8_BAR; PG8_SCHED;
            PG8_STAGE(PG8_SB(0, 1), b2 + hstep, voffB);
            PG8_WAIT_V(6); PG8_BAR; PG8_MMA(1, 1, At, B1); PG8_BAR;
            PG8_LDB(B0, 1, 0); PG8_SCHED; PG8_LDA(At, 1, 0); PG8_STAGE(PG8_SA(0, 1), a2 + hstep, voffA);
            PG8_WAIT_L(8); PG8_BAR; PG8_WAIT_L(0); PG8_MMA(0, 0, At, B0); PG8_BAR; PG8_SCHED;
            PG8_LDB(B1, 1, 1); PG8_STAGE(PG8_SB(1, 0), b3, voffB);
            PG8_BAR; PG8_WAIT_L(0); PG8_MMA(0, 1, At, B1); PG8_BAR;
            PG8_LDA(At, 1, 1); PG8_STAGE(PG8_SA(1, 0), a3, voffA);
            PG8_BAR; PG8_WAIT_L(0); PG8_MMA(1, 0, At, B0); PG8_BAR; PG8_SCHED;
            PG8_STAGE(PG8_SB(1, 1), b3 + hstep, voffB);
            PG8_WAIT_V(6); PG8_BAR; PG8_MMA(1, 1, At, B1); PG8_BAR;
            }
        }
        if constexpr (ALIGN_EPI) { if (wr == 0) PG8_BAR; }
        if constexpr (!Epi::AFTER_DRAIN) { E(acc, cur, wr, wc, fr, fq); S.done(cur); }
        if (!has_next) break;
#pragma unroll
        for (int a = 0; a < 2; ++a)
#pragma unroll
            for (int b = 0; b < 2; ++b)
#pragma unroll
                for (int m = 0; m < 4; ++m)
#pragma unroll
                    for (int n = 0; n < 2; ++n) acc[a][b][m][n] = (f32x4){0.f, 0.f, 0.f, 0.f};
        cur = nxt; cA = nA; cB = nB; ++ui;
        if constexpr (ALIGN_EPI) { if (wr == 1) PG8_BAR; }
    }
    PG8_WAIT_V(0);
    if constexpr (!ALIGN_EPI) { if (wr == 0) PG8_BAR; }
    PG8_BAR;
    if constexpr (Epi::AFTER_DRAIN) { E.fused(acc, cur, wr, wc, fr, fq, lds, wid, lane); S.done(cur); }
#undef PG8_SA
#undef PG8_SB
#undef PG8_STAGE
#undef PG8_LDA
#undef PG8_LDB
#undef PG8_MMA
#undef PG8_WAIT_V
#undef PG8_WAIT_L
#undef PG8_BAR
#undef PG8_SCHED
}
}

#ifndef PROBE_PREP
#define PROBE_PREP 1
#endif
#ifndef PROBE_SEQ
#define PROBE_SEQ 1
#endif
#ifndef PROBE_ATTN
#define PROBE_ATTN 1
#endif
#ifndef MK_USE_CG
#define MK_USE_CG 1
#endif
namespace mk {
using pg8::bf16_t; using pg8::bf16x8; using pg8::f32x4; using pg8::u32x4; using pg8::Unit; using pg8::cvt_pk_bf16;
typedef unsigned u32x2 __attribute__((ext_vector_type(2)));
typedef float f32x16 __attribute__((ext_vector_type(16)));
#define LAS __attribute__((address_space(3)))

constexpr int T_ = 2048, NB_ = 8, M_ = NB_ * T_, MS_ = 32, D_ = 1024, NIN_ = 6144, FF_ = 4096;
constexpr int QKVW = 2304, ZBW = 1792, GTW = 2048;
constexpr float NORM_EPS = 1e-6f, GN_EPS = 64e-5f;
constexpr size_t O_Y = 0, O_YS = O_Y + (size_t)M_ * D_, O_KV128P = O_YS + (size_t)MS_ * D_, O_KV512P = O_KV128P + (size_t)NB_ * 128 * 512,
                 O_KV2048P = O_KV512P + (size_t)NB_ * 512 * 512, O_WKVP = O_KV2048P + (size_t)NB_ * 2048 * 512, O_SHIFTP = O_WKVP + (size_t)NB_ * 8 * 4096,
                 O_KV128S = O_SHIFTP + (size_t)NB_ * ZBW, O_KV512S = O_KV128S + (size_t)MS_ * 512, O_KV2048S = O_KV512S + (size_t)MS_ * 512,
                 O_WKVS = O_KV2048S + (size_t)MS_ * 512, O_SHIFTS = O_WKVS + (size_t)MS_ * 8 * 4096, O_END = O_SHIFTS + (size_t)MS_ * ZBW;
constexpr size_t MiB = 1u << 20, KiB = 1u << 10;
constexpr size_t WS_CTL = 0, CTL_ZERO_BYTES = 1 * MiB;
constexpr size_t CTL_SS1 = 64 * KiB, CTL_SS1S = 128 * KiB, CTL_SS2 = 192 * KiB, CTL_SS2S = 256 * KiB, CTL_BAR = 512 * KiB;
constexpr size_t WS_WIN = 2 * MiB, WS_WA = 14 * MiB, WS_WB = 14 * MiB + 512 * KiB, WS_WO = 16 * MiB, WS_WUP = 18 * MiB, WS_WDN = 26 * MiB;
constexpr size_t WS_WL = 34 * MiB, WS_AL = WS_WL + 64 * KiB, WS_GL = WS_WL + 128 * KiB;
constexpr size_t WS_SMALL = 35 * MiB;
constexpr size_t SM_H1S = 0, SM_ZS = 64 * KiB, SM_ATTS = 832 * KiB, SM_RWS = 848 * KiB, SM_MGS = 880 * KiB, SM_X1GS = 944 * KiB, SM_US = 1024 * KiB;
constexpr size_t WS_H1 = 38 * MiB, WS_QKV = 70 * MiB, WS_ZB = 142 * MiB, WS_U = 70 * MiB, WS_GATE = 198 * MiB, WS_OG = 262 * MiB, WS_LSE = 286 * MiB,
                 WS_Y = 287 * MiB, WS_G = 319 * MiB, WS_BON = 351 * MiB, WS_TMP = 287 * MiB, WS_REC = 383 * MiB, WS_ATT = 383 * MiB, WS_RW = 391 * MiB, WS_MG = 407 * MiB, WS_END = 481 * MiB;
constexpr int RING_BYTES = 131072, MISC_OFF = RING_BYTES + 320, LDS_BYTES = 147456;

__device__ __forceinline__ float bf2f(unsigned short h) { return __builtin_bit_cast(float, (unsigned)h << 16); }
__device__ __forceinline__ unsigned f2bf(float f) { unsigned u = __builtin_bit_cast(unsigned, f); return (u + 0x7fffu + ((u >> 16) & 1u)) >> 16; }
__device__ __forceinline__ unsigned pk2(float lo, float hi) { return f2bf(lo) | (f2bf(hi) << 16); }
__device__ __forceinline__ float sigm(float x) { return __builtin_amdgcn_rcpf(1.f + __expf(-x)); }
__device__ __forceinline__ float tanh_fast(float x) { return 1.f - 2.f * __builtin_amdgcn_rcpf(1.f + __expf(2.f * x)); }
__device__ __forceinline__ void store8bf(bf16_t* p, f32x4 v0, f32x4 v1) { u32x4 w; w.x = cvt_pk_bf16(v0[0], v0[1]); w.y = cvt_pk_bf16(v0[2], v0[3]); w.z = cvt_pk_bf16(v1[0], v1[1]); w.w = cvt_pk_bf16(v1[2], v1[3]); *(u32x4*)p = w; }
__device__ __forceinline__ void store4bf(bf16_t* p, f32x4 v) { u32x2 w; w.x = cvt_pk_bf16(v[0], v[1]); w.y = cvt_pk_bf16(v[2], v[3]); *(u32x2*)p = w; }
__device__ __forceinline__ f32x4 load4bf(const bf16_t* p) { const u32x2 w = *(const u32x2*)p; f32x4 r; r[0] = __builtin_bit_cast(float, w.x << 16); r[1] = __builtin_bit_cast(float, w.x & 0xffff0000u); r[2] = __builtin_bit_cast(float, w.y << 16); r[3] = __builtin_bit_cast(float, w.y & 0xffff0000u); return r; }
template <int CTRL> __device__ __forceinline__ float dppf(float v) { return __builtin_bit_cast(float, __builtin_amdgcn_update_dpp(0, __builtin_bit_cast(int, v), CTRL, 0xF, 0xF, true)); }
__device__ __forceinline__ float red16(float v) { v += dppf<0xB1>(v); v += dppf<0x4E>(v); v += dppf<0x141>(v); v += dppf<0x140>(v); return v; }
__device__ __forceinline__ float red8(float v) { v += dppf<0xB1>(v); v += dppf<0x4E>(v); v += dppf<0x141>(v); return v; }
__device__ __forceinline__ float wave_sum(float v) {
#pragma unroll
    for (int o = 1; o < 64; o <<= 1) v += __shfl_xor(v, o);
    return v;
}
__device__ __forceinline__ float wave_max(float v) {
#pragma unroll
    for (int o = 1; o < 64; o <<= 1) v = fmaxf(v, __shfl_xor(v, o));
    return v;
}

#define XB_TMO      128
#define XB_XCNT(j)  (256  + 64 * (j))
#define XB_XSUB(j)  (1280 + 64 * (j))
#define XB_XGEN(j)  (2304 + 64 * (j))
#define XB_TOP      3328
#define XB_TOPGEN   3392
#define XCD_BAR_WORDS 3456
#define XB_SPIN_CAP (1u << 18)

__device__ __forceinline__ unsigned xb_ld(unsigned* p)              { return __hip_atomic_load(p, __ATOMIC_RELAXED, __HIP_MEMORY_SCOPE_AGENT); }
__device__ __forceinline__ unsigned xb_add(unsigned* p, unsigned v) { return __hip_atomic_fetch_add(p, v, __ATOMIC_RELAXED, __HIP_MEMORY_SCOPE_AGENT); }
__device__ __forceinline__ unsigned xb_xcc_id() { return (unsigned)__builtin_amdgcn_s_getreg((3 << 11) | 20) & 0xFu; }
#define XB_SPIN(cond, bar) do { unsigned _sp = 0; while (cond) { __builtin_amdgcn_s_sleep(1); \
    if ((++_sp & 255u) == 0u) { if (xb_ld(&(bar)[XB_TMO])) break; if (_sp > XB_SPIN_CAP) { atomicAdd(&(bar)[XB_TMO], 1u); break; } } } } while (0)

struct XcdBarrier {
    unsigned* bar; unsigned x;
    volatile LAS unsigned* st;
};

__device__ __forceinline__ XcdBarrier xcd_barrier_post(unsigned* bar, volatile LAS unsigned* st) {
    XcdBarrier b; b.bar = bar; b.x = xb_xcc_id(); b.st = st;
    if (threadIdx.x == 0) (void)xb_add(&bar[XB_XCNT(b.x)], 1u);
    return b;
}
__device__ __forceinline__ void xcd_barrier_complete(unsigned* bar, unsigned x, unsigned& nloc, unsigned& nx) {
    const unsigned G = gridDim.x * gridDim.y * gridDim.z;
    unsigned sum, cnt, mine, sp = 0u;
    for (;;) {
        sum = 0u; cnt = 0u; mine = 0u;
#pragma unroll
        for (unsigned j = 0; j < 16; ++j) { const unsigned c = xb_ld(&bar[XB_XCNT(j)]); sum += c; cnt += (c > 0u) ? 1u : 0u; mine = (j == x) ? c : mine; }
        if (sum == G) break;
        __builtin_amdgcn_s_sleep(1);
        if ((++sp & 255u) == 0u) { if (xb_ld(&bar[XB_TMO])) break; if (sp > XB_SPIN_CAP) { atomicAdd(&bar[XB_TMO], 1u); break; } }
    }
    nloc = mine > 0u ? mine : 1u; nx = cnt > 0u ? cnt : 1u;
}

__device__ __forceinline__ void xcd_barrier(const XcdBarrier& b) {
    asm volatile("s_waitcnt vmcnt(0)" ::: "memory");
    __syncthreads();
    if (threadIdx.x == 0) {
        unsigned* bar = b.bar;
        __builtin_amdgcn_s_waitcnt(0);
        unsigned nloc = b.st[0], nx = b.st[1];
        if (nloc == 0u) { xcd_barrier_complete(bar, b.x, nloc, nx); b.st[0] = nloc; b.st[1] = nx; }
        const unsigned old = xb_add(&bar[XB_XSUB(b.x)], 1u);
        const unsigned gen = old / nloc;
        if (old + 1u == (gen + 1u) * nloc) {
            __builtin_amdgcn_fence(__ATOMIC_RELEASE, "agent");
            asm volatile("s_waitcnt vmcnt(0)" ::: "memory");
            const unsigned og = xb_add(&bar[XB_TOP], 1u);
            const unsigned tg = og / nx;
            if (og + 1u == (tg + 1u) * nx) xb_add(&bar[XB_TOPGEN], 1u);
            else XB_SPIN(xb_ld(&bar[XB_TOPGEN]) == tg, bar);
            __builtin_amdgcn_fence(__ATOMIC_ACQUIRE, "agent");
            xb_add(&bar[XB_XGEN(b.x)], 1u);
            asm volatile("s_waitcnt vmcnt(0)" ::: "memory");
        } else {
            XB_SPIN(xb_ld(&bar[XB_XGEN(b.x)]) == gen, bar);
            __builtin_amdgcn_fence(__ATOMIC_ACQUIRE, "agent");
            asm volatile("s_waitcnt vmcnt(0)" ::: "memory");
        }
    }
    __syncthreads();
}

struct EpiZ {
    static constexpr bool PERM = true, AFTER_DRAIN = false;
    bf16_t* QKV; bf16_t* ZB; bf16_t* GATE; const float* b_gate; float* out;
    __device__ __forceinline__ void operator()(const f32x4 (&acc)[2][2][4][2], const Unit& u, int wr, int wc, int fr, int fq) const {
        const int pn = u.pn;
#pragma unroll
        for (int ai = 0; ai < 2; ++ai)
#pragma unroll
            for (int m = 0; m < 4; ++m) {
                const int row = u.pm * 256 + ai * 128 + wr * 64 + m * 16 + fr; const int b = row >> 11, t = row & 2047;
#pragma unroll
                for (int bj = 0; bj < 2; ++bj) {
                    const int col = pn * 256 + bj * 128 + wc * 32 + 8 * fq;
                    const f32x4 v0 = acc[ai][bj][m][0], v1 = acc[ai][bj][m][1];
                    if (pn < 9) {
                        store8bf(QKV + (size_t)row * QKVW + col, v0, v1);
                        if (col >= 768) {
                            const int kvsel = col >= 1536 ? 1 : 0; const int cc = col - 768 - kvsel * 768; const int head = cc >> 6, g = head >> 2, hs = head & 3, d = cc & 63;
                            const int rows_g = 128 << (2 * g); const int j = t - (T_ - rows_g);
                            if (j >= 0) { float* dst = out + (g == 0 ? O_KV128P : (g == 1 ? O_KV512P : O_KV2048P)) + ((size_t)(b * rows_g + j) * 2 + kvsel) * 256 + hs * 64 + d; *(f32x4*)dst = v0; *(f32x4*)(dst + 4) = v1; }
                        }
                    } else if (pn < 16) {
                        const int c = col - QKVW; store8bf(ZB + (size_t)row * ZBW + c, v0, v1);
                        if (t == T_ - 1) { float* dst = out + O_SHIFTP + (size_t)b * ZBW + c; *(f32x4*)dst = v0; *(f32x4*)(dst + 4) = v1; }
                    } else {
                        const int c = col - 4096; const f32x4 b0 = *(const f32x4*)(b_gate + c), b1 = *(const f32x4*)(b_gate + c + 4); f32x4 g0, g1;
#pragma unroll
                        for (int e = 0; e < 4; ++e) { g0[e] = sigm(v0[e] + b0[e]); g1[e] = sigm(v1[e] + b1[e]); }
                        store8bf(GATE + (size_t)row * GTW + c, g0, g1);
                    }
                }
            }
    }
};
struct EpiPA {
    static constexpr bool PERM = false, AFTER_DRAIN = false;
    const bf16_t* GATE; float* TMP;
    __device__ __forceinline__ void operator()(const f32x4 (&acc)[2][2][4][2], const Unit& u, int wr, int wc, int fr, int fq) const {
#pragma unroll
        for (int ai = 0; ai < 2; ++ai)
#pragma unroll
            for (int m = 0; m < 4; ++m) { const int row = u.pm * 256 + ai * 128 + wr * 64 + m * 16 + fr;
#pragma unroll
                for (int bj = 0; bj < 2; ++bj)
#pragma unroll
                    for (int n = 0; n < 2; ++n) { const int col = u.pn * 256 + bj * 128 + wc * 32 + 16 * n + 4 * fq;
                        const f32x4 ga = load4bf(GATE + (size_t)row * GTW + col); *(f32x4*)(TMP + (size_t)row * D_ + col) = ga * acc[ai][bj][m][n]; }
                asm volatile("" ::: "memory"); }
    }
};
struct EpiPB {
    static constexpr bool PERM = false, AFTER_DRAIN = false;
    const bf16_t* GATE; const float* TMP; bf16_t* MG;
    __device__ __forceinline__ void operator()(const f32x4 (&acc)[2][2][4][2], const Unit& u, int wr, int wc, int fr, int fq) const {
#pragma unroll
        for (int ai = 0; ai < 2; ++ai)
#pragma unroll
            for (int m = 0; m < 4; ++m) { const int row = u.pm * 256 + ai * 128 + wr * 64 + m * 16 + fr;
#pragma unroll
                for (int bj = 0; bj < 2; ++bj)
#pragma unroll
                    for (int n = 0; n < 2; ++n) { const int col = u.pn * 256 + bj * 128 + wc * 32 + 16 * n + 4 * fq;
                        const f32x4 gb = load4bf(GATE + (size_t)row * GTW + D_ + col); const f32x4 t = *(const f32x4*)(TMP + (size_t)row * D_ + col);
                        store4bf(MG + (size_t)row * D_ + col, t + gb * acc[ai][bj][m][n]); }
                asm volatile("" ::: "memory"); }
    }
};
template <bool WRITE_XG> struct EpiRes {
    static constexpr bool PERM = false, AFTER_DRAIN = false;
    const float* xin; float* xo; bf16_t* XG; const float* g; float* SS;
    __device__ __forceinline__ void operator()(const f32x4 (&acc)[2][2][4][2], const Unit& u, int wr, int wc, int fr, int fq) const {
#pragma unroll
        for (int ai = 0; ai < 2; ++ai)
#pragma unroll
            for (int m = 0; m < 4; ++m) { const int row = u.pm * 256 + ai * 128 + wr * 64 + m * 16 + fr; float ss = 0.f;
#pragma unroll
                for (int bj = 0; bj < 2; ++bj)
#pragma unroll
                    for (int n = 0; n < 2; ++n) { const int col = u.pn * 256 + bj * 128 + wc * 32 + 16 * n + 4 * fq;
                        const f32x4 x1 = *(const f32x4*)(xin + (size_t)row * D_ + col) + acc[ai][bj][m][n];
                        *(f32x4*)(xo + (size_t)row * D_ + col) = x1; ss += (x1[0] * x1[0] + x1[1] * x1[1]) + (x1[2] * x1[2] + x1[3] * x1[3]);
                        if (WRITE_XG) { const f32x4 gg = *(const f32x4*)(g + col); store4bf(XG + (size_t)row * D_ + col, x1 * gg); } }
                ss += __shfl_xor(ss, 16); ss += __shfl_xor(ss, 32);
                if (fq == 0) atomicAdd(SS + row, ss);
                asm volatile("" ::: "memory"); }
    }
};
struct EpiUp {
    static constexpr bool PERM = true, AFTER_DRAIN = false;
    const float* SS; bf16_t* U;
    __device__ __forceinline__ void operator()(const f32x4 (&acc)[2][2][4][2], const Unit& u, int wr, int wc, int fr, int fq) const {
#pragma unroll
        for (int ai = 0; ai < 2; ++ai)
#pragma unroll
            for (int m = 0; m < 4; ++m) { const int row = u.pm * 256 + ai * 128 + wr * 64 + m * 16 + fr; const float rs = rsqrtf(SS[row] * (1.f / D_) + NORM_EPS);
#pragma unroll
                for (int bj = 0; bj < 2; ++bj) { const int col = u.pn * 256 + bj * 128 + wc * 32 + 8 * fq; f32x4 v0 = acc[ai][bj][m][0] * rs, v1 = acc[ai][bj][m][1] * rs;
#pragma unroll
                    for (int e = 0; e < 4; ++e) { const float a = fmaxf(v0[e], 0.f), b = fmaxf(v1[e], 0.f); v0[e] = a * a; v1[e] = b * b; }
                    store8bf(U + (size_t)row * FF_ + col, v0, v1); } }
    }
};

struct SP { float* ZS; const float* b_gate; float* out; const float* xs; const float* g2; bf16_t* MGS; bf16_t* X1GS; bf16_t* US; float* SS1S; float* SS2S; };
template <int MODE> __device__ __forceinline__ void sample_gemm(LAS unsigned char* lds, const bf16_t* A1, int K1, const bf16_t* B1, const bf16_t* A2, int K2, const bf16_t* B2, int N, const SP p) {
    const int tid = threadIdx.x, wid = tid >> 6, lane = tid & 63, r = lane & 31, hh = lane >> 5;
    LAS float* P = (LAS float*)lds;
    for (int tile = blockIdx.x; tile < N / 32; tile += gridDim.x) {
        const int n0 = tile * 32;
        f32x16 acc1, acc2;
#pragma unroll
        for (int i = 0; i < 16; ++i) { acc1[i] = 0.f; acc2[i] = 0.f; }
        { const int kw = K1 / 8; const bf16_t* ap = A1 + (size_t)r * K1 + wid * kw + 8 * hh; const bf16_t* bp = B1 + (size_t)(n0 + r) * K1 + wid * kw + 8 * hh;
#pragma unroll 4
          for (int k = 0; k < kw; k += 16) { const bf16x8 a = *(const bf16x8*)(ap + k), b = *(const bf16x8*)(bp + k); acc1 = __builtin_amdgcn_mfma_f32_32x32x16_bf16(a, b, acc1, 0, 0, 0); } }
        if (K2 > 0) { const int kw = K2 / 8; const bf16_t* ap = A2 + (size_t)r * K2 + wid * kw + 8 * hh; const bf16_t* bp = B2 + (size_t)(n0 + r) * K2 + wid * kw + 8 * hh;
#pragma unroll 4
          for (int k = 0; k < kw; k += 16) { const bf16x8 a = *(const bf16x8*)(ap + k), b = *(const bf16x8*)(bp + k); acc2 = __builtin_amdgcn_mfma_f32_32x32x16_bf16(a, b, acc2, 0, 0, 0); } }
#pragma unroll
        for (int reg = 0; reg < 16; ++reg) { const int row = (reg & 3) + 8 * (reg >> 2) + 4 * hh; P[wid * 1024 + row * 32 + r] = acc1[reg]; if (K2 > 0) P[8192 + wid * 1024 + row * 32 + r] = acc2[reg]; }
        __syncthreads();
        const int row = tid >> 4, c2 = (tid & 15) * 2, col = n0 + c2;
        float s1a = 0.f, s1b = 0.f, s2a = 0.f, s2b = 0.f;
#pragma unroll
        for (int w = 0; w < 8; ++w) { s1a += P[w * 1024 + row * 32 + c2]; s1b += P[w * 1024 + row * 32 + c2 + 1]; if (K2 > 0) { s2a += P[8192 + w * 1024 + row * 32 + c2]; s2b += P[8192 + w * 1024 + row * 32 + c2 + 1]; } }
        if (MODE == 0) {
            p.ZS[(size_t)row * NIN_ + col] = s1a; p.ZS[(size_t)row * NIN_ + col + 1] = s1b;
            if (col >= 768 && col < QKVW) { const int kvsel = col >= 1536 ? 1 : 0; const int cc = col - 768 - kvsel * 768; const int head = cc >> 6, g = head >> 2, hs = head & 3, d = cc & 63;
                float* dst = p.out + (g == 0 ? O_KV128S : (g == 1 ? O_KV512S : O_KV2048S)) + ((size_t)row * 2 + kvsel) * 256 + hs * 64 + d; dst[0] = s1a; dst[1] = s1b; }
            else if (col >= QKVW && col < 4096) { float* dst = p.out + O_SHIFTS + (size_t)row * ZBW + (col - QKVW); dst[0] = s1a; dst[1] = s1b; }
        } else if (MODE == 1) {
            const float* zg = p.ZS + (size_t)row * NIN_ + 4096;
            const float ga0 = sigm(zg[col] + p.b_gate[col]), ga1 = sigm(zg[col + 1] + p.b_gate[col + 1]), gb0 = sigm(zg[D_ + col] + p.b_gate[D_ + col]), gb1 = sigm(zg[D_ + col + 1] + p.b_gate[D_ + col + 1]);
            *(unsigned*)(p.MGS + (size_t)row * D_ + col) = pk2(ga0 * s1a + gb0 * s2a, ga1 * s1b + gb1 * s2b);
        } else if (MODE == 2 || MODE == 4) {
            const float* xin = (MODE == 2) ? p.xs : (p.out + O_YS); float* xo = p.out + O_YS;
            const float x0 = xin[(size_t)row * D_ + col] + s1a, x1 = xin[(size_t)row * D_ + col + 1] + s1b;
            xo[(size_t)row * D_ + col] = x0; xo[(size_t)row * D_ + col + 1] = x1;
            if (MODE == 2) *(unsigned*)(p.X1GS + (size_t)row * D_ + col) = pk2(x0 * p.g2[col], x1 * p.g2[col + 1]);
            float ss = x0 * x0 + x1 * x1; ss = red16(ss);
            if ((tid & 15) == 0) atomicAdd((MODE == 2 ? p.SS1S : p.SS2S) + row, ss);
        } else if (MODE == 3) {
            const float rs = rsqrtf(p.SS1S[row] * (1.f / D_) + NORM_EPS); const float a = fmaxf(rs * s1a, 0.f), b = fmaxf(rs * s1b, 0.f);
            *(unsigned*)(p.US + (size_t)row * FF_ + col) = pk2(a * a, b * b);
        }
        __syncthreads();
    }
}

__device__ __forceinline__ void p0_transpose_item(const float* W, int K, int N, bf16_t* WT, LAS float* scr, int item, int lane) {
    const int nblk = N / 32, kb = item / nblk, nb = item % nblk, k0 = 64 * kb, n0 = 32 * nb;
#pragma unroll 8
    for (int i = 0; i < 32; ++i) { const int kk = 2 * i + (lane >> 5); scr[kk * 33 + (lane & 31)] = W[(size_t)(k0 + kk) * N + n0 + (lane & 31)]; }
    asm volatile("s_waitcnt lgkmcnt(0)" ::: "memory");
    const int c = lane & 7;
#pragma unroll
    for (int j = 0; j < 4; ++j) { const int n = (lane >> 3) + 8 * j; const LAS float* s = scr + (8 * c) * 33 + n;
        u32x4 o; o.x = pk2(s[0 * 33], s[1 * 33]); o.y = pk2(s[2 * 33], s[3 * 33]); o.z = pk2(s[4 * 33], s[5 * 33]); o.w = pk2(s[6 * 33], s[7 * 33]);
        *(u32x4*)(WT + (size_t)(n0 + n) * K + k0 + 8 * c) = o; }
    asm volatile("s_waitcnt lgkmcnt(0)" ::: "memory");
}
__device__ __forceinline__ void rms_row_to_bf16(const float* xrow, const float* g, bf16_t* orow, int lane) {
    f32x4 v[4]; float s = 0.f;
#pragma unroll
    for (int j = 0; j < 4; ++j) { v[j] = *((const f32x4*)xrow + lane + 64 * j); s += (v[j][0] * v[j][0] + v[j][1] * v[j][1]) + (v[j][2] * v[j][2] + v[j][3] * v[j][3]); }
    const float rs = rsqrtf(wave_sum(s) * (1.f / D_) + NORM_EPS);
#pragma unroll
    for (int j = 0; j < 4; ++j) { const f32x4 gg = *((const f32x4*)g + lane + 64 * j); store4bf(orow + 4 * (lane + 64 * j), v[j] * rs * gg); }
}

constexpr int AT_KS = 0, AT_VT = 36864, AT_PS = 72704;
__device__ __forceinline__ void attn_unit(LAS unsigned char* lds, int item, const bf16_t* QKV, bf16_t* OG, float* LSE) {
    int tid_ = threadIdx.x; asm volatile("" : "+v"(tid_));
    const int tid = tid_, wid = __builtin_amdgcn_readfirstlane(tid >> 6), lane = tid & 63, fr = lane & 15, fq = lane >> 4;
    const int blk = item & 15, hs = (item >> 4) & 3, g = (item >> 6) % 3, b = item / 192;
    const int dsh = 2 * g, dil = 1 << dsh, nbk = 16 >> dsh, r = blk / nbk, n = blk % nbk, h = g * 4 + hs;
    const float slope = exp2f(-8.0f * (float)(h + 1) / 12.0f);
    const bf16_t* base = QKV + (size_t)b * T_ * QKVW;
    LAS unsigned char* Ks = lds + AT_KS; LAS unsigned char* Vt = lds + AT_VT; LAS unsigned char* Ps = lds + AT_PS + wid * (16 * 336);
#pragma unroll
    for (int i = 0; i < 4; ++i) { const int c = tid + 512 * i, row = c >> 3, part = c & 7; const int e = (n - 1) * 128 + row;
        u32x4 v = (u32x4){0u, 0u, 0u, 0u}; if (e >= 0) v = *(const u32x4*)(base + (size_t)((e << dsh) + r) * QKVW + 768 + h * 64 + part * 8);
        *(LAS u32x4*)(Ks + row * 144 + part * 16) = v; }
#pragma unroll
    for (int i = 0; i < 4; ++i) { const int key = tid & 255, part = (tid >> 8) + 2 * i; const int e = (n - 1) * 128 + key;
        u32x4 v = (u32x4){0u, 0u, 0u, 0u}; if (e >= 0) v = *(const u32x4*)(base + (size_t)((e << dsh) + r) * QKVW + 1536 + h * 64 + part * 8);
        LAS unsigned short* dst = (LAS unsigned short*)(Vt + (part * 8) * 560 + key * 2);
        dst[0 * 280] = (unsigned short)(v.x & 0xffff); dst[1 * 280] = (unsigned short)(v.x >> 16); dst[2 * 280] = (unsigned short)(v.y & 0xffff); dst[3 * 280] = (unsigned short)(v.y >> 16);
        dst[4 * 280] = (unsigned short)(v.z & 0xffff); dst[5 * 280] = (unsigned short)(v.z >> 16); dst[6 * 280] = (unsigned short)(v.w & 0xffff); dst[7 * 280] = (unsigned short)(v.w >> 16); }
    for (int idx = tid; idx < 64 * 12; idx += 512) { const int d = idx / 12, k2 = idx % 12; *(LAS unsigned*)(Vt + d * 560 + (256 + 2 * k2) * 2) = 0u; }
    const int qi = 16 * wid + fr; const int tq = ((n * 128 + qi) << dsh) + r;
    const bf16x8 qa0 = *(const bf16x8*)(base + (size_t)tq * QKVW + h * 64 + 8 * fq), qa1 = *(const bf16x8*)(base + (size_t)tq * QKVW + h * 64 + 32 + 8 * fq);
    __syncthreads();
    f32x4 s[10];
    float mx[4] = {-3.0e38f, -3.0e38f, -3.0e38f, -3.0e38f};
#pragma unroll
    for (int jt = 0; jt < 10; ++jt) {
        const int jtile = wid + jt; f32x4 a = (f32x4){0.f, 0.f, 0.f, 0.f};
        if (jtile < 16) {
            const bf16x8 k0 = *(const LAS bf16x8*)(Ks + (jtile * 16 + fr) * 144 + fq * 16), k1 = *(const LAS bf16x8*)(Ks + (jtile * 16 + fr) * 144 + 64 + fq * 16);
            a = __builtin_amdgcn_mfma_f32_16x16x32_bf16(qa0, k0, a, 0, 0, 0); a = __builtin_amdgcn_mfma_f32_16x16x32_bf16(qa1, k1, a, 0, 0, 0);
        }
        const int j = jtile * 16 + fr;
#pragma unroll
        for (int e = 0; e < 4; ++e) { const int i = 16 * wid + 4 * fq + e; const int delta = 128 + i - j;
            const bool valid = (jtile < 16) && (delta >= 0) && (delta <= 128) && (n > 0 || j >= 128);
            const float sc = valid ? (a[e] * 0.125f - slope * (float)(delta << dsh)) : -1.0e30f; a[e] = sc; mx[e] = fmaxf(mx[e], sc); }
        s[jt] = a;
    }
    float lsum[4];
#pragma unroll
    for (int e = 0; e < 4; ++e) { float m = mx[e]; m = fmaxf(m, __shfl_xor(m, 1)); m = fmaxf(m, __shfl_xor(m, 2)); m = fmaxf(m, __shfl_xor(m, 4)); m = fmaxf(m, __shfl_xor(m, 8)); mx[e] = m; lsum[e] = 0.f; }
#pragma unroll
    for (int jt = 0; jt < 10; ++jt)
#pragma unroll
        for (int e = 0; e < 4; ++e) { const float p = __expf(s[jt][e] - mx[e]); lsum[e] += p; *(LAS unsigned short*)(Ps + (4 * fq + e) * 336 + (jt * 16 + fr) * 2) = (unsigned short)f2bf(p); }
#pragma unroll
    for (int e = 0; e < 4; ++e) { float l = lsum[e]; l += __shfl_xor(l, 1); l += __shfl_xor(l, 2); l += __shfl_xor(l, 4); l += __shfl_xor(l, 8); lsum[e] = l; }
    asm volatile("s_waitcnt lgkmcnt(0)" ::: "memory");
    f32x4 o[4];
#pragma unroll
    for (int nt = 0; nt < 4; ++nt) o[nt] = (f32x4){0.f, 0.f, 0.f, 0.f};
#pragma unroll
    for (int ks = 0; ks < 5; ++ks) {
        const bf16x8 pa = *(const LAS bf16x8*)(Ps + fr * 336 + (32 * ks + 8 * fq) * 2);
#pragma unroll
        for (int nt = 0; nt < 4; ++nt) { const bf16x8 vb = *(const LAS bf16x8*)(Vt + (nt * 16 + fr) * 560 + (16 * wid + 32 * ks + 8 * fq) * 2); o[nt] = __builtin_amdgcn_mfma_f32_16x16x32_bf16(pa, vb, o[nt], 0, 0, 0); }
    }
#pragma unroll
    for (int e = 0; e < 4; ++e) { const int i = 16 * wid + 4 * fq + e; const int t = ((n * 128 + i) << dsh) + r; const size_t row = (size_t)b * T_ + t; const float inv = 1.f / lsum[e];
#pragma unroll
        for (int nt = 0; nt < 4; ++nt) OG[row * 768 + h * 64 + nt * 16 + fr] = (bf16_t)f2bf(o[nt][e] * inv);
        if (fr == 0) LSE[row * 12 + h] = mx[e] + __logf(lsum[e]); }
    __syncthreads();
}

__device__ __forceinline__ void sample_attn(LAS unsigned char* lds, int b, const float* ZS, const float* c128, const float* c512, const float* c2048, bf16_t* ATTS) {
    const int tid = threadIdx.x, wid = tid >> 6, lane = tid & 63;
    LAS float* qs = (LAS float*)lds;
    LAS float* sc = qs + 256;
    LAS float* og = sc + 4 * 132;
    LAS float* ls = og + 768;
    LAS float* lsm = ls + 12;
    const float* z = ZS + (size_t)b * NIN_;
    for (int g = 0; g < 3; ++g) {
        const int dsh = 2 * g, Lb = 128 << dsh; const float* cache = g == 0 ? c128 : (g == 1 ? c512 : c2048);
        const float* cb = cache + (size_t)b * Lb * 512;
        if (tid < 256) qs[tid] = z[g * 256 + tid];
        __syncthreads();
        { const int hs = tid >> 7, mi = tid & 127, m = mi + 1; const float slope = exp2f(-8.0f * (float)(g * 4 + hs + 1) / 12.0f);
          const float* kr = cb + (size_t)(Lb - (m << dsh)) * 512 + hs * 64; float d = 0.f;
#pragma unroll
          for (int i = 0; i < 16; ++i) { const f32x4 kv = *(const f32x4*)(kr + 4 * i); const f32x4 qv = *(const LAS f32x4*)(qs + hs * 64 + 4 * i); d += (kv[0] * qv[0] + kv[1] * qv[1]) + (kv[2] * qv[2] + kv[3] * qv[3]); }
          sc[hs * 132 + m] = d * 0.125f - slope * (float)(m << dsh);
          if (mi == 0) { const float* kn = z + 768 + (g * 4 + hs) * 64; float d0 = 0.f; for (int i = 0; i < 64; ++i) d0 += kn[i] * qs[hs * 64 + i]; sc[hs * 132] = d0 * 0.125f; } }
        __syncthreads();
        if (wid < 4) { const int hs = wid; float v0 = sc[hs * 132 + lane], v1 = sc[hs * 132 + 64 + lane], v2 = lane == 0 ? sc[hs * 132 + 128] : -3.0e38f;
            const float mxx = wave_max(fmaxf(fmaxf(v0, v1), v2)); const float p0 = __expf(v0 - mxx), p1 = __expf(v1 - mxx), p2 = lane == 0 ? __expf(v2 - mxx) : 0.f;
            const float l = wave_sum(p0 + p1 + p2); sc[hs * 132 + lane] = p0; sc[hs * 132 + 64 + lane] = p1; if (lane == 0) { sc[hs * 132 + 128] = p2; ls[g * 4 + hs] = mxx + __logf(l); lsm[hs] = l; } }
        __syncthreads();
        { const int hs = tid >> 7, d = (tid >> 1) & 63, half = tid & 1; float acc = 0.f;
          const int m0 = half ? 65 : 0, m1 = half ? 129 : 65;
          for (int m = m0; m < m1; ++m) { const float vv = (m == 0) ? z[1536 + (g * 4 + hs) * 64 + d] : cb[(size_t)(Lb - (m << dsh)) * 512 + 256 + hs * 64 + d]; acc += sc[hs * 132 + m] * vv; }
          acc += __shfl_xor(acc, 1);
          if (half == 0) og[(g * 4 + hs) * 64 + d] = acc / lsm[hs]; }
        __syncthreads();
    }
    if (tid < 256) { const int hs = tid >> 6, d = tid & 63; const float l0 = ls[hs], l1 = ls[4 + hs], l2 = ls[8 + hs]; const float mm = fmaxf(l0, fmaxf(l1, l2));
        const float w0 = __expf(l0 - mm), w1 = __expf(l1 - mm), w2 = __expf(l2 - mm); const float inv = 1.f / (w0 + w1 + w2);
        ATTS[(size_t)b * 256 + tid] = (bf16_t)f2bf((w0 * og[hs * 64 + d] + w1 * og[(4 + hs) * 64 + d] + w2 * og[(8 + hs) * 64 + d]) * inv); }
    __syncthreads();
}

struct RwW { const float *mu, *w0, *a0, *k_k, *k_a, *r_k, *gn_g, *gn_b, *wl, *al, *gl; };
__device__ __forceinline__ float decay_of(float w0c, float wl) { const float x = -(w0c + wl); const float sp = fmaxf(x, 0.f) + __logf(1.f + __expf(-fabsf(x))); return __expf(-__expf(-sp - 0.5f)); }

__device__ __forceinline__ void sample_rwkv(LAS unsigned char* lds, int item, const float* ZS, const float* state_wkv, const float* state_shift, const RwW w, float* out, bf16_t* RWS) {
    const int tid = threadIdx.x, wid = tid >> 6, lane = tid & 63; const int b = item >> 3, h = item & 7;
    LAS float* xr = (LAS float*)lds; LAS float* xk = xr + 64; LAS float* xv = xk + 64; LAS float* lw = xv + 64; LAS float* la = lw + 64; LAS float* lg = la + 64;
    LAS float* pw = lg + 128; LAS float* pa = pw + 64; LAS float* pg = pa + 64;
    LAS float* sR = pg + 64; LAS float* sW = sR + 64; LAS float* sK = sW + 64; LAS float* sV = sK + 64; LAS float* sA = sV + 64; LAS float* sB = sA + 64; LAS float* sG = sB + 64; LAS float* sY = sG + 64; LAS float* sC = sY + 64;
    const float* zb = ZS + (size_t)b * NIN_ + QKVW; const float* pv = state_shift + (size_t)b * ZBW;
    if (tid < 448) { int col; if (tid < 192) col = (tid >> 6) * 512 + h * 64 + (tid & 63); else col = 1536 + (tid - 192);
        const float cur = zb[col], prv = pv[col]; const float mx = cur + (prv - cur) * w.mu[col];
        if (tid < 64) xr[tid] = mx; else if (tid < 128) xk[tid - 64] = mx; else if (tid < 192) xv[tid - 128] = mx; else if (tid < 256) lw[tid - 192] = tanhf(mx); else if (tid < 320) la[tid - 256] = mx; else lg[tid - 320] = sigm(mx); }
    __syncthreads();
    if (tid < 192) { const int which = tid >> 6, nn = tid & 63, c = h * 64 + nn; float acc = 0.f;
        if (which == 0) { for (int j = 0; j < 64; ++j) acc += lw[j] * w.wl[j * 512 + c]; pw[nn] = acc; }
        else if (which == 1) { for (int j = 0; j < 64; ++j) acc += la[j] * w.al[j * 512 + c]; pa[nn] = acc; }
        else { for (int j = 0; j < 128; ++j) acc += lg[j] * w.gl[j * 512 + c]; pg[nn] = acc; } }
    __syncthreads();
    if (wid == 0) { const int c = h * 64 + lane; const float r = xr[lane], k = xk[lane], v = xv[lane];
        const float dec = decay_of(w.w0[c], pw[lane]); const float a = sigm(w.a0[c] + pa[lane]);
        const float kkr = k * w.k_k[c]; const float nrm = fmaxf(sqrtf(wave_sum(kkr * kkr)), 1e-12f); const float kk = kkr / nrm;
        const float kp = k * (1.f + (a - 1.f) * w.k_a[c]); const float cs = wave_sum(r * kp * w.r_k[c]);
        sR[lane] = r; sW[lane] = dec; sK[lane] = kp; sV[lane] = v; sA[lane] = -kk; sB[lane] = kk * a; sG[lane] = pg[lane]; if (lane == 0) sC[0] = cs; }
    __syncthreads();
    { const int row = tid >> 3, kq = tid & 7; const float* S0 = state_wkv + ((size_t)(b * 8 + h) * 64 + row) * 64 + 8 * kq; float s[8];
      const f32x4 s0 = *(const f32x4*)S0, s1 = *(const f32x4*)(S0 + 4); s[0] = s0[0]; s[1] = s0[1]; s[2] = s0[2]; s[3] = s0[3]; s[4] = s1[0]; s[5] = s1[1]; s[6] = s1[2]; s[7] = s1[3];
      float dot = 0.f;
#pragma unroll
      for (int i = 0; i < 8; ++i) dot += s[i] * sA[8 * kq + i];
      const float sa = red8(dot); const float vv = sV[row]; float yp = 0.f;
#pragma unroll
      for (int i = 0; i < 8; ++i) { s[i] = s[i] * sW[8 * kq + i] + sa * sB[8 * kq + i] + vv * sK[8 * kq + i]; yp += s[i] * sR[8 * kq + i]; }
      const float y = red8(yp); float* So = out + O_WKVS + ((size_t)(b * 8 + h) * 64 + row) * 64 + 8 * kq;
      *(f32x4*)So = (f32x4){s[0], s[1], s[2], s[3]}; *(f32x4*)(So + 4) = (f32x4){s[4], s[5], s[6], s[7]};
      if (kq == 0) sY[row] = y; }
    __syncthreads();
    if (wid == 0) { const int c = h * 64 + lane; const float y = sY[lane]; const float mu = wave_sum(y) * (1.f / 64.f); const float dv = y - mu; const float var = wave_sum(dv * dv) * (1.f / 64.f);
        const float yn = dv * rsqrtf(var + GN_EPS) * w.gn_g[c] + w.gn_b[c]; RWS[(size_t)b * 512 + c] = (bf16_t)f2bf((yn + sC[0] * sV[lane]) * sG[lane]); }
    __syncthreads();
}

constexpr int RC_P = 0, RC_P2 = 2048, RC_Q = 4096, RC_Q2 = 5120, RC_BK = 6144, RC_VT = 10240, RC_DC = 12288, RC_BYTES = 12544;
constexpr int PS = 68;
constexpr int PR_XR = 0, PR_XK = 8704, PR_XV = 17408, PR_PW = 26112, PR_PA = 34816, PR_PG = 43520, PR_LW = 52224, PR_LA = 56832, PR_LG = 61440, PR_GM = 70144, PR_TM = 80384, PR_PP = 82944, PR_QQ = 91648;
struct PrepLd { u32x2 c[7], p[7]; };
__device__ __forceinline__ f32x4 ub4(u32x2 w) { f32x4 r; r[0] = __builtin_bit_cast(float, w.x << 16); r[1] = __builtin_bit_cast(float, w.x & 0xffff0000u); r[2] = __builtin_bit_cast(float, w.y << 16); r[3] = __builtin_bit_cast(float, w.y & 0xffff0000u); return r; }
__device__ __forceinline__ void prep_load(PrepLd& ld, int item, const bf16_t* ZB) {
    const int tid = threadIdx.x, tt = tid >> 4, q = tid & 15; const int bh = item >> 6, c32 = item & 63, b = bh >> 3, h = bh & 7, t = c32 * 32 + tt, c0 = h * 64 + 4 * q;
    const bf16_t* cur = ZB + ((size_t)b * T_ + t) * ZBW; const bf16_t* prv = cur - ZBW; const bool hp = t > 0; const u32x2 z = (u32x2){0u, 0u};
    ld.c[0] = *(const u32x2*)(cur + c0); ld.c[1] = *(const u32x2*)(cur + 512 + c0); ld.c[2] = *(const u32x2*)(cur + 1024 + c0); ld.c[3] = *(const u32x2*)(cur + 1536 + 4 * q); ld.c[4] = *(const u32x2*)(cur + 1600 + 4 * q); ld.c[5] = *(const u32x2*)(cur + 1664 + 8 * q); ld.c[6] = *(const u32x2*)(cur + 1668 + 8 * q);
    ld.p[0] = hp ? *(const u32x2*)(prv + c0) : z; ld.p[1] = hp ? *(const u32x2*)(prv + 512 + c0) : z; ld.p[2] = hp ? *(const u32x2*)(prv + 1024 + c0) : z; ld.p[3] = hp ? *(const u32x2*)(prv + 1536 + 4 * q) : z; ld.p[4] = hp ? *(const u32x2*)(prv + 1600 + 4 * q) : z;
    ld.p[5] = hp ? *(const u32x2*)(prv + 1664 + 8 * q) : z; ld.p[6] = hp ? *(const u32x2*)(prv + 1668 + 8 * q) : z;
}
__device__ __forceinline__ void prep_item(LAS unsigned char* lds, int item, int next_item, PrepLd& ld, const bf16_t* ZB, const RwW w, const bf16_t* WlT, const bf16_t* AlT, const bf16_t* GlT, float* G, float* BON, unsigned char* REC) {
    int tid_ = threadIdx.x; asm volatile("" : "+v"(tid_));
    const int tid = tid_, wid = __builtin_amdgcn_readfirstlane(tid >> 6), lane = tid & 63, fr = lane & 15, fq = lane >> 4;
    const int bh = item >> 6, c32 = item & 63, b = bh >> 3, h = bh & 7, t0 = c32 * 32;
    LAS float* XR = (LAS float*)(lds + PR_XR); LAS float* XK = (LAS float*)(lds + PR_XK); LAS float* XV = (LAS float*)(lds + PR_XV);
    LAS float* PW = (LAS float*)(lds + PR_PW); LAS float* PA = (LAS float*)(lds + PR_PA); LAS float* PG = (LAS float*)(lds + PR_PG);
    LAS unsigned char* LW = lds + PR_LW; LAS unsigned char* LA = lds + PR_LA; LAS unsigned char* LG = lds + PR_LG;
    LAS float* GM = (LAS float*)(lds + PR_GM); LAS float* TM = (LAS float*)(lds + PR_TM); LAS float* PP = (LAS float*)(lds + PR_PP); LAS float* QQ = (LAS float*)(lds + PR_QQ);
    const int ttile = wid >> 2, ntile = wid & 3; const int ncol = h * 64 + ntile * 16 + fr;
    const int tt = tid >> 4, q = tid & 15, c0 = h * 64 + 4 * q;
    { const f32x4 mu_r = *(const f32x4*)(w.mu + c0), mu_k = *(const f32x4*)(w.mu + 512 + c0), mu_v = *(const f32x4*)(w.mu + 1024 + c0);
      const f32x4 mu_w = *(const f32x4*)(w.mu + 1536 + 4 * q), mu_a = *(const f32x4*)(w.mu + 1600 + 4 * q), mu_g0 = *(const f32x4*)(w.mu + 1664 + 8 * q), mu_g1 = *(const f32x4*)(w.mu + 1668 + 8 * q);
      f32x4 cr = ub4(ld.c[0]), ck = ub4(ld.c[1]), cv = ub4(ld.c[2]), cw = ub4(ld.c[3]), ca = ub4(ld.c[4]), cg0 = ub4(ld.c[5]), cg1 = ub4(ld.c[6]);
      const f32x4 pr = ub4(ld.p[0]), pk = ub4(ld.p[1]), pv = ub4(ld.p[2]), pw = ub4(ld.p[3]), pa = ub4(ld.p[4]), pg0 = ub4(ld.p[5]), pg1 = ub4(ld.p[6]);
      cr = cr + (pr - cr) * mu_r; ck = ck + (pk - ck) * mu_k; cv = cv + (pv - cv) * mu_v; cw = cw + (pw - cw) * mu_w; ca = ca + (pa - ca) * mu_a; cg0 = cg0 + (pg0 - cg0) * mu_g0; cg1 = cg1 + (pg1 - cg1) * mu_g1;
      *(LAS f32x4*)(XR + tt * PS + 4 * q) = cr; *(LAS f32x4*)(XK + tt * PS + 4 * q) = ck; *(LAS f32x4*)(XV + tt * PS + 4 * q) = cv;
      u32x2 o; o.x = pk2(tanh_fast(cw[0]), tanh_fast(cw[1])); o.y = pk2(tanh_fast(cw[2]), tanh_fast(cw[3])); *(LAS u32x2*)(LW + tt * 144 + 8 * q) = o;
      o.x = pk2(ca[0], ca[1]); o.y = pk2(ca[2], ca[3]); *(LAS u32x2*)(LA + tt * 144 + 8 * q) = o;
      u32x4 o4; o4.x = pk2(sigm(cg0[0]), sigm(cg0[1])); o4.y = pk2(sigm(cg0[2]), sigm(cg0[3])); o4.z = pk2(sigm(cg1[0]), sigm(cg1[1])); o4.w = pk2(sigm(cg1[2]), sigm(cg1[3])); *(LAS u32x4*)(LG + tt * 272 + 16 * q) = o4; }
    __syncthreads();
    if (next_item >= 0) prep_load(ld, next_item, ZB);
    { f32x4 wl = (f32x4){0.f, 0.f, 0.f, 0.f}, al = wl, gl = wl;
#pragma unroll
      for (int ks = 0; ks < 2; ++ks) { const bf16x8 aw = *(const LAS bf16x8*)(LW + (ttile * 16 + fr) * 144 + 64 * ks + 16 * fq), aa = *(const LAS bf16x8*)(LA + (ttile * 16 + fr) * 144 + 64 * ks + 16 * fq);
          const bf16x8 bw = *(const bf16x8*)(WlT + (size_t)ncol * 64 + 32 * ks + 8 * fq), ba = *(const bf16x8*)(AlT + (size_t)ncol * 64 + 32 * ks + 8 * fq);
          wl = __builtin_amdgcn_mfma_f32_16x16x32_bf16(aw, bw, wl, 0, 0, 0); al = __builtin_amdgcn_mfma_f32_16x16x32_bf16(aa, ba, al, 0, 0, 0); }
#pragma unroll
      for (int ks = 0; ks < 4; ++ks) { const bf16x8 ag = *(const LAS bf16x8*)(LG + (ttile * 16 + fr) * 272 + 64 * ks + 16 * fq); const bf16x8 bg = *(const bf16x8*)(GlT + (size_t)ncol * 128 + 32 * ks + 8 * fq);
          gl = __builtin_amdgcn_mfma_f32_16x16x32_bf16(ag, bg, gl, 0, 0, 0); }
#pragma unroll
      for (int e = 0; e < 4; ++e) { const int tr = ttile * 16 + 4 * fq + e, nc = ntile * 16 + fr; PW[tr * PS + nc] = wl[e]; PA[tr * PS + nc] = al[e]; PG[tr * PS + nc] = gl[e]; } }
    __syncthreads();
    { const f32x4 c_w0 = *(const f32x4*)(w.w0 + c0), c_a0 = *(const f32x4*)(w.a0 + c0), c_kk = *(const f32x4*)(w.k_k + c0), c_ka = *(const f32x4*)(w.k_a + c0), c_rk = *(const f32x4*)(w.r_k + c0);
      const f32x4 wl = *(LAS f32x4*)(PW + tt * PS + 4 * q), al = *(LAS f32x4*)(PA + tt * PS + 4 * q), gl = *(LAS f32x4*)(PG + tt * PS + 4 * q);
      const f32x4 r4 = *(LAS f32x4*)(XR + tt * PS + 4 * q), k4 = *(LAS f32x4*)(XK + tt * PS + 4 * q), v4 = *(LAS f32x4*)(XV + tt * PS + 4 * q);
      f32x4 dec, a4, kkr, kp; float ssq = 0.f, cs = 0.f;
#pragma unroll
      for (int e = 0; e < 4; ++e) { dec[e] = decay_of(c_w0[e], wl[e]); a4[e] = sigm(c_a0[e] + al[e]); kkr[e] = k4[e] * c_kk[e]; ssq += kkr[e] * kkr[e]; kp[e] = k4[e] * (1.f + (a4[e] - 1.f) * c_ka[e]); cs += r4[e] * kp[e] * c_rk[e]; }
      ssq = red16(ssq); cs = red16(cs); const float inv = 1.f / fmaxf(sqrtf(ssq), 1e-12f);
      const f32x4 kk = kkr * inv;
      *(LAS f32x4*)(PW + tt * PS + 4 * q) = dec; *(LAS f32x4*)(PA + tt * PS + 4 * q) = -kk; *(LAS f32x4*)(PG + tt * PS + 4 * q) = kk * a4; *(LAS f32x4*)(XK + tt * PS + 4 * q) = kp;
      const size_t off = ((size_t)b * T_ + t0 + tt) * 512 + c0; *(f32x4*)(G + off) = gl; *(f32x4*)(BON + off) = v4 * cs; }
    __syncthreads();
    unsigned char* rec0 = REC + (size_t)(bh * 128 + c32 * 2) * RC_BYTES;
    { const int s1 = wid >> 2, arr = wid & 3, k = lane; float Dc = 1.f; LAS float* dst = arr == 0 ? PA : (arr == 1 ? PG : (arr == 2 ? XK : XR));
      float wv[16], xv[16];
#pragma unroll
      for (int t = 0; t < 16; ++t) { const int o = (s1 * 16 + t) * PS + k; wv[t] = PW[o]; xv[t] = dst[o]; }
#pragma unroll
      for (int t = 0; t < 16; ++t) { const int o = (s1 * 16 + t) * PS + k; const float Dp = Dc; Dc *= wv[t];
          float f; if (arr == 0) f = Dp; else if (arr == 3) f = Dc; else f = __builtin_amdgcn_rcpf(Dc);
          dst[o] = xv[t] * f; }
      if (arr == 0) *(float*)(rec0 + (size_t)s1 * RC_BYTES + RC_DC + 4 * k) = Dc; }
    __syncthreads();
    const int s = wid >> 2;
    unsigned char* rec = rec0 + (size_t)s * RC_BYTES;
    { const int which = wid & 3; const LAS float* X = (which < 2) ? PA : XR; const LAS float* Yv = (which & 1) ? XK : PG;
      f32x4 acc = (f32x4){0.f, 0.f, 0.f, 0.f};
#pragma unroll
      for (int m = 0; m < 4; ++m) { const f32x4 xa = *(const LAS f32x4*)(X + (s * 16 + fr) * PS + 16 * m + 4 * fq), yb = *(const LAS f32x4*)(Yv + (s * 16 + fr) * PS + 16 * m + 4 * fq);
#pragma unroll
          for (int j = 0; j < 4; ++j) acc = __builtin_amdgcn_mfma_f32_16x16x4f32(xa[j], yb[j], acc, 0, 0, 0); }
#pragma unroll
      for (int e = 0; e < 4; ++e) { const int t = 4 * fq + e; const bool keep = (which < 2) ? (fr < t) : (fr <= t); GM[((s * 4 + which) * 16 + t) * 20 + fr] = keep ? acc[e] : 0.f; } }
    __syncthreads();
    if (tid >= 256) { const int u = tid - 256; const int ss = u >> 7, k = (u >> 1) & 63, half = u & 1; const LAS float* src = half ? XK : PG; unsigned char* rr = rec0 + (size_t)ss * RC_BYTES + RC_BK + k * 64;
#pragma unroll
        for (int c = 0; c < 2; ++c) { u32x4 o; const LAS float* p = src + (ss * 16 + 8 * c) * PS + k;
            o.x = pk2(p[0], p[PS]); o.y = pk2(p[2 * PS], p[3 * PS]); o.z = pk2(p[4 * PS], p[5 * PS]); o.w = pk2(p[6 * PS], p[7 * PS]);
            *(u32x4*)(rr + (((half * 2 + c) ^ ((k >> 2) & 3)) << 4)) = o; } }
    else if (tid >= 128) { const int ss = (tid - 128) >> 6, v = tid & 63; unsigned char* rr = rec0 + (size_t)ss * RC_BYTES + RC_VT + v * 32;
#pragma unroll
        for (int c = 0; c < 2; ++c) { u32x4 o; const LAS float* p = XV + (ss * 16 + 8 * c) * PS + v;
            o.x = pk2(p[0], p[PS]); o.y = pk2(p[2 * PS], p[3 * PS]); o.z = pk2(p[4 * PS], p[5 * PS]); o.w = pk2(p[6 * PS], p[7 * PS]);
            *(u32x4*)(rr + c * 16) = o; } }
    if (wid == 0 && lane < 32) { const int ss = lane >> 4, j = lane & 15; float x[16];
#pragma unroll
        for (int t = 0; t < 16; ++t) { float sum = (t == j) ? 1.f : 0.f; const LAS float* Lr = GM + ((ss * 4 + 0) * 16 + t) * 20;
#pragma unroll
            for (int i = 0; i < t; ++i) sum += Lr[i] * x[i];
            x[t] = sum; TM[(ss * 16 + t) * 20 + j] = sum;
            if ((t & 3) == 3) asm volatile("" ::: "memory"); } }
    __syncthreads();
    { const f32x4 ta = *(const LAS f32x4*)(TM + (s * 16 + fr) * 20 + 4 * fq); f32x4 acc = (f32x4){0.f, 0.f, 0.f, 0.f};
#pragma unroll
      for (int j = 0; j < 4; ++j) acc = __builtin_amdgcn_mfma_f32_16x16x4f32(ta[j], PA[(s * 16 + 4 * fq + j) * PS + ntile * 16 + fr], acc, 0, 0, 0);
#pragma unroll
      for (int e = 0; e < 4; ++e) { const int t = 4 * fq + e, k = ntile * 16 + fr; PP[(s * 16 + t) * PS + k] = acc[e];
          *(bf16_t*)(rec + RC_P + t * 128 + ((((k >> 3) ^ ((t >> 1) & 7))) << 4) + (k & 7) * 2) = (bf16_t)f2bf(acc[e]); }
      if (ntile == 0) { f32x4 aq = (f32x4){0.f, 0.f, 0.f, 0.f};
#pragma unroll
          for (int j = 0; j < 4; ++j) aq = __builtin_amdgcn_mfma_f32_16x16x4f32(ta[j], GM[((s * 4 + 1) * 16 + 4 * fq + j) * 20 + fr], aq, 0, 0, 0);
#pragma unroll
          for (int e = 0; e < 4; ++e) { const int t = 4 * fq + e; QQ[(s * 16 + t) * 20 + fr] = aq[e];
              *(bf16_t*)(rec + RC_Q + t * 64 + ((((fr >> 3)) ^ ((t >> 2) & 3)) << 4) + (fr & 7) * 2) = (bf16_t)f2bf(aq[e]);
              *(bf16_t*)(rec + RC_Q + t * 64 + (((2 + (fr >> 3)) ^ ((t >> 2) & 3)) << 4) + (fr & 7) * 2) = (bf16_t)0; } } }
    __syncthreads();
    { const f32x4 ma = *(const LAS f32x4*)(GM + ((s * 4 + 2) * 16 + fr) * 20 + 4 * fq); f32x4 acc;
#pragma unroll
      for (int e = 0; e < 4; ++e) acc[e] = XR[(s * 16 + 4 * fq + e) * PS + ntile * 16 + fr];
#pragma unroll
      for (int j = 0; j < 4; ++j) acc = __builtin_amdgcn_mfma_f32_16x16x4f32(ma[j], PP[(s * 16 + 4 * fq + j) * PS + ntile * 16 + fr], acc, 0, 0, 0);
#pragma unroll
      for (int e = 0; e < 4; ++e) { const int t = 4 * fq + e, k = ntile * 16 + fr; *(bf16_t*)(rec + RC_P2 + t * 128 + ((((k >> 3) ^ ((t >> 1) & 7))) << 4) + (k & 7) * 2) = (bf16_t)f2bf(acc[e]); }
      if (ntile == 0) { f32x4 aq;
#pragma unroll
          for (int e = 0; e < 4; ++e) aq[e] = GM[((s * 4 + 3) * 16 + 4 * fq + e) * 20 + fr];
#pragma unroll
          for (int j = 0; j < 4; ++j) aq = __builtin_amdgcn_mfma_f32_16x16x4f32(ma[j], QQ[(s * 16 + 4 * fq + j) * 20 + fr], aq, 0, 0, 0);
#pragma unroll
          for (int e = 0; e < 4; ++e) { const int t = 4 * fq + e;
              *(bf16_t*)(rec + RC_Q2 + t * 64 + ((((fr >> 3)) ^ ((t >> 2) & 3)) << 4) + (fr & 7) * 2) = (bf16_t)f2bf(aq[e]);
              *(bf16_t*)(rec + RC_Q2 + t * 64 + (((2 + (fr >> 3)) ^ ((t >> 2) & 3)) << 4) + (fr & 7) * 2) = (bf16_t)0; } } }
    __syncthreads();
}

struct Ops { bf16x8 P0, P1, P20, P21, Q, Q2, VT, BK0, BK1, BK2, BK3; f32x4 DC0, DC1, DC2, DC3; };
__device__ __forceinline__ void load_ops(Ops& o, const unsigned char* rec, int fr, int fq, int v0) {
    const int sw8 = (fr >> 1) & 7, sw4 = (fr >> 2) & 3;
    o.P0 = *(const bf16x8*)(rec + RC_P + fr * 128 + ((fq ^ sw8) << 4)); o.P1 = *(const bf16x8*)(rec + RC_P + fr * 128 + (((4 + fq) ^ sw8) << 4));
    o.P20 = *(const bf16x8*)(rec + RC_P2 + fr * 128 + ((fq ^ sw8) << 4)); o.P21 = *(const bf16x8*)(rec + RC_P2 + fr * 128 + (((4 + fq) ^ sw8) << 4));
    o.Q = *(const bf16x8*)(rec + RC_Q + fr * 64 + ((fq ^ sw4) << 4)); o.Q2 = *(const bf16x8*)(rec + RC_Q2 + fr * 64 + ((fq ^ sw4) << 4));
    o.VT = *(const bf16x8*)(rec + RC_VT + (v0 + fr) * 32 + (fq & 1) * 16);
    o.BK0 = *(const bf16x8*)(rec + RC_BK + (fr) * 64 + ((fq ^ sw4) << 4)); o.BK1 = *(const bf16x8*)(rec + RC_BK + (16 + fr) * 64 + ((fq ^ sw4) << 4));
    o.BK2 = *(const bf16x8*)(rec + RC_BK + (32 + fr) * 64 + ((fq ^ sw4) << 4)); o.BK3 = *(const bf16x8*)(rec + RC_BK + (48 + fr) * 64 + ((fq ^ sw4) << 4));
    o.DC0 = *(const f32x4*)(rec + RC_DC + (4 * fq) * 4); o.DC1 = *(const f32x4*)(rec + RC_DC + (16 + 4 * fq) * 4); o.DC2 = *(const f32x4*)(rec + RC_DC + (32 + 4 * fq) * 4); o.DC3 = *(const f32x4*)(rec + RC_DC + (48 + 4 * fq) * 4);
}
__device__ __forceinline__ void hilo_store(LAS unsigned char* Shi, LAS unsigned char* Slo, int fr, int fq, int mt, f32x4 sv) {
    u32x2 hi, lo; hi.x = pk2(sv[0], sv[1]); hi.y = pk2(sv[2], sv[3]);
    const float r0 = sv[0] - __builtin_bit_cast(float, hi.x << 16), r1 = sv[1] - __builtin_bit_cast(float, hi.x & 0xffff0000u), r2 = sv[2] - __builtin_bit_cast(float, hi.y << 16), r3 = sv[3] - __builtin_bit_cast(float, hi.y & 0xffff0000u);
    lo.x = pk2(r0, r1); lo.y = pk2(r2, r3);
    *(LAS u32x2*)(Shi + fr * 144 + (16 * mt + 4 * fq) * 2) = hi; *(LAS u32x2*)(Slo + fr * 144 + (16 * mt + 4 * fq) * 2) = lo;
}
__device__ __forceinline__ void seq_step(const Ops& o, f32x4 (&st)[4], LAS unsigned char* Shi, LAS unsigned char* Slo, LAS unsigned char* Ul, int fr, int fq, float* yrow) {
    hilo_store(Shi, Slo, fr, fq, 0, st[0]); hilo_store(Shi, Slo, fr, fq, 1, st[1]); hilo_store(Shi, Slo, fr, fq, 2, st[2]); hilo_store(Shi, Slo, fr, fq, 3, st[3]);
    asm volatile("s_waitcnt lgkmcnt(0)" ::: "memory");
    const bf16x8 sh0 = *(const LAS bf16x8*)(Shi + fr * 144 + 16 * fq), sh1 = *(const LAS bf16x8*)(Shi + fr * 144 + 64 + 16 * fq), sl0 = *(const LAS bf16x8*)(Slo + fr * 144 + 16 * fq), sl1 = *(const LAS bf16x8*)(Slo + fr * 144 + 64 + 16 * fq);
    const bf16x8 zero8 = (bf16x8){0, 0, 0, 0, 0, 0, 0, 0}; const bf16x8 vq = (fq < 2) ? o.VT : zero8;
    f32x4 ut = (f32x4){0.f, 0.f, 0.f, 0.f}, yt = ut;
    ut = __builtin_amdgcn_mfma_f32_16x16x32_bf16(o.P0, sh0, ut, 0, 0, 0); yt = __builtin_amdgcn_mfma_f32_16x16x32_bf16(o.P20, sh0, yt, 0, 0, 0);
    ut = __builtin_amdgcn_mfma_f32_16x16x32_bf16(o.P1, sh1, ut, 0, 0, 0); yt = __builtin_amdgcn_mfma_f32_16x16x32_bf16(o.P21, sh1, yt, 0, 0, 0);
    ut = __builtin_amdgcn_mfma_f32_16x16x32_bf16(o.P0, sl0, ut, 0, 0, 0); yt = __builtin_amdgcn_mfma_f32_16x16x32_bf16(o.P20, sl0, yt, 0, 0, 0);
    ut = __builtin_amdgcn_mfma_f32_16x16x32_bf16(o.P1, sl1, ut, 0, 0, 0); yt = __builtin_amdgcn_mfma_f32_16x16x32_bf16(o.P21, sl1, yt, 0, 0, 0);
    ut = __builtin_amdgcn_mfma_f32_16x16x32_bf16(o.Q, vq, ut, 0, 0, 0); yt = __builtin_amdgcn_mfma_f32_16x16x32_bf16(o.Q2, vq, yt, 0, 0, 0);
    { u32x2 uu; uu.x = pk2(ut[0], ut[1]); uu.y = pk2(ut[2], ut[3]); *(LAS u32x2*)(Ul + fr * 48 + 8 * fq) = uu; }
#pragma unroll
    for (int e = 0; e < 4; ++e) yrow[(size_t)(4 * fq + e) * 512] = yt[e];
    asm volatile("s_waitcnt lgkmcnt(0)" ::: "memory");
    const bf16x8 uf = *(const LAS bf16x8*)(Ul + fr * 48 + 16 * (fq & 1)); const bf16x8 uv = (fq < 2) ? uf : o.VT;
    st[0] = __builtin_amdgcn_mfma_f32_16x16x32_bf16(o.BK0, uv, st[0], 0, 0, 0); st[1] = __builtin_amdgcn_mfma_f32_16x16x32_bf16(o.BK1, uv, st[1], 0, 0, 0);
    st[2] = __builtin_amdgcn_mfma_f32_16x16x32_bf16(o.BK2, uv, st[2], 0, 0, 0); st[3] = __builtin_amdgcn_mfma_f32_16x16x32_bf16(o.BK3, uv, st[3], 0, 0, 0);
    st[0] = st[0] * o.DC0; st[1] = st[1] * o.DC1; st[2] = st[2] * o.DC2; st[3] = st[3] * o.DC3;
}
__device__ __forceinline__ void seq_unit(LAS unsigned char* lds, int bh, int wv, const unsigned char* REC, float* Y, float* out) {
    const int lane = threadIdx.x & 63, fr = lane & 15, fq = lane >> 4, v0 = wv * 16, b = bh >> 3, h = bh & 7;
    LAS unsigned char* Shi = lds + wv * 5376; LAS unsigned char* Slo = Shi + 2304; LAS unsigned char* Ul = Slo + 2304;
    f32x4 st[4];
#pragma unroll
    for (int i = 0; i < 4; ++i) st[i] = (f32x4){0.f, 0.f, 0.f, 0.f};
    const unsigned char* rec = REC + (size_t)bh * 128 * RC_BYTES;
    float* ybase = Y + (size_t)b * T_ * 512 + h * 64 + v0 + fr;
    Ops A, B; load_ops(A, rec, fr, fq, v0);
    for (int c = 0; c < 128; c += 2) {
        load_ops(B, rec + (size_t)(c + 1) * RC_BYTES, fr, fq, v0);
        seq_step(A, st, Shi, Slo, Ul, fr, fq, ybase + (size_t)(c * 16) * 512);
        if (c + 2 < 128) load_ops(A, rec + (size_t)(c + 2) * RC_BYTES, fr, fq, v0);
        seq_step(B, st, Shi, Slo, Ul, fr, fq, ybase + (size_t)((c + 1) * 16) * 512);
    }
#pragma unroll
    for (int mt = 0; mt < 4; ++mt) *(f32x4*)(out + O_WKVP + ((size_t)(b * 8 + h) * 64 + v0 + fr) * 64 + 16 * mt + 4 * fq) = st[mt];
}

struct Args { const float* in[28]; float* out; unsigned char* ws; int ph_lo, ph_hi; };
constexpr int N_PH = 10;

__global__ void __launch_bounds__(512, 2) fwd_kernel(Args args) {
    extern __shared__ __attribute__((aligned(16))) unsigned char lds_raw[];
    LAS unsigned char* lds = (LAS unsigned char*)lds_raw;
    const int tid = threadIdx.x, lane = tid & 63, wid = __builtin_amdgcn_readfirstlane(tid >> 6);
    const int G = gridDim.x, bx = blockIdx.x;
    const int gw = bx * 8 + wid, NGW = G * 8;
    unsigned char* ws = args.ws; float* out = args.out;
    const float* x = args.in[0]; const float* xs = args.in[1];
    unsigned* ctl = (unsigned*)(ws + WS_CTL);
    float* SS1 = (float*)(ws + CTL_SS1); float* SS1S = (float*)(ws + CTL_SS1S); float* SS2 = (float*)(ws + CTL_SS2); float* SS2S = (float*)(ws + CTL_SS2S);
    bf16_t* WinT = (bf16_t*)(ws + WS_WIN); bf16_t* WaT = (bf16_t*)(ws + WS_WA); bf16_t* WbT = (bf16_t*)(ws + WS_WB); bf16_t* WoT = (bf16_t*)(ws + WS_WO); bf16_t* WupT = (bf16_t*)(ws + WS_WUP); bf16_t* WdnT = (bf16_t*)(ws + WS_WDN);
    bf16_t* WlT = (bf16_t*)(ws + WS_WL); bf16_t* AlT = (bf16_t*)(ws + WS_AL); bf16_t* GlT = (bf16_t*)(ws + WS_GL);
    unsigned char* sm = ws + WS_SMALL;
    bf16_t* H1S = (bf16_t*)(sm + SM_H1S); float* ZS = (float*)(sm + SM_ZS); bf16_t* ATTS = (bf16_t*)(sm + SM_ATTS); bf16_t* RWS = (bf16_t*)(sm + SM_RWS); bf16_t* MGS = (bf16_t*)(sm + SM_MGS); bf16_t* X1GS = (bf16_t*)(sm + SM_X1GS); bf16_t* US = (bf16_t*)(sm + SM_US);
    bf16_t* H1 = (bf16_t*)(ws + WS_H1); bf16_t* QKV = (bf16_t*)(ws + WS_QKV); bf16_t* ZB = (bf16_t*)(ws + WS_ZB); bf16_t* U = (bf16_t*)(ws + WS_U); bf16_t* GATE = (bf16_t*)(ws + WS_GATE);
    bf16_t* OG = (bf16_t*)(ws + WS_OG); float* LSE = (float*)(ws + WS_LSE); bf16_t* ATT = (bf16_t*)(ws + WS_ATT); bf16_t* RW = (bf16_t*)(ws + WS_RW); bf16_t* MG = (bf16_t*)(ws + WS_MG);
    float* Yb = (float*)(ws + WS_Y); float* Gb = (float*)(ws + WS_G); float* BON = (float*)(ws + WS_BON); float* TMP = (float*)(ws + WS_TMP);
    SP sp; sp.ZS = ZS; sp.b_gate = args.in[9]; sp.out = out; sp.xs = xs; sp.g2 = args.in[24]; sp.MGS = MGS; sp.X1GS = X1GS; sp.US = US; sp.SS1S = SS1S; sp.SS2S = SS2S;
    const int lo = args.ph_lo, hi = args.ph_hi;
    if (tid < 32) ((volatile LAS unsigned*)(lds + MISC_OFF))[tid] = 0u;
    __syncthreads();
    if (lo < 0) cg::this_grid().sync();
    XcdBarrier xbar = xcd_barrier_post((unsigned*)(ws + CTL_BAR), (volatile LAS unsigned*)(lds + MISC_OFF) + 8);
#ifndef MK_ONLY
#define MK_ONLY -1
#endif
#define IN(k) ((MK_ONLY < 0 || MK_ONLY == (k)) && lo <= (k) && (k) < hi)
#define SEAM(k) do { if (IN(k) && IN((k) + 1)) { xcd_barrier(xbar); } } while (0)

    if (IN(0)) {
        LAS float* scr = (LAS float*)(lds + wid * 16384);
        constexpr int I_IN = 16 * 192, I_A = 4 * 32, I_B = 8 * 32, I_O = 16 * 32, I_UP = 16 * 128, I_DN = 64 * 32, I_WL = 16, I_AL = 16, I_GL = 32;
        constexpr int NITEMS = I_IN + I_A + I_B + I_O + I_UP + I_DN + I_WL + I_AL + I_GL;
        for (int it = gw; it < NITEMS; it += NGW) {
            int r = it;
            if (r < I_IN) { p0_transpose_item(args.in[8], 1024, 6144, WinT, scr, r, lane); continue; } r -= I_IN;
            if (r < I_A) { p0_transpose_item(args.in[21], 256, 1024, WaT, scr, r, lane); continue; } r -= I_A;
            if (r < I_B) { p0_transpose_item(args.in[22], 512, 1024, WbT, scr, r, lane); continue; } r -= I_B;
            if (r < I_O) { p0_transpose_item(args.in[23], 1024, 1024, WoT, scr, r, lane); continue; } r -= I_O;
            if (r < I_UP) { p0_transpose_item(args.in[25], 1024, 4096, WupT, scr, r, lane); continue; } r -= I_UP;
            if (r < I_DN) { p0_transpose_item(args.in[26], 4096, 1024, WdnT, scr, r, lane); continue; } r -= I_DN;
            if (r < I_WL) { p0_transpose_item(args.in[12], 64, 512, WlT, scr, r, lane); continue; } r -= I_WL;
            if (r < I_AL) { p0_transpose_item(args.in[14], 64, 512, AlT, scr, r, lane); continue; } r -= I_AL;
            p0_transpose_item(args.in[15], 128, 512, GlT, scr, r, lane);
        }
        for (int m = gw; m < M_ + MS_; m += NGW) { if (m < M_) rms_row_to_bf16(x + (size_t)m * D_, args.in[7], H1 + (size_t)m * D_, lane); else rms_row_to_bf16(xs + (size_t)(m - M_) * D_, args.in[7], H1S + (size_t)(m - M_) * D_, lane); }
        __syncthreads();
    }
    SEAM(0);
    if (IN(1)) {
        pg8::Gemm g{H1, WinT, M_, NIN_, D_}; pg8::StaticOrder S; S.init(M_, NIN_, G, bx);
        EpiZ E{QKV, ZB, GATE, args.in[9], out};
        pg8::gemm_phase<EpiZ, pg8::StaticOrder, true, true>(lds, g, S, E);
        sample_gemm<0>(lds, H1S, D_, WinT, nullptr, 0, nullptr, NIN_, sp);
    }
    SEAM(1);
    RwW w; w.mu = args.in[10]; w.w0 = args.in[11]; w.wl = args.in[12]; w.a0 = args.in[13]; w.al = args.in[14]; w.gl = args.in[15]; w.k_k = args.in[16]; w.k_a = args.in[17]; w.r_k = args.in[18]; w.gn_g = args.in[19]; w.gn_b = args.in[20];
    unsigned char* REC = ws + WS_REC;
    if (IN(2)) {
        for (int rep = 0; rep < PROBE_PREP; ++rep)
        { PrepLd ld; prep_load(ld, bx, ZB);
          for (int it = bx; it < 4096; it += G) prep_item(lds, it, (it + G < 4096) ? it + G : -1, ld, ZB, w, WlT, AlT, GlT, Gb, BON, REC); }
    }
    SEAM(2);
    if (IN(3)) {
        for (int rep = 0; rep < PROBE_SEQ; ++rep)
        if (bx < 64 && wid < 4) seq_unit(lds, bx, wid, REC, Yb, out);
        __syncthreads();
        volatile LAS int* qslot = (volatile LAS int*)(lds + MISC_OFF);
        constexpr int NQ = 32 + 256 + 1536;
        for (;;) {
            if (tid == 0) *qslot = (int)atomicAdd(ctl, 1u);
            __syncthreads(); int item = *qslot; __syncthreads();
            if (item >= NQ * PROBE_ATTN) break;
            item = item % NQ;
            if (item < 32) sample_attn(lds, item, ZS, args.in[2], args.in[3], args.in[4], ATTS);
            else if (item < 288) sample_rwkv(lds, item - 32, ZS, args.in[5], args.in[6], w, out, RWS);
            else attn_unit(lds, item - 288, QKV, OG, LSE);
        }
    }
    SEAM(3);
    if (IN(4)) {
        const float* gn_g = args.in[19]; const float* gn_b = args.in[20];
        for (int m = gw; m < M_; m += NGW) {
            { const int hs = lane >> 4; const float l0 = LSE[(size_t)m * 12 + hs], l1 = LSE[(size_t)m * 12 + 4 + hs], l2 = LSE[(size_t)m * 12 + 8 + hs]; const float mm = fmaxf(l0, fmaxf(l1, l2));
              const float w0 = __expf(l0 - mm), w1 = __expf(l1 - mm), w2 = __expf(l2 - mm); const float inv = 1.f / (w0 + w1 + w2);
              const f32x4 o0 = load4bf(OG + (size_t)m * 768 + 4 * lane), o1 = load4bf(OG + (size_t)m * 768 + 256 + 4 * lane), o2 = load4bf(OG + (size_t)m * 768 + 512 + 4 * lane);
              store4bf(ATT + (size_t)m * 256 + 4 * lane, (o0 * w0 + o1 * w1 + o2 * w2) * inv); }
            { const size_t off = (size_t)m * 512 + 8 * lane; const f32x4 y0 = *(const f32x4*)(Yb + off), y1 = *(const f32x4*)(Yb + off + 4);
              const float mu = red8((y0[0] + y0[1]) + (y0[2] + y0[3]) + (y1[0] + y1[1]) + (y1[2] + y1[3])) * (1.f / 64.f); const f32x4 d0 = y0 - mu, d1 = y1 - mu;
              const float var = red8((d0[0] * d0[0] + d0[1] * d0[1]) + (d0[2] * d0[2] + d0[3] * d0[3]) + (d1[0] * d1[0] + d1[1] * d1[1]) + (d1[2] * d1[2] + d1[3] * d1[3])) * (1.f / 64.f); const float rstd = rsqrtf(var + GN_EPS);
              const f32x4 g0 = *(const f32x4*)(gn_g + 8 * lane), g1 = *(const f32x4*)(gn_g + 8 * lane + 4), b0 = *(const f32x4*)(gn_b + 8 * lane), b1 = *(const f32x4*)(gn_b + 8 * lane + 4);
              const f32x4 bo0 = *(const f32x4*)(BON + off), bo1 = *(const f32x4*)(BON + off + 4), gg0 = *(const f32x4*)(Gb + off), gg1 = *(const f32x4*)(Gb + off + 4);
              store8bf(RW + off, (d0 * rstd * g0 + b0 + bo0) * gg0, (d1 * rstd * g1 + b1 + bo1) * gg1); }
        }
    }
    SEAM(4);
    if (IN(5)) {
        pg8::StaticOrder S; S.init(M_, D_, G, bx);
        int ka = 256, kb = 512; asm volatile("" : "+s"(ka), "+s"(kb));
        { pg8::Gemm g{ATT, WaT, M_, D_, ka}; EpiPA E{GATE, TMP}; pg8::gemm_phase<EpiPA, pg8::StaticOrder, true, true>(lds, g, S, E); }
        { pg8::Gemm g{RW, WbT, M_, D_, kb}; EpiPB E{GATE, TMP, MG}; pg8::gemm_phase<EpiPB, pg8::StaticOrder, true, true>(lds, g, S, E); }
        sample_gemm<1>(lds, ATTS, 256, WaT, RWS, 512, WbT, D_, sp);
    }
    SEAM(5);
    if (IN(6)) {
        pg8::Gemm g{MG, WoT, M_, D_, D_}; pg8::StaticOrder S; S.init(M_, D_, G, bx);
        EpiRes<true> E{x, out + O_Y, H1, args.in[24], SS1};
        pg8::gemm_phase<EpiRes<true>, pg8::StaticOrder, true, true>(lds, g, S, E);
        sample_gemm<2>(lds, MGS, D_, WoT, nullptr, 0, nullptr, D_, sp);
    }
    SEAM(6);
    if (IN(7)) {
        pg8::Gemm g{H1, WupT, M_, FF_, D_}; pg8::StaticOrder S; S.init(M_, FF_, G, bx);
        EpiUp E{SS1, U};
        pg8::gemm_phase<EpiUp, pg8::StaticOrder, true, true>(lds, g, S, E);
        sample_gemm<3>(lds, X1GS, D_, WupT, nullptr, 0, nullptr, FF_, sp);
    }
    SEAM(7);
    if (IN(8)) {
        pg8::Gemm g{U, WdnT, M_, D_, FF_}; pg8::StaticOrder S; S.init(M_, D_, G, bx);
        EpiRes<false> E{out + O_Y, out + O_Y, nullptr, nullptr, SS2};
        pg8::gemm_phase<EpiRes<false>, pg8::StaticOrder, true, true>(lds, g, S, E);
        sample_gemm<4>(lds, US, FF_, WdnT, nullptr, 0, nullptr, D_, sp);
    }
    SEAM(8);
    if (IN(9)) {
        const float* gf = args.in[27];
        for (int m = gw; m < M_ + MS_; m += NGW) {
            float* row = (m < M_) ? (out + O_Y + (size_t)m * D_) : (out + O_YS + (size_t)(m - M_) * D_); const float ss = (m < M_) ? SS2[m] : SS2S[m - M_];
            const float rs = rsqrtf(ss * (1.f / D_) + NORM_EPS);
#pragma unroll
            for (int j = 0; j < 4; ++j) { f32x4* p = (f32x4*)row + lane + 64 * j; const f32x4 gg = *((const f32x4*)gf + lane + 64 * j); *p = *p * rs * gg; }
        }
    }
#undef IN
#undef SEAM
}
}

#ifndef MK_N_LAUNCHES
#define MK_N_LAUNCHES 1
#endif
extern "C" void kernel_launch(void* const* d_in, const int* in_sizes, int n_in, void* d_out, int out_size, void* d_ws, size_t ws_size, hipStream_t stream) {
    static int grid = 0;
    if (grid == 0) {
        if (n_in != 28 || (size_t)out_size != mk::O_END || ws_size < mk::WS_END) { fprintf(stderr, "kernel_launch: unexpected shapes: n_in %d out %d ws %zu\n", n_in, out_size, ws_size); grid = -1; return; }
        int dev = 0, cus = 0, per_cu = 0;
        if (hipGetDevice(&dev) != hipSuccess || hipDeviceGetAttribute(&cus, hipDeviceAttributeMultiprocessorCount, dev) != hipSuccess) { grid = -1; return; }
        if (hipFuncSetAttribute((const void*)mk::fwd_kernel, hipFuncAttributeMaxDynamicSharedMemorySize, mk::LDS_BYTES) != hipSuccess) { fprintf(stderr, "kernel_launch: hipFuncSetAttribute failed\n"); grid = -1; return; }
        if (hipOccupancyMaxActiveBlocksPerMultiprocessor(&per_cu, (const void*)mk::fwd_kernel, 512, mk::LDS_BYTES) != hipSuccess || per_cu < 1) { fprintf(stderr, "kernel_launch: occupancy query says %d\n", per_cu); }
        (void)hipGetLastError();
        grid = cus;
    }
    if (grid < 0) return;
    (void)hipMemsetAsync((char*)d_ws + mk::WS_CTL, 0, mk::CTL_ZERO_BYTES, stream);
    mk::Args a{};
    for (int i = 0; i < 28; ++i) a.in[i] = (const float*)d_in[i];
    a.out = (float*)d_out; a.ws = (unsigned char*)d_ws;
    if (MK_N_LAUNCHES == 1) {
        a.ph_lo = 0; a.ph_hi = mk::N_PH;
        void* params[] = {&a};
        hipError_t e = hipLaunchCooperativeKernel((const void*)mk::fwd_kernel, dim3(grid), dim3(512), params, mk::LDS_BYTES, stream);
        if (e != hipSuccess) fprintf(stderr, "cooperative launch failed: %s (grid %d)\n", hipGetErrorString(e), grid);
    } else {
        for (int ph = 0; ph < mk::N_PH; ++ph) { a.ph_lo = ph; a.ph_hi = ph + 1; hipLaunchKernelGGL(mk::fwd_kernel, dim3(grid), dim3(512), mk::LDS_BYTES, stream, a); }
    }
}
```

```cpp
#include <hip/hip_runtime.h>
#include <hip/hip_cooperative_groups.h>
#include <cstdio>
#include <cstdint>
namespace cg = cooperative_groups;
namespace pg8 {
#define PG8_LAS __attribute__((address_space(3)))
typedef unsigned short bf16_t;
typedef short bf16x8 __attribute__((ext_vector_type(8)));
typedef float f32x4 __attribute__((ext_vector_type(4)));
typedef unsigned u32x4 __attribute__((ext_vector_type(4)));
constexpr int BM = 256, BK = 64, HALF = 128, HTB = HALF * BK * 2  , STAGE_BYTES = 8 * HTB, NXCD = 8, WGM = 8;

__host__ __device__ __forceinline__ int lds_byte(int r, int c) { const int st = (r >> 4) * 2 + (c >> 5), rr = r & 15, cc = c & 31, ob = rr * 64 + cc * 2; return st * 1024 + (ob ^ (((ob >> 9) & 1) << 5)); }
__host__ __device__ __forceinline__ void stage_rc(int b, int& R, int& C) { const int st = b / 1024, sb = b % 1024, swz = sb ^ (((sb >> 9) & 1) << 5); R = (st >> 1) * 16 + swz / 64; C = (st & 1) * 32 + (swz % 64) / 2; }
__host__ __device__ __forceinline__ int perm32(int rho) { const int n = rho >> 4, i = rho & 15; return 8 * (i >> 2) + 4 * n + (i & 3); }

struct Unit { int pm, pn; };
struct Gemm { const bf16_t* A; const bf16_t* Bt; int M, N, K; };

struct StaticOrder {
    int nM, nN, nwg, G, c;
    __host__ __device__ void init(int M, int N, int G_, int c_) { nM = M / BM; nN = N / BM; nwg = nM * nN; G = G_; c = c_; }
    __host__ __device__ bool next(int i, Unit& u) const {
        const long L = (long)i * G + c; if (L >= nwg) return false;
        int wgid = (int)L; { const int q = nwg / NXCD, r = nwg % NXCD, xcd = wgid % NXCD, off = wgid / NXCD; wgid = (xcd < r ? xcd * (q + 1) : r * (q + 1) + (xcd - r) * q) + off; }
        const int nig = WGM * nN, gid = wgid / nig, fm = gid * WGM, gsz = (nM - fm) < WGM ? (nM - fm) : WGM;
        u.pm = fm + ((wgid % nig) % gsz); u.pn = (wgid % nig) / gsz; return true;
    }
    __device__ __forceinline__ void a_ready(const Unit&) const {}
    __device__ __forceinline__ void done(const Unit&) const {}
};

__device__ __forceinline__ unsigned cvt_pk_bf16(float lo, float hi) { unsigned r; asm volatile("v_cvt_pk_bf16_f32 %0, %1, %2" : "=v"(r) : "v"(lo), "v"(hi)); return r; }
template <class Epi, class Sched, bool ALIGN_EPI = false, bool SP2 = false>
__device__ __forceinline__ void gemm_phase(PG8_LAS unsigned char* lds, const Gemm g, const Sched& S, const Epi& E) {
    const int tid = threadIdx.x, wid = __builtin_amdgcn_readfirstlane(tid >> 6), lane = tid & 63, wr = wid >> 2, wc = wid & 3, fr = lane & 15, fq = lane >> 4;
    const int K = g.K, nt = K / BK;
    unsigned voffA[2], voffB[2];
#pragma unroll
    for (int i = 0; i < 2; ++i) { int R, C; stage_rc(tid * 16 + i * 8192, R, C); const int Rb = Epi::PERM ? ((R & ~31) + perm32(R & 31)) : R;
        voffA[i] = (unsigned)(R * K + C) * 2u; voffB[i] = (unsigned)(Rb * K + C) * 2u; }
    const size_t kstep = (size_t)(BK * 2);
    const size_t hstep = (size_t)HALF * K * 2;
    const size_t tstep = 2 * hstep;
    const unsigned ldsw = (unsigned)wid * 1024u;
    const int aoff = lds_byte(wr * 64 + fr, fq * 8), boff = lds_byte(wc * 32 + fr, fq * 8);
#define PG8_SA(b, h) (((b) * 2 + (h)) * HTB)
#define PG8_SB(b, h) ((4 + (b) * 2 + (h)) * HTB)
#define PG8_STAGE(bufoff, gbase, voff) do { _Pragma("unroll") for (int _i = 0; _i < 2; ++_i) \
        __builtin_amdgcn_global_load_lds((const unsigned*)((const char*)(gbase) + (voff)[_i]), (PG8_LAS unsigned*)(lds + (bufoff) + ldsw + _i * 8192), 16, 0, 0); } while (0)
#define PG8_LDA(dst, b, h) do { _Pragma("unroll") for (int m = 0; m < 4; ++m) _Pragma("unroll") for (int k = 0; k < 2; ++k) dst[m][k] = *(const PG8_LAS bf16x8*)(lds + PG8_SA(b, h) + aoff + m * 2048 + k * 1024); } while (0)
#define PG8_LDB(dst, b, h) do { _Pragma("unroll") for (int n = 0; n < 2; ++n) _Pragma("unroll") for (int k = 0; k < 2; ++k) dst[n][k] = *(const PG8_LAS bf16x8*)(lds + PG8_SB(b, h) + boff + n * 2048 + k * 1024); } while (0)
#define PG8_MMA(ai, bj, At, Bt) do { __builtin_amdgcn_s_setprio(1); _Pragma("unroll") for (int m = 0; m < 4; ++m) _Pragma("unroll") for (int n = 0; n < 2; ++n) _Pragma("unroll") for (int k = 0; k < 2; ++k) \
        acc[ai][bj][m][n] = __builtin_amdgcn_mfma_f32_16x16x32_bf16(Bt[n][k], At[m][k], acc[ai][bj][m][n], 0, 0, 0); __builtin_amdgcn_s_setprio(0); } while (0)
#define PG8_WAIT_V(n) asm volatile("s_waitcnt vmcnt(" #n ")" ::: "memory")
#define PG8_WAIT_L(n) asm volatile("s_waitcnt lgkmcnt(" #n ")" ::: "memory")
#define PG8_BAR __builtin_amdgcn_s_barrier()
#define PG8_SCHED __builtin_amdgcn_sched_barrier(0)
    Unit cur, nxt; int ui = 0;
    if (!S.next(0, cur)) return;
    f32x4 acc[2][2][4][2];
#pragma unroll
    for (int a = 0; a < 2; ++a)
#pragma unroll
        for (int b = 0; b < 2; ++b)
#pragma unroll
            for (int m = 0; m < 4; ++m)
#pragma unroll
                for (int n = 0; n < 2; ++n) acc[a][b][m][n] = (f32x4){0.f, 0.f, 0.f, 0.f};
    bf16x8 At[4][2], B0[2][2], B1[2][2];
    const char* cA = (const char*)g.A + (size_t)cur.pm * tstep; const char* cB = (const char*)g.Bt + (size_t)cur.pn * tstep;
    S.a_ready(cur);
    if constexpr (SP2) {
        PG8_STAGE(PG8_SB(0, 0), cB, voffB); PG8_STAGE(PG8_SB(0, 1), cB + hstep, voffB); PG8_STAGE(PG8_SA(0, 0), cA, voffA); PG8_STAGE(PG8_SA(0, 1), cA + hstep, voffA);
        if (wr == 1) PG8_BAR;
        PG8_WAIT_V(2); PG8_BAR;
        PG8_STAGE(PG8_SB(1, 0), cB + kstep, voffB); PG8_STAGE(PG8_SA(1, 0), cA + kstep, voffA); PG8_STAGE(PG8_SB(1, 1), cB + hstep + kstep, voffB);
        PG8_WAIT_V(6); PG8_BAR;
    } else {
        PG8_STAGE(PG8_SB(0, 0), cB, voffB); PG8_STAGE(PG8_SA(0, 0), cA, voffA); PG8_STAGE(PG8_SB(0, 1), cB + hstep, voffB); PG8_STAGE(PG8_SA(0, 1), cA + hstep, voffA);
        if (wr == 1) PG8_BAR;
        PG8_WAIT_V(4); PG8_BAR;
        PG8_STAGE(PG8_SB(1, 0), cB + kstep, voffB); PG8_STAGE(PG8_SA(1, 0), cA + kstep, voffA); PG8_STAGE(PG8_SB(1, 1), cB + hstep + kstep, voffB);
        PG8_WAIT_V(6); PG8_BAR;
    }
    for (;;) {
        const bool has_next = S.next(ui + 1, nxt);
        const char* nA = has_next ? (const char*)g.A + (size_t)nxt.pm * tstep : cA; const char* nB = has_next ? (const char*)g.Bt + (size_t)nxt.pn * tstep : cB;
        for (int t = 0; t < nt; t += 2) {
            const bool last = (t == nt - 2);
            const char* a1 = cA + (size_t)(t + 1) * kstep;
            const char* a2 = last ? nA : cA + (size_t)(t + 2) * kstep; const char* b2 = last ? nB : cB + (size_t)(t + 2) * kstep;
            const char* a3 = a2 + kstep; const char* b3 = b2 + kstep;
            if (last && has_next) S.a_ready(nxt);
            if constexpr (SP2) {
            PG8_LDB(B0, 0, 0); PG8_LDB(B1, 0, 1); PG8_SCHED; PG8_LDA(At, 0, 0); PG8_STAGE(PG8_SA(1, 1), a1 + hstep, voffA);
            PG8_WAIT_V(8); PG8_WAIT_L(0); PG8_BAR; PG8_MMA(0, 0, At, B0); PG8_MMA(0, 1, At, B1); PG8_BAR; PG8_SCHED;
            PG8_LDA(At, 0, 1); PG8_STAGE(PG8_SB(0, 0), b2, voffB); PG8_STAGE(PG8_SB(0, 1), b2 + hstep, voffB); PG8_STAGE(PG8_SA(0, 0), a2, voffA);
            PG8_WAIT_V(8); PG8_WAIT_L(0); PG8_BAR; PG8_MMA(1, 0, At, B0); PG8_MMA(1, 1, At, B1); PG8_BAR; PG8_SCHED;
            PG8_LDB(B0, 1, 0); PG8_LDB(B1, 1, 1); PG8_SCHED; PG8_LDA(At, 1, 0); PG8_STAGE(PG8_SA(0, 1), a2 + hstep, voffA);
            PG8_WAIT_V(8); PG8_WAIT_L(0); PG8_BAR; PG8_MMA(0, 0, At, B0); PG8_MMA(0, 1, At, B1); PG8_BAR; PG8_SCHED;
            PG8_LDA(At, 1, 1); PG8_STAGE(PG8_SB(1, 0), b3, voffB); PG8_STAGE(PG8_SB(1, 1), b3 + hstep, voffB); PG8_STAGE(PG8_SA(1, 0), a3, voffA);
            PG8_WAIT_V(8); PG8_WAIT_L(0); PG8_BAR; PG8_MMA(1, 0, At, B0); PG8_MMA(1, 1, At, B1); PG8_BAR; PG8_SCHED;
            } else {
            PG8_LDB(B0, 0, 0); PG8_SCHED; PG8_LDA(At, 0, 0); PG8_STAGE(PG8_SA(1, 1), a1 + hstep, voffA);
            PG8_WAIT_L(8); PG8_BAR; PG8_WAIT_L(0); PG8_MMA(0, 0, At, B0); PG8_BAR; PG8_SCHED;
            PG8_LDB(B1, 0, 1); PG8_STAGE(PG8_SB(0, 0), b2, voffB);
            PG8_BAR; PG8_WAIT_L(0); PG8_MMA(0, 1, At, B1); PG8_BAR;
            PG8_LDA(At, 0, 1); PG8_STAGE(PG8_SA(0, 0), a2, voffA);
            PG8_BAR; PG8_WAIT_L(0); PG8_MMA(1, 0, At, B0); PG8_BAR; PG8_SCHED;
            PG8_STAGE(PG8_SB(0, 1), b2 + hstep, voffB);
            PG8_WAIT_V(6); PG8_BAR; PG8_MMA(1, 1, At, B1); PG8_BAR;
            PG8_LDB(B0, 1, 0); PG8_SCHED; PG8_LDA(At, 1, 0); PG8_STAGE(PG8_SA(0, 1), a2 + hstep, voffA);
            PG8_WAIT_L(8); PG8_BAR; PG8_WAIT_L(0); PG8_MMA(0, 0, At, B0); PG8_BAR; PG8_SCHED;
            PG8_LDB(B1, 1, 1); PG8_STAGE(PG8_SB(1, 0), b3, voffB);
            PG8_BAR; PG8_WAIT_L(0); PG8_MMA(0, 1, At, B1); PG8_BAR;
            PG8_LDA(At, 1, 1); PG8_STAGE(PG8_SA(1, 0), a3, voffA);
            PG8_BAR; PG8_WAIT_L(0); PG8_MMA(1, 0, At, B0); PG8_BAR; PG8_SCHED;
            PG8_STAGE(PG8_SB(1, 1), b3 + hstep, voffB);
            PG8_WAIT_V(6); PG8_BAR; PG8_MMA(1, 1, At, B1); PG8_BAR;
            }
        }
        if constexpr (ALIGN_EPI) { if (wr == 0) PG8_BAR; }
        if constexpr (!Epi::AFTER_DRAIN) { E(acc, cur, wr, wc, fr, fq); S.done(cur); }
        if (!has_next) break;
#pragma unroll
        for (int a = 0; a < 2; ++a)
#pragma unroll
            for (int b = 0; b < 2; ++b)
#pragma unroll
                for (int m = 0; m < 4; ++m)
#pragma unroll
                    for (int n = 0; n < 2; ++n) acc[a][b][m][n] = (f32x4){0.f, 0.f, 0.f, 0.f};
        cur = nxt; cA = nA; cB = nB; ++ui;
        if constexpr (ALIGN_EPI) { if (wr == 1) PG8_BAR; }
    }
    PG8_WAIT_V(0);
    if constexpr (!ALIGN_EPI) { if (wr == 0) PG8_BAR; }
    PG8_BAR;
    if constexpr (Epi::AFTER_DRAIN) { E.fused(acc, cur, wr, wc, fr, fq, lds, wid, lane); S.done(cur); }
#undef PG8_SA
#undef PG8_SB
#undef PG8_STAGE
#undef PG8_LDA
#undef PG8_LDB
#undef PG8_MMA
#undef PG8_WAIT_V
#undef PG8_WAIT_L
#undef PG8_BAR
#undef PG8_SCHED
}
}

#ifndef PROBE_PREP
#define PROBE_PREP 1
#endif
#ifndef PROBE_SEQ
#define PROBE_SEQ 1
#endif
#ifndef PROBE_ATTN
#define PROBE_ATTN 1
#endif
#ifndef MK_USE_CG
#define MK_USE_CG 1
#endif
namespace mk {
using pg8::bf16_t; using pg8::bf16x8; using pg8::f32x4; using pg8::u32x4; using pg8::Unit; using pg8::cvt_pk_bf16;
typedef unsigned u32x2 __attribute__((ext_vector_type(2)));
typedef float f32x16 __attribute__((ext_vector_type(16)));
#define LAS __attribute__((address_space(3)))

constexpr int T_ = 2048, NB_ = 8, M_ = NB_ * T_, MS_ = 32, D_ = 1024, NIN_ = 6144, FF_ = 4096;
constexpr int QKVW = 2304, ZBW = 1792, GTW = 2048;
constexpr float NORM_EPS = 1e-6f, GN_EPS = 64e-5f;
constexpr size_t O_Y = 0, O_YS = O_Y + (size_t)M_ * D_, O_KV128P = O_YS + (size_t)MS_ * D_, O_KV512P = O_KV128P + (size_t)NB_ * 128 * 512,
                 O_KV2048P = O_KV512P + (size_t)NB_ * 512 * 512, O_WKVP = O_KV2048P + (size_t)NB_ * 2048 * 512, O_SHIFTP = O_WKVP + (size_t)NB_ * 8 * 4096,
                 O_KV128S = O_SHIFTP + (size_t)NB_ * ZBW, O_KV512S = O_KV128S + (size_t)MS_ * 512, O_KV2048S = O_KV512S + (size_t)MS_ * 512,
                 O_WKVS = O_KV2048S + (size_t)MS_ * 512, O_SHIFTS = O_WKVS + (size_t)MS_ * 8 * 4096, O_END = O_SHIFTS + (size_t)MS_ * ZBW;
constexpr size_t MiB = 1u << 20, KiB = 1u << 10;
constexpr size_t WS_CTL = 0, CTL_ZERO_BYTES = 1 * MiB;
constexpr size_t CTL_SS1 = 64 * KiB, CTL_SS1S = 128 * KiB, CTL_SS2 = 192 * KiB, CTL_SS2S = 256 * KiB, CTL_BAR = 512 * KiB;
constexpr size_t WS_WIN = 2 * MiB, WS_WA = 14 * MiB, WS_WB = 14 * MiB + 512 * KiB, WS_WO = 16 * MiB, WS_WUP = 18 * MiB, WS_WDN = 26 * MiB;
constexpr size_t WS_WL = 34 * MiB, WS_AL = WS_WL + 64 * KiB, WS_GL = WS_WL + 128 * KiB;
constexpr size_t WS_SMALL = 35 * MiB;
constexpr size_t SM_H1S = 0, SM_ZS = 64 * KiB, SM_ATTS = 832 * KiB, SM_RWS = 848 * KiB, SM_MGS = 880 * KiB, SM_X1GS = 944 * KiB, SM_US = 1024 * KiB;
constexpr size_t WS_H1 = 38 * MiB, WS_QKV = 70 * MiB, WS_ZB = 142 * MiB, WS_U = 70 * MiB, WS_GATE = 198 * MiB, WS_OG = 262 * MiB, WS_LSE = 286 * MiB,
                 WS_Y = 287 * MiB, WS_G = 319 * MiB, WS_BON = 351 * MiB, WS_TMP = 287 * MiB, WS_REC = 383 * MiB, WS_ATT = 383 * MiB, WS_RW = 391 * MiB, WS_MG = 407 * MiB, WS_END = 481 * MiB;
constexpr int RING_BYTES = 131072, MISC_OFF = RING_BYTES + 320, LDS_BYTES = 147456;

__device__ __forceinline__ float bf2f(unsigned short h) { return __builtin_bit_cast(float, (unsigned)h << 16); }
__device__ __forceinline__ unsigned pk2(float lo, float hi);
__device__ __forceinline__ unsigned f2bf(float f) { return pk2(f, 0.f) & 0xffffu; }
typedef float f32x2_t __attribute__((ext_vector_type(2))); typedef __bf16 bf16x2_t __attribute__((ext_vector_type(2)));
__device__ __forceinline__ unsigned pk2(float lo, float hi) { const f32x2_t v = {lo, hi}; const bf16x2_t b = __builtin_convertvector(v, bf16x2_t); return __builtin_bit_cast(unsigned, b); }
__device__ __forceinline__ float sigm(float x) { return __builtin_amdgcn_rcpf(1.f + __expf(-x)); }
__device__ __forceinline__ float tanh_fast(float x) { return 1.f - 2.f * __builtin_amdgcn_rcpf(1.f + __expf(2.f * x)); }
__device__ __forceinline__ void store8bf(bf16_t* p, f32x4 v0, f32x4 v1) { u32x4 w; w.x = pk2(v0[0], v0[1]); w.y = pk2(v0[2], v0[3]); w.z = pk2(v1[0], v1[1]); w.w = pk2(v1[2], v1[3]); *(u32x4*)p = w; }
__device__ __forceinline__ void store4bf(bf16_t* p, f32x4 v) { u32x2 w; w.x = pk2(v[0], v[1]); w.y = pk2(v[2], v[3]); *(u32x2*)p = w; }
__device__ __forceinline__ f32x4 load4bf(const bf16_t* p) { const u32x2 w = *(const u32x2*)p; f32x4 r; r[0] = __builtin_bit_cast(float, w.x << 16); r[1] = __builtin_bit_cast(float, w.x & 0xffff0000u); r[2] = __builtin_bit_cast(float, w.y << 16); r[3] = __builtin_bit_cast(float, w.y & 0xffff0000u); return r; }
template <int CTRL> __device__ __forceinline__ float dppf(float v) { return __builtin_bit_cast(float, __builtin_amdgcn_update_dpp(0, __builtin_bit_cast(int, v), CTRL, 0xF, 0xF, true)); }
__device__ __forceinline__ float red16(float v) { v += dppf<0xB1>(v); v += dppf<0x4E>(v); v += dppf<0x141>(v); v += dppf<0x140>(v); return v; }
__device__ __forceinline__ float red8(float v) { v += dppf<0xB1>(v); v += dppf<0x4E>(v); v += dppf<0x141>(v); return v; }
__device__ __forceinline__ float wave_sum(float v) {
#pragma unroll
    for (int o = 1; o < 64; o <<= 1) v += __shfl_xor(v, o);
    return v;
}
__device__ __forceinline__ float wave_max(float v) {
#pragma unroll
    for (int o = 1; o < 64; o <<= 1) v = fmaxf(v, __shfl_xor(v, o));
    return v;
}

#define XB_TMO      128
#define XB_XCNT(j)  (256  + 64 * (j))
#define XB_XSUB(j)  (1280 + 64 * (j))
#define XB_XGEN(j)  (2304 + 64 * (j))
#define XB_TOP      3328
#define XB_TOPGEN   3392
#define XCD_BAR_WORDS 3456
#define XB_SPIN_CAP (1u << 18)

__device__ __forceinline__ unsigned xb_ld(unsigned* p)              { return __hip_atomic_load(p, __ATOMIC_RELAXED, __HIP_MEMORY_SCOPE_AGENT); }
__device__ __forceinline__ unsigned xb_add(unsigned* p, unsigned v) { return __hip_atomic_fetch_add(p, v, __ATOMIC_RELAXED, __HIP_MEMORY_SCOPE_AGENT); }
__device__ __forceinline__ unsigned xb_xcc_id() { return (unsigned)__builtin_amdgcn_s_getreg((3 << 11) | 20) & 0xFu; }
#define XB_SPIN(cond, bar) do { unsigned _sp = 0; while (cond) { __builtin_amdgcn_s_sleep(1); \
    if ((++_sp & 255u) == 0u) { if (xb_ld(&(bar)[XB_TMO])) break; if (_sp > XB_SPIN_CAP) { atomicAdd(&(bar)[XB_TMO], 1u); break; } } } } while (0)

struct XcdBarrier {
    unsigned* bar; unsigned x;
    volatile LAS unsigned* st;
};

__device__ __forceinline__ XcdBarrier xcd_barrier_post(unsigned* bar, volatile LAS unsigned* st) {
    XcdBarrier b; b.bar = bar; b.x = xb_xcc_id(); b.st = st;
    if (threadIdx.x == 0) (void)xb_add(&bar[XB_XCNT(b.x)], 1u);
    return b;
}
__device__ __forceinline__ void xcd_barrier_complete(unsigned* bar, unsigned x, unsigned& nloc, unsigned& nx) {
    const unsigned G = gridDim.x * gridDim.y * gridDim.z;
    unsigned sum, cnt, mine, sp = 0u;
    for (;;) {
        sum = 0u; cnt = 0u; mine = 0u;
#pragma unroll
        for (unsigned j = 0; j < 16; ++j) { const unsigned c = xb_ld(&bar[XB_XCNT(j)]); sum += c; cnt += (c > 0u) ? 1u : 0u; mine = (j == x) ? c : mine; }
        if (sum == G) break;
        __builtin_amdgcn_s_sleep(1);
        if ((++sp & 255u) == 0u) { if (xb_ld(&bar[XB_TMO])) break; if (sp > XB_SPIN_CAP) { atomicAdd(&bar[XB_TMO], 1u); break; } }
    }
    nloc = mine > 0u ? mine : 1u; nx = cnt > 0u ? cnt : 1u;
}

__device__ __forceinline__ void xcd_barrier(const XcdBarrier& b) {
    asm volatile("s_waitcnt vmcnt(0)" ::: "memory");
    __syncthreads();
    if (threadIdx.x == 0) {
        unsigned* bar = b.bar;
        __builtin_amdgcn_s_waitcnt(0);
        unsigned nloc = b.st[0], nx = b.st[1];
        if (nloc == 0u) { xcd_barrier_complete(bar, b.x, nloc, nx); b.st[0] = nloc; b.st[1] = nx; }
        const unsigned old = xb_add(&bar[XB_XSUB(b.x)], 1u);
        const unsigned gen = old / nloc;
        if (old + 1u == (gen + 1u) * nloc) {
            __builtin_amdgcn_fence(__ATOMIC_RELEASE, "agent");
            asm volatile("s_waitcnt vmcnt(0)" ::: "memory");
            const unsigned og = xb_add(&bar[XB_TOP], 1u);
            const unsigned tg = og / nx;
            if (og + 1u == (tg + 1u) * nx) xb_add(&bar[XB_TOPGEN], 1u);
            else XB_SPIN(xb_ld(&bar[XB_TOPGEN]) == tg, bar);
            __builtin_amdgcn_fence(__ATOMIC_ACQUIRE, "agent");
            xb_add(&bar[XB_XGEN(b.x)], 1u);
            asm volatile("s_waitcnt vmcnt(0)" ::: "memory");
        } else {
            XB_SPIN(xb_ld(&bar[XB_XGEN(b.x)]) == gen, bar);
            __builtin_amdgcn_fence(__ATOMIC_ACQUIRE, "agent");
            asm volatile("s_waitcnt vmcnt(0)" ::: "memory");
        }
    }
    __syncthreads();
}

struct EpiZ {
    static constexpr bool PERM = true, AFTER_DRAIN = false;
    bf16_t* QKV; bf16_t* ZB; bf16_t* GATE; const float* b_gate; float* out;
    __device__ __forceinline__ void operator()(const f32x4 (&acc)[2][2][4][2], const Unit& u, int wr, int wc, int fr, int fq) const {
        const int pn = u.pn;
#pragma unroll
        for (int ai = 0; ai < 2; ++ai)
#pragma unroll
            for (int m = 0; m < 4; ++m) {
                const int row = u.pm * 256 + ai * 128 + wr * 64 + m * 16 + fr; const int b = row >> 11, t = row & 2047;
#pragma unroll
                for (int bj = 0; bj < 2; ++bj) {
                    const int col = pn * 256 + bj * 128 + wc * 32 + 8 * fq;
                    const f32x4 v0 = acc[ai][bj][m][0], v1 = acc[ai][bj][m][1];
                    if (pn < 9) {
                        { const int sel = col / 768, cq = col - sel * 768, hd = cq >> 6, dsh_ = 2 * (hd >> 2);
                          const int pos = ((t & ((1 << dsh_) - 1)) << (11 - dsh_)) + (t >> dsh_);
                          store8bf(QKV + ((((size_t)sel * NB_ + b) * 12 + hd) * T_ + pos) * 64 + (cq & 63), v0, v1); }
                        if (col >= 768) {
                            const int kvsel = col >= 1536 ? 1 : 0; const int cc = col - 768 - kvsel * 768; const int head = cc >> 6, g = head >> 2, hs = head & 3, d = cc & 63;
                            const int rows_g = 128 << (2 * g); const int j = t - (T_ - rows_g);
                            if (j >= 0) { float* dst = out + (g == 0 ? O_KV128P : (g == 1 ? O_KV512P : O_KV2048P)) + ((size_t)(b * rows_g + j) * 2 + kvsel) * 256 + hs * 64 + d; *(f32x4*)dst = v0; *(f32x4*)(dst + 4) = v1; }
                        }
                    } else if (pn < 16) {
                        const int c = col - QKVW; store8bf(ZB + (size_t)row * ZBW + c, v0, v1);
                        if (t == T_ - 1) { float* dst = out + O_SHIFTP + (size_t)b * ZBW + c; *(f32x4*)dst = v0; *(f32x4*)(dst + 4) = v1; }
                    } else {
                        const int c = col - 4096; const f32x4 b0 = *(const f32x4*)(b_gate + c), b1 = *(const f32x4*)(b_gate + c + 4); f32x4 g0, g1;
#pragma unroll
                        for (int e = 0; e < 4; ++e) { g0[e] = sigm(v0[e] + b0[e]); g1[e] = sigm(v1[e] + b1[e]); }
                        store8bf(GATE + (size_t)row * GTW + c, g0, g1);
                    }
                }
            }
    }
};
struct EpiPA {
    static constexpr bool PERM = false, AFTER_DRAIN = false;
    const bf16_t* GATE; float* TMP;
    __device__ __forceinline__ void operator()(const f32x4 (&acc)[2][2][4][2], const Unit& u, int wr, int wc, int fr, int fq) const {
#pragma unroll
        for (int ai = 0; ai < 2; ++ai)
#pragma unroll
            for (int m = 0; m < 4; ++m) { const int row = u.pm * 256 + ai * 128 + wr * 64 + m * 16 + fr;
#pragma unroll
                for (int bj = 0; bj < 2; ++bj)
#pragma unroll
                    for (int n = 0; n < 2; ++n) { const int col = u.pn * 256 + bj * 128 + wc * 32 + 16 * n + 4 * fq;
                        const f32x4 ga = load4bf(GATE + (size_t)row * GTW + col); *(f32x4*)(TMP + (size_t)row * D_ + col) = ga * acc[ai][bj][m][n]; }
                asm volatile("" ::: "memory"); }
    }
};
struct EpiPB {
    static constexpr bool PERM = false, AFTER_DRAIN = false;
    const bf16_t* GATE; const float* TMP; bf16_t* MG;
    __device__ __forceinline__ void operator()(const f32x4 (&acc)[2][2][4][2], const Unit& u, int wr, int wc, int fr, int fq) const {
#pragma unroll
        for (int ai = 0; ai < 2; ++ai)
#pragma unroll
            for (int m = 0; m < 4; ++m) { const int row = u.pm * 256 + ai * 128 + wr * 64 + m * 16 + fr;
#pragma unroll
                for (int bj = 0; bj < 2; ++bj)
#pragma unroll
                    for (int n = 0; n < 2; ++n) { const int col = u.pn * 256 + bj * 128 + wc * 32 + 16 * n + 4 * fq;
                        const f32x4 gb = load4bf(GATE + (size_t)row * GTW + D_ + col); const f32x4 t = *(const f32x4*)(TMP + (size_t)row * D_ + col);
                        store4bf(MG + (size_t)row * D_ + col, t + gb * acc[ai][bj][m][n]); }
                asm volatile("" ::: "memory"); }
    }
};
template <bool WRITE_XG> struct EpiRes {
    static constexpr bool PERM = false, AFTER_DRAIN = false;
    const float* xin; float* xo; bf16_t* XG; const float* g; float* SS;
    __device__ __forceinline__ void operator()(const f32x4 (&acc)[2][2][4][2], const Unit& u, int wr, int wc, int fr, int fq) const {
#pragma unroll
        for (int ai = 0; ai < 2; ++ai)
#pragma unroll
            for (int m = 0; m < 4; ++m) { const int row = u.pm * 256 + ai * 128 + wr * 64 + m * 16 + fr; float ss = 0.f;
#pragma unroll
                for (int bj = 0; bj < 2; ++bj)
#pragma unroll
                    for (int n = 0; n < 2; ++n) { const int col = u.pn * 256 + bj * 128 + wc * 32 + 16 * n + 4 * fq;
                        const f32x4 x1 = *(const f32x4*)(xin + (size_t)row * D_ + col) + acc[ai][bj][m][n];
                        *(f32x4*)(xo + (size_t)row * D_ + col) = x1; ss += (x1[0] * x1[0] + x1[1] * x1[1]) + (x1[2] * x1[2] + x1[3] * x1[3]);
                        if (WRITE_XG) { const f32x4 gg = *(const f32x4*)(g + col); store4bf(XG + (size_t)row * D_ + col, x1 * gg); } }
                ss += __shfl_xor(ss, 16); ss += __shfl_xor(ss, 32);
                if (fq == 0) atomicAdd(SS + row, ss);
                asm volatile("" ::: "memory"); }
    }
};
struct EpiUp {
    static constexpr bool PERM = true, AFTER_DRAIN = false;
    const float* SS; bf16_t* U;
    __device__ __forceinline__ void operator()(const f32x4 (&acc)[2][2][4][2], const Unit& u, int wr, int wc, int fr, int fq) const {
#pragma unroll
        for (int ai = 0; ai < 2; ++ai)
#pragma unroll
            for (int m = 0; m < 4; ++m) { const int row = u.pm * 256 + ai * 128 + wr * 64 + m * 16 + fr; const float rs = rsqrtf(SS[row] * (1.f / D_) + NORM_EPS);
#pragma unroll
                for (int bj = 0; bj < 2; ++bj) { const int col = u.pn * 256 + bj * 128 + wc * 32 + 8 * fq; f32x4 v0 = acc[ai][bj][m][0] * rs, v1 = acc[ai][bj][m][1] * rs;
#pragma unroll
                    for (int e = 0; e < 4; ++e) { const float a = fmaxf(v0[e], 0.f), b = fmaxf(v1[e], 0.f); v0[e] = a * a; v1[e] = b * b; }
                    store8bf(U + (size_t)row * FF_ + col, v0, v1); } }
    }
};

struct SP { float* ZS; const float* b_gate; float* out; const float* xs; const float* g2; bf16_t* MGS; bf16_t* X1GS; bf16_t* US; float* SS1S; float* SS2S; };
template <int MODE> __device__ __forceinline__ void sample_gemm(LAS unsigned char* lds, const bf16_t* A1, int K1, const bf16_t* B1, const bf16_t* A2, int K2, const bf16_t* B2, int N, const SP p) {
    const int tid = threadIdx.x, wid = tid >> 6, lane = tid & 63, r = lane & 31, hh = lane >> 5;
    LAS float* P = (LAS float*)lds;
    for (int tile = blockIdx.x; tile < N / 32; tile += gridDim.x) {
        const int n0 = tile * 32;
        f32x16 acc1, acc2;
#pragma unroll
        for (int i = 0; i < 16; ++i) { acc1[i] = 0.f; acc2[i] = 0.f; }
        { const int kw = K1 / 8; const bf16_t* ap = A1 + (size_t)r * K1 + wid * kw + 8 * hh; const bf16_t* bp = B1 + (size_t)(n0 + r) * K1 + wid * kw + 8 * hh;
#pragma unroll 4
          for (int k = 0; k < kw; k += 16) { const bf16x8 a = *(const bf16x8*)(ap + k), b = *(const bf16x8*)(bp + k); acc1 = __builtin_amdgcn_mfma_f32_32x32x16_bf16(a, b, acc1, 0, 0, 0); } }
        if (K2 > 0) { const int kw = K2 / 8; const bf16_t* ap = A2 + (size_t)r * K2 + wid * kw + 8 * hh; const bf16_t* bp = B2 + (size_t)(n0 + r) * K2 + wid * kw + 8 * hh;
#pragma unroll 4
          for (int k = 0; k < kw; k += 16) { const bf16x8 a = *(const bf16x8*)(ap + k), b = *(const bf16x8*)(bp + k); acc2 = __builtin_amdgcn_mfma_f32_32x32x16_bf16(a, b, acc2, 0, 0, 0); } }
#pragma unroll
        for (int reg = 0; reg < 16; ++reg) { const int row = (reg & 3) + 8 * (reg >> 2) + 4 * hh; P[wid * 1024 + row * 32 + r] = acc1[reg]; if (K2 > 0) P[8192 + wid * 1024 + row * 32 + r] = acc2[reg]; }
        __syncthreads();
        const int row = tid >> 4, c2 = (tid & 15) * 2, col = n0 + c2;
        float s1a = 0.f, s1b = 0.f, s2a = 0.f, s2b = 0.f;
#pragma unroll
        for (int w = 0; w < 8; ++w) { s1a += P[w * 1024 + row * 32 + c2]; s1b += P[w * 1024 + row * 32 + c2 + 1]; if (K2 > 0) { s2a += P[8192 + w * 1024 + row * 32 + c2]; s2b += P[8192 + w * 1024 + row * 32 + c2 + 1]; } }
        if (MODE == 0) {
            p.ZS[(size_t)row * NIN_ + col] = s1a; p.ZS[(size_t)row * NIN_ + col + 1] = s1b;
            if (col >= 768 && col < QKVW) { const int kvsel = col >= 1536 ? 1 : 0; const int cc = col - 768 - kvsel * 768; const int head = cc >> 6, g = head >> 2, hs = head & 3, d = cc & 63;
                float* dst = p.out + (g == 0 ? O_KV128S : (g == 1 ? O_KV512S : O_KV2048S)) + ((size_t)row * 2 + kvsel) * 256 + hs * 64 + d; dst[0] = s1a; dst[1] = s1b; }
            else if (col >= QKVW && col < 4096) { float* dst = p.out + O_SHIFTS + (size_t)row * ZBW + (col - QKVW); dst[0] = s1a; dst[1] = s1b; }
        } else if (MODE == 1) {
            const float* zg = p.ZS + (size_t)row * NIN_ + 4096;
            const float ga0 = sigm(zg[col] + p.b_gate[col]), ga1 = sigm(zg[col + 1] + p.b_gate[col + 1]), gb0 = sigm(zg[D_ + col] + p.b_gate[D_ + col]), gb1 = sigm(zg[D_ + col + 1] + p.b_gate[D_ + col + 1]);
            *(unsigned*)(p.MGS + (size_t)row * D_ + col) = pk2(ga0 * s1a + gb0 * s2a, ga1 * s1b + gb1 * s2b);
        } else if (MODE == 2 || MODE == 4) {
            const float* xin = (MODE == 2) ? p.xs : (p.out + O_YS); float* xo = p.out + O_YS;
            const float x0 = xin[(size_t)row * D_ + col] + s1a, x1 = xin[(size_t)row * D_ + col + 1] + s1b;
            xo[(size_t)row * D_ + col] = x0; xo[(size_t)row * D_ + col + 1] = x1;
            if (MODE == 2) *(unsigned*)(p.X1GS + (size_t)row * D_ + col) = pk2(x0 * p.g2[col], x1 * p.g2[col + 1]);
            float ss = x0 * x0 + x1 * x1; ss = red16(ss);
            if ((tid & 15) == 0) atomicAdd((MODE == 2 ? p.SS1S : p.SS2S) + row, ss);
        } else if (MODE == 3) {
            const float rs = rsqrtf(p.SS1S[row] * (1.f / D_) + NORM_EPS); const float a = fmaxf(rs * s1a, 0.f), b = fmaxf(rs * s1b, 0.f);
            *(unsigned*)(p.US + (size_t)row * FF_ + col) = pk2(a * a, b * b);
        }
        __syncthreads();
    }
}

__device__ __forceinline__ void p0_transpose_item(const float* W, int K, int N, bf16_t* WT, LAS float* scr, int item, int lane) {
    const int nblk = N / 32, kb = item / nblk, nb = item % nblk, k0 = 64 * kb, n0 = 32 * nb;
#pragma unroll 8
    for (int i = 0; i < 32; ++i) { const int kk = 2 * i + (lane >> 5); scr[kk * 33 + (lane & 31)] = W[(size_t)(k0 + kk) * N + n0 + (lane & 31)]; }
    asm volatile("s_waitcnt lgkmcnt(0)" ::: "memory");
    const int c = lane & 7;
#pragma unroll
    for (int j = 0; j < 4; ++j) { const int n = (lane >> 3) + 8 * j; const LAS float* s = scr + (8 * c) * 33 + n;
        u32x4 o; o.x = pk2(s[0 * 33], s[1 * 33]); o.y = pk2(s[2 * 33], s[3 * 33]); o.z = pk2(s[4 * 33], s[5 * 33]); o.w = pk2(s[6 * 33], s[7 * 33]);
        *(u32x4*)(WT + (size_t)(n0 + n) * K + k0 + 8 * c) = o; }
    asm volatile("s_waitcnt lgkmcnt(0)" ::: "memory");
}
__device__ __forceinline__ void rms_row_to_bf16(const float* xrow, const float* g, bf16_t* orow, int lane) {
    f32x4 v[4]; float s = 0.f;
#pragma unroll
    for (int j = 0; j < 4; ++j) { v[j] = *((const f32x4*)xrow + lane + 64 * j); s += (v[j][0] * v[j][0] + v[j][1] * v[j][1]) + (v[j][2] * v[j][2] + v[j][3] * v[j][3]); }
    const float rs = rsqrtf(wave_sum(s) * (1.f / D_) + NORM_EPS);
#pragma unroll
    for (int j = 0; j < 4; ++j) { const f32x4 gg = *((const f32x4*)g + lane + 64 * j); store4bf(orow + 4 * (lane + 64 * j), v[j] * rs * gg); }
}

__device__ __forceinline__ void rms_row2_to_bf16(const float* x0, const float* x1, const float* g, bf16_t* o0, bf16_t* o1, int lane) {
    f32x4 a[4], b[4]; float sa = 0.f, sb = 0.f;
#pragma unroll
    for (int j = 0; j < 4; ++j) { a[j] = *((const f32x4*)x0 + lane + 64 * j); b[j] = *((const f32x4*)x1 + lane + 64 * j); }
#pragma unroll
    for (int j = 0; j < 4; ++j) { sa += (a[j][0] * a[j][0] + a[j][1] * a[j][1]) + (a[j][2] * a[j][2] + a[j][3] * a[j][3]); sb += (b[j][0] * b[j][0] + b[j][1] * b[j][1]) + (b[j][2] * b[j][2] + b[j][3] * b[j][3]); }
#pragma unroll
    for (int o = 1; o < 64; o <<= 1) { sa += __shfl_xor(sa, o); sb += __shfl_xor(sb, o); }
    const float ra = rsqrtf(sa * (1.f / D_) + NORM_EPS), rb = rsqrtf(sb * (1.f / D_) + NORM_EPS);
#pragma unroll
    for (int j = 0; j < 4; ++j) { const f32x4 gg = *((const f32x4*)g + lane + 64 * j); store4bf(o0 + 4 * (lane + 64 * j), a[j] * ra * gg); store4bf(o1 + 4 * (lane + 64 * j), b[j] * rb * gg); }
}
constexpr int AT_KS = 0, AT_VT = 36864, AT_PS = 72704;
struct AttnLd { u32x4 k[4], v[4]; bf16x8 q0, q1; };
__device__ __forceinline__ void attn_load(AttnLd& L, int item, const bf16_t* QKV) {
    int tid_ = threadIdx.x; asm volatile("" : "+v"(tid_));
    const int tid = tid_, wid = tid >> 6, lane = tid & 63, fr = lane & 15, fq = lane >> 4;
    const int blk = item & 15, hs = (item >> 4) & 3, g = (item >> 6) % 3, b = item / 192;
    const int dsh = 2 * g, nbk = 16 >> dsh, r = blk / nbk, n = blk % nbk, h = g * 4 + hs;
    const int Lr = T_ >> dsh;
    const bf16_t* qb = QKV + (((size_t)(0 * NB_ + b) * 12 + h) * T_ + (size_t)r * Lr) * 64;
    const bf16_t* kb = QKV + (((size_t)(1 * NB_ + b) * 12 + h) * T_ + (size_t)r * Lr) * 64;
    const bf16_t* vb = QKV + (((size_t)(2 * NB_ + b) * 12 + h) * T_ + (size_t)r * Lr) * 64;
#pragma unroll
    for (int i = 0; i < 4; ++i) { const int c = tid + 512 * i, row = c >> 3, part = c & 7; const int e = (n - 1) * 128 + row;
        L.k[i] = (u32x4){0u, 0u, 0u, 0u}; if (e >= 0) L.k[i] = *(const u32x4*)(kb + (size_t)e * 64 + part * 8); }
#pragma unroll
    for (int i = 0; i < 4; ++i) { const int key = tid & 255, part = (tid >> 8) + 2 * i; const int e = (n - 1) * 128 + key;
        L.v[i] = (u32x4){0u, 0u, 0u, 0u}; if (e >= 0) L.v[i] = *(const u32x4*)(vb + (size_t)e * 64 + part * 8); }
    const int qi = 16 * wid + fr; const int eq = n * 128 + qi;
    L.q0 = *(const bf16x8*)(qb + (size_t)eq * 64 + 8 * fq); L.q1 = *(const bf16x8*)(qb + (size_t)eq * 64 + 32 + 8 * fq);
}
__device__ __forceinline__ void attn_unit(LAS unsigned char* lds, int item, int next_item, AttnLd& L, const bf16_t* QKV, bf16_t* OG, float* LSE, volatile LAS int* qslot, int tk_pub) {
    int tid_ = threadIdx.x; asm volatile("" : "+v"(tid_));
    const int tid = tid_, wid = __builtin_amdgcn_readfirstlane(tid >> 6), lane = tid & 63, fr = lane & 15, fq = lane >> 4;
    const int blk = item & 15, hs = (item >> 4) & 3, g = (item >> 6) % 3, b = item / 192;
    const int dsh = 2 * g, nbk = 16 >> dsh, r = blk / nbk, n = blk % nbk, h = g * 4 + hs;
    const float slope = exp2f(-8.0f * (float)(h + 1) / 12.0f);
    LAS unsigned char* Ks = lds + AT_KS; LAS unsigned char* Vt = lds + AT_VT;
#pragma unroll
    for (int i = 0; i < 4; ++i) { const int c = tid + 512 * i, row = c >> 3, part = c & 7; *(LAS u32x4*)(Ks + row * 144 + part * 16) = L.k[i]; }
#pragma unroll
    for (int i = 0; i < 4; ++i) { const int key = tid & 255, part = (tid >> 8) + 2 * i; const u32x4 v = L.v[i];
        LAS unsigned short* dst = (LAS unsigned short*)(Vt + (part * 8) * 560 + key * 2);
        dst[0 * 280] = (unsigned short)(v.x & 0xffff); dst[1 * 280] = (unsigned short)(v.x >> 16); dst[2 * 280] = (unsigned short)(v.y & 0xffff); dst[3 * 280] = (unsigned short)(v.y >> 16);
        dst[4 * 280] = (unsigned short)(v.z & 0xffff); dst[5 * 280] = (unsigned short)(v.z >> 16); dst[6 * 280] = (unsigned short)(v.w & 0xffff); dst[7 * 280] = (unsigned short)(v.w >> 16); }
    if (tid < 64) { const u32x4 z4 = (u32x4){0u, 0u, 0u, 0u}; *(LAS u32x4*)(Vt + tid * 560 + 512) = z4; *(LAS u32x4*)(Vt + tid * 560 + 528) = z4; *(LAS u32x4*)(Vt + tid * 560 + 544) = z4; }
    const bf16x8 qa0 = L.q0, qa1 = L.q1;
    __syncthreads();
    if (next_item >= 0) attn_load(L, next_item, QKV);
    f32x4 s[10];
    float mx = -3.0e38f;
    const int i = 16 * wid + fr;
#pragma unroll
    for (int jt = 0; jt < 10; ++jt) {
        const int jtile = wid + jt; f32x4 a = (f32x4){0.f, 0.f, 0.f, 0.f};
        if (jtile < 16) {
            const bf16x8 k0 = *(const LAS bf16x8*)(Ks + (jtile * 16 + fr) * 144 + fq * 16), k1 = *(const LAS bf16x8*)(Ks + (jtile * 16 + fr) * 144 + 64 + fq * 16);
            a = __builtin_amdgcn_mfma_f32_16x16x32_bf16(k0, qa0, a, 0, 0, 0); a = __builtin_amdgcn_mfma_f32_16x16x32_bf16(k1, qa1, a, 0, 0, 0);
        }
#pragma unroll
        for (int e = 0; e < 4; ++e) { const int j = jtile * 16 + 4 * fq + e; const int delta = 128 + i - j;
            const bool valid = (jtile < 16) && (delta >= 0) && (delta <= 128) && (n > 0 || j >= 128);
            const float sc = valid ? (a[e] * 0.125f - slope * (float)(delta << dsh)) : -1.0e30f; a[e] = sc; mx = fmaxf(mx, sc); }
        s[jt] = a;
    }
    mx = fmaxf(mx, __shfl_xor(mx, 16)); mx = fmaxf(mx, __shfl_xor(mx, 32));
    float lsum = 0.f;
#pragma unroll
    for (int jt = 0; jt < 10; ++jt)
#pragma unroll
        for (int e = 0; e < 4; ++e) { const float p = __expf(s[jt][e] - mx); lsum += p; s[jt][e] = p; }
    lsum += __shfl_xor(lsum, 16); lsum += __shfl_xor(lsum, 32);
    f32x4 o[4];
#pragma unroll
    for (int nt = 0; nt < 4; ++nt) o[nt] = (f32x4){0.f, 0.f, 0.f, 0.f};
#pragma unroll
    for (int u = 0; u < 5; ++u) {
        u32x4 pw; pw.x = pk2(s[2 * u][0], s[2 * u][1]); pw.y = pk2(s[2 * u][2], s[2 * u][3]); pw.z = pk2(s[2 * u + 1][0], s[2 * u + 1][1]); pw.w = pk2(s[2 * u + 1][2], s[2 * u + 1][3]);
        const bf16x8 pb = __builtin_bit_cast(bf16x8, pw);
#pragma unroll
        for (int nt = 0; nt < 4; ++nt) { const LAS unsigned char* vp = Vt + (nt * 16 + fr) * 560 + (16 * wid + 32 * u + 4 * fq) * 2;
            const u32x2 v0 = *(const LAS u32x2*)vp, v1 = *(const LAS u32x2*)(vp + 32); u32x4 vw; vw.x = v0.x; vw.y = v0.y; vw.z = v1.x; vw.w = v1.y;
            o[nt] = __builtin_amdgcn_mfma_f32_16x16x32_bf16(__builtin_bit_cast(bf16x8, vw), pb, o[nt], 0, 0, 0); }
    }
    { const int t = ((n * 128 + i) << dsh) + r; const size_t row = (size_t)b * T_ + t; const float inv = 1.f / lsum;
#pragma unroll
      for (int nt = 0; nt < 4; ++nt) store4bf(OG + row * 768 + h * 64 + nt * 16 + 4 * fq, o[nt] * inv);
      if (fq == 0) LSE[row * 12 + h] = mx + __logf(lsum); }
    if (tid == 0) *qslot = tk_pub;
    __syncthreads();
}

__device__ __forceinline__ void sample_attn(LAS unsigned char* lds, int b, const float* ZS, const float* c128, const float* c512, const float* c2048, bf16_t* ATTS) {
    const int tid = threadIdx.x, wid = tid >> 6, lane = tid & 63;
    LAS float* qs = (LAS float*)lds;
    LAS float* sc = qs + 256;
    LAS float* og = sc + 4 * 132;
    LAS float* ls = og + 768;
    LAS float* lsm = ls + 12;
    const float* z = ZS + (size_t)b * NIN_;
    for (int g = 0; g < 3; ++g) {
        const int dsh = 2 * g, Lb = 128 << dsh; const float* cache = g == 0 ? c128 : (g == 1 ? c512 : c2048);
        const float* cb = cache + (size_t)b * Lb * 512;
        if (tid < 256) qs[tid] = z[g * 256 + tid];
        __syncthreads();
        { const int hs = tid >> 7, mi = tid & 127, m = mi + 1; const float slope = exp2f(-8.0f * (float)(g * 4 + hs + 1) / 12.0f);
          const float* kr = cb + (size_t)(Lb - (m << dsh)) * 512 + hs * 64; float d = 0.f; f32x4 kv[16];
#pragma unroll
          for (int i = 0; i < 16; ++i) kv[i] = *(const f32x4*)(kr + 4 * i);
#pragma unroll
          for (int i = 0; i < 16; ++i) { const f32x4 qv = *(const LAS f32x4*)(qs + hs * 64 + 4 * i); d += (kv[i][0] * qv[0] + kv[i][1] * qv[1]) + (kv[i][2] * qv[2] + kv[i][3] * qv[3]); }
          sc[hs * 132 + m] = d * 0.125f - slope * (float)(m << dsh);
          if (mi == 0) { const float* kn = z + 768 + (g * 4 + hs) * 64; float d0 = 0.f;
#pragma unroll
              for (int i = 0; i < 16; ++i) { const f32x4 kq = *(const f32x4*)(kn + 4 * i); const f32x4 qv = *(const LAS f32x4*)(qs + hs * 64 + 4 * i); d0 += (kq[0] * qv[0] + kq[1] * qv[1]) + (kq[2] * qv[2] + kq[3] * qv[3]); }
              sc[hs * 132] = d0 * 0.125f; } }
        __syncthreads();
        if (wid < 4) { const int hs = wid; float v0 = sc[hs * 132 + lane], v1 = sc[hs * 132 + 64 + lane], v2 = lane == 0 ? sc[hs * 132 + 128] : -3.0e38f;
            const float mxx = wave_max(fmaxf(fmaxf(v0, v1), v2)); const float p0 = __expf(v0 - mxx), p1 = __expf(v1 - mxx), p2 = lane == 0 ? __expf(v2 - mxx) : 0.f;
            const float l = wave_sum(p0 + p1 + p2); sc[hs * 132 + lane] = p0; sc[hs * 132 + 64 + lane] = p1; if (lane == 0) { sc[hs * 132 + 128] = p2; ls[g * 4 + hs] = mxx + __logf(l); lsm[hs] = l; } }
        __syncthreads();
        { const int hs = tid >> 7, d4 = (tid >> 3) & 15, mp = tid & 7; f32x4 vv[17];
#pragma unroll
          for (int i = 0; i < 17; ++i) { const int m = mp * 17 + i; const float* vp = (m == 0) ? (z + 1536 + (g * 4 + hs) * 64 + 4 * d4) : (cb + (size_t)(Lb - ((m < 129 ? m : 128) << dsh)) * 512 + 256 + hs * 64 + 4 * d4); vv[i] = *(const f32x4*)vp; }
          f32x4 acc = (f32x4){0.f, 0.f, 0.f, 0.f};
#pragma unroll
          for (int i = 0; i < 17; ++i) { const int m = mp * 17 + i; const float p = (m < 129) ? sc[hs * 132 + (m < 129 ? m : 0)] : 0.f; acc = acc + vv[i] * p; }
          acc[0] = red8(acc[0]); acc[1] = red8(acc[1]); acc[2] = red8(acc[2]); acc[3] = red8(acc[3]);
          if (mp == 0) { const float inv = 1.f / lsm[hs]; *(LAS f32x4*)(og + (g * 4 + hs) * 64 + 4 * d4) = acc * inv; } }
        __syncthreads();
    }
    if (tid < 256) { const int hs = tid >> 6, d = tid & 63; const float l0 = ls[hs], l1 = ls[4 + hs], l2 = ls[8 + hs]; const float mm = fmaxf(l0, fmaxf(l1, l2));
        const float w0 = __expf(l0 - mm), w1 = __expf(l1 - mm), w2 = __expf(l2 - mm); const float inv = 1.f / (w0 + w1 + w2);
        ATTS[(size_t)b * 256 + tid] = (bf16_t)f2bf((w0 * og[hs * 64 + d] + w1 * og[(4 + hs) * 64 + d] + w2 * og[(8 + hs) * 64 + d]) * inv); }
    __syncthreads();
}

struct RwW { const float *mu, *w0, *a0, *k_k, *k_a, *r_k, *gn_g, *gn_b, *wl, *al, *gl; };
__device__ __forceinline__ float decay_of(float w0c, float wl) { const float x = -(w0c + wl); const float sp = fmaxf(x, 0.f) + __logf(1.f + __expf(-fabsf(x))); return __expf(-__expf(-sp - 0.5f)); }

__device__ __forceinline__ void sample_rwkv(LAS unsigned char* lds, int item, const float* ZS, const float* state_wkv, const float* state_shift, const RwW w, float* out, bf16_t* RWS) {
    const int tid = threadIdx.x, wid = tid >> 6, lane = tid & 63; const int b = item >> 3, h = item & 7;
    LAS float* xr = (LAS float*)lds; LAS float* xk = xr + 64; LAS float* xv = xk + 64; LAS float* lw = xv + 64; LAS float* la = lw + 64; LAS float* lg = la + 64;
    LAS float* pw = lg + 128; LAS float* pa = pw + 64; LAS float* pg = pa + 64;
    LAS float* sR = pg + 64; LAS float* sW = sR + 64; LAS float* sK = sW + 64; LAS float* sV = sK + 64; LAS float* sA = sV + 64; LAS float* sB = sA + 64; LAS float* sG = sB + 64; LAS float* sY = sG + 64; LAS float* sC = sY + 64;
    const float* zb = ZS + (size_t)b * NIN_ + QKVW; const float* pv = state_shift + (size_t)b * ZBW;
    if (tid < 448) { int col; if (tid < 192) col = (tid >> 6) * 512 + h * 64 + (tid & 63); else col = 1536 + (tid - 192);
        const float cur = zb[col], prv = pv[col]; const float mx = cur + (prv - cur) * w.mu[col];
        if (tid < 64) xr[tid] = mx; else if (tid < 128) xk[tid - 64] = mx; else if (tid < 192) xv[tid - 128] = mx; else if (tid < 256) lw[tid - 192] = tanhf(mx); else if (tid < 320) la[tid - 256] = mx; else lg[tid - 320] = sigm(mx); }
    __syncthreads();
    if (tid < 192) { const int which = tid >> 6, nn = tid & 63, c = h * 64 + nn; float acc = 0.f;
        if (which == 0) {
#pragma unroll 16
            for (int j = 0; j < 64; ++j) acc += lw[j] * w.wl[j * 512 + c]; pw[nn] = acc; }
        else if (which == 1) {
#pragma unroll 16
            for (int j = 0; j < 64; ++j) acc += la[j] * w.al[j * 512 + c]; pa[nn] = acc; }
        else {
#pragma unroll 16
            for (int j = 0; j < 128; ++j) acc += lg[j] * w.gl[j * 512 + c]; pg[nn] = acc; } }
    __syncthreads();
    if (wid == 0) { const int c = h * 64 + lane; const float r = xr[lane], k = xk[lane], v = xv[lane];
        const float dec = decay_of(w.w0[c], pw[lane]); const float a = sigm(w.a0[c] + pa[lane]);
        const float kkr = k * w.k_k[c]; const float nrm = fmaxf(sqrtf(wave_sum(kkr * kkr)), 1e-12f); const float kk = kkr / nrm;
        const float kp = k * (1.f + (a - 1.f) * w.k_a[c]); const float cs = wave_sum(r * kp * w.r_k[c]);
        sR[lane] = r; sW[lane] = dec; sK[lane] = kp; sV[lane] = v; sA[lane] = -kk; sB[lane] = kk * a; sG[lane] = pg[lane]; if (lane == 0) sC[0] = cs; }
    __syncthreads();
    { const int row = tid >> 3, kq = tid & 7; const float* S0 = state_wkv + ((size_t)(b * 8 + h) * 64 + row) * 64 + 8 * kq; float s[8];
      const f32x4 s0 = *(const f32x4*)S0, s1 = *(const f32x4*)(S0 + 4); s[0] = s0[0]; s[1] = s0[1]; s[2] = s0[2]; s[3] = s0[3]; s[4] = s1[0]; s[5] = s1[1]; s[6] = s1[2]; s[7] = s1[3];
      float dot = 0.f;
#pragma unroll
      for (int i = 0; i < 8; ++i) dot += s[i] * sA[8 * kq + i];
      const float sa = red8(dot); const float vv = sV[row]; float yp = 0.f;
#pragma unroll
      for (int i = 0; i < 8; ++i) { s[i] = s[i] * sW[8 * kq + i] + sa * sB[8 * kq + i] + vv * sK[8 * kq + i]; yp += s[i] * sR[8 * kq + i]; }
      const float y = red8(yp); float* So = out + O_WKVS + ((size_t)(b * 8 + h) * 64 + row) * 64 + 8 * kq;
      *(f32x4*)So = (f32x4){s[0], s[1], s[2], s[3]}; *(f32x4*)(So + 4) = (f32x4){s[4], s[5], s[6], s[7]};
      if (kq == 0) sY[row] = y; }
    __syncthreads();
    if (wid == 0) { const int c = h * 64 + lane; const float y = sY[lane]; const float mu = wave_sum(y) * (1.f / 64.f); const float dv = y - mu; const float var = wave_sum(dv * dv) * (1.f / 64.f);
        const float yn = dv * rsqrtf(var + GN_EPS) * w.gn_g[c] + w.gn_b[c]; RWS[(size_t)b * 512 + c] = (bf16_t)f2bf((yn + sC[0] * sV[lane]) * sG[lane]); }
    __syncthreads();
}

constexpr int RC_P = 0, RC_P2 = 2048, RC_Q = 4096, RC_Q2 = 5120, RC_BK = 6144, RC_VT = 10240, RC_DC = 12288, RC_BYTES = 12544;
constexpr int PS = 68;
constexpr int PR_XR = 0, PR_XK = 8704, PR_XV = 17408, PR_PW = 26112, PR_PA = 34816, PR_PG = 43520, PR_LW = 52224, PR_LA = 56832, PR_LG = 61440, PR_GM = 70144, PR_TM = 80384, PR_PP = 82944, PR_QQ = 91648;
struct PrepLd { u32x2 c[7], p[7]; };
__device__ __forceinline__ f32x4 ub4(u32x2 w) { f32x4 r; r[0] = __builtin_bit_cast(float, w.x << 16); r[1] = __builtin_bit_cast(float, w.x & 0xffff0000u); r[2] = __builtin_bit_cast(float, w.y << 16); r[3] = __builtin_bit_cast(float, w.y & 0xffff0000u); return r; }
__device__ __forceinline__ void prep_load(PrepLd& ld, int item, const bf16_t* ZB) {
    const int tid = threadIdx.x, tt = tid >> 4, q = tid & 15; const int bh = item >> 6, c32 = item & 63, b = bh >> 3, h = bh & 7, t = c32 * 32 + tt, c0 = h * 64 + 4 * q;
    const bf16_t* cur = ZB + ((size_t)b * T_ + t) * ZBW; const bf16_t* prv = cur - ZBW; const bool hp = t > 0; const u32x2 z = (u32x2){0u, 0u};
    ld.c[0] = *(const u32x2*)(cur + c0); ld.c[1] = *(const u32x2*)(cur + 512 + c0); ld.c[2] = *(const u32x2*)(cur + 1024 + c0); ld.c[3] = *(const u32x2*)(cur + 1536 + 4 * q); ld.c[4] = *(const u32x2*)(cur + 1600 + 4 * q); ld.c[5] = *(const u32x2*)(cur + 1664 + 8 * q); ld.c[6] = *(const u32x2*)(cur + 1668 + 8 * q);
    ld.p[0] = hp ? *(const u32x2*)(prv + c0) : z; ld.p[1] = hp ? *(const u32x2*)(prv + 512 + c0) : z; ld.p[2] = hp ? *(const u32x2*)(prv + 1024 + c0) : z; ld.p[3] = hp ? *(const u32x2*)(prv + 1536 + 4 * q) : z; ld.p[4] = hp ? *(const u32x2*)(prv + 1600 + 4 * q) : z;
    ld.p[5] = hp ? *(const u32x2*)(prv + 1664 + 8 * q) : z; ld.p[6] = hp ? *(const u32x2*)(prv + 1668 + 8 * q) : z;
}
__device__ __forceinline__ void prep_item(LAS unsigned char* lds, int item, int next_item, PrepLd& ld, const bf16_t* ZB, const RwW w, const bf16_t* WlT, const bf16_t* AlT, const bf16_t* GlT, float* G, float* BON, unsigned char* REC) {
    int tid_ = threadIdx.x; asm volatile("" : "+v"(tid_));
    const int tid = tid_, wid = __builtin_amdgcn_readfirstlane(tid >> 6), lane = tid & 63, fr = lane & 15, fq = lane >> 4;
    const int bh = item >> 6, c32 = item & 63, b = bh >> 3, h = bh & 7, t0 = c32 * 32;
    LAS float* XR = (LAS float*)(lds + PR_XR); LAS float* XK = (LAS float*)(lds + PR_XK); LAS float* XV = (LAS float*)(lds + PR_XV);
    LAS float* PW = (LAS float*)(lds + PR_PW); LAS float* PA = (LAS float*)(lds + PR_PA); LAS float* PG = (LAS float*)(lds + PR_PG);
    LAS unsigned char* LW = lds + PR_LW; LAS unsigned char* LA = lds + PR_LA; LAS unsigned char* LG = lds + PR_LG;
    LAS float* GM = (LAS float*)(lds + PR_GM); LAS float* TM = (LAS float*)(lds + PR_TM); LAS float* PP = (LAS float*)(lds + PR_PP); LAS float* QQ = (LAS float*)(lds + PR_QQ);
    const int ttile = wid >> 2, ntile = wid & 3; const int ncol = h * 64 + ntile * 16 + fr;
    const int tt = tid >> 4, q = tid & 15, c0 = h * 64 + 4 * q;
    { const f32x4 mu_r = *(const f32x4*)(w.mu + c0), mu_k = *(const f32x4*)(w.mu + 512 + c0), mu_v = *(const f32x4*)(w.mu + 1024 + c0);
      const f32x4 mu_w = *(const f32x4*)(w.mu + 1536 + 4 * q), mu_a = *(const f32x4*)(w.mu + 1600 + 4 * q), mu_g0 = *(const f32x4*)(w.mu + 1664 + 8 * q), mu_g1 = *(const f32x4*)(w.mu + 1668 + 8 * q);
      f32x4 cr = ub4(ld.c[0]), ck = ub4(ld.c[1]), cv = ub4(ld.c[2]), cw = ub4(ld.c[3]), ca = ub4(ld.c[4]), cg0 = ub4(ld.c[5]), cg1 = ub4(ld.c[6]);
      const f32x4 pr = ub4(ld.p[0]), pk = ub4(ld.p[1]), pv = ub4(ld.p[2]), pw = ub4(ld.p[3]), pa = ub4(ld.p[4]), pg0 = ub4(ld.p[5]), pg1 = ub4(ld.p[6]);
      cr = cr + (pr - cr) * mu_r; ck = ck + (pk - ck) * mu_k; cv = cv + (pv - cv) * mu_v; cw = cw + (pw - cw) * mu_w; ca = ca + (pa - ca) * mu_a; cg0 = cg0 + (pg0 - cg0) * mu_g0; cg1 = cg1 + (pg1 - cg1) * mu_g1;
      *(LAS f32x4*)(XR + tt * PS + 4 * q) = cr; *(LAS f32x4*)(XK + tt * PS + 4 * q) = ck; *(LAS f32x4*)(XV + tt * PS + 4 * q) = cv;
      u32x2 o; o.x = pk2(tanh_fast(cw[0]), tanh_fast(cw[1])); o.y = pk2(tanh_fast(cw[2]), tanh_fast(cw[3])); *(LAS u32x2*)(LW + tt * 144 + 8 * q) = o;
      o.x = pk2(ca[0], ca[1]); o.y = pk2(ca[2], ca[3]); *(LAS u32x2*)(LA + tt * 144 + 8 * q) = o;
      u32x4 o4; o4.x = pk2(sigm(cg0[0]), sigm(cg0[1])); o4.y = pk2(sigm(cg0[2]), sigm(cg0[3])); o4.z = pk2(sigm(cg1[0]), sigm(cg1[1])); o4.w = pk2(sigm(cg1[2]), sigm(cg1[3])); *(LAS u32x4*)(LG + tt * 272 + 16 * q) = o4; }
    __syncthreads();
    if (next_item >= 0) prep_load(ld, next_item, ZB);
    { f32x4 wl = (f32x4){0.f, 0.f, 0.f, 0.f}, al = wl, gl = wl;
#pragma unroll
      for (int ks = 0; ks < 2; ++ks) { const bf16x8 aw = *(const LAS bf16x8*)(LW + (ttile * 16 + fr) * 144 + 64 * ks + 16 * fq), aa = *(const LAS bf16x8*)(LA + (ttile * 16 + fr) * 144 + 64 * ks + 16 * fq);
          const bf16x8 bw = *(const bf16x8*)(WlT + (size_t)ncol * 64 + 32 * ks + 8 * fq), ba = *(const bf16x8*)(AlT + (size_t)ncol * 64 + 32 * ks + 8 * fq);
          wl = __builtin_amdgcn_mfma_f32_16x16x32_bf16(aw, bw, wl, 0, 0, 0); al = __builtin_amdgcn_mfma_f32_16x16x32_bf16(aa, ba, al, 0, 0, 0); }
#pragma unroll
      for (int ks = 0; ks < 4; ++ks) { const bf16x8 ag = *(const LAS bf16x8*)(LG + (ttile * 16 + fr) * 272 + 64 * ks + 16 * fq); const bf16x8 bg = *(const bf16x8*)(GlT + (size_t)ncol * 128 + 32 * ks + 8 * fq);
          gl = __builtin_amdgcn_mfma_f32_16x16x32_bf16(ag, bg, gl, 0, 0, 0); }
#pragma unroll
      for (int e = 0; e < 4; ++e) { const int tr = ttile * 16 + 4 * fq + e, nc = ntile * 16 + fr; PW[tr * PS + nc] = wl[e]; PA[tr * PS + nc] = al[e]; PG[tr * PS + nc] = gl[e]; } }
    __syncthreads();
    { const f32x4 c_w0 = *(const f32x4*)(w.w0 + c0), c_a0 = *(const f32x4*)(w.a0 + c0), c_kk = *(const f32x4*)(w.k_k + c0), c_ka = *(const f32x4*)(w.k_a + c0), c_rk = *(const f32x4*)(w.r_k + c0);
      const f32x4 wl = *(LAS f32x4*)(PW + tt * PS + 4 * q), al = *(LAS f32x4*)(PA + tt * PS + 4 * q), gl = *(LAS f32x4*)(PG + tt * PS + 4 * q);
      const f32x4 r4 = *(LAS f32x4*)(XR + tt * PS + 4 * q), k4 = *(LAS f32x4*)(XK + tt * PS + 4 * q), v4 = *(LAS f32x4*)(XV + tt * PS + 4 * q);
      f32x4 dec, a4, kkr, kp; float ssq = 0.f, cs = 0.f;
#pragma unroll
      for (int e = 0; e < 4; ++e) { dec[e] = decay_of(c_w0[e], wl[e]); a4[e] = sigm(c_a0[e] + al[e]); kkr[e] = k4[e] * c_kk[e]; ssq += kkr[e] * kkr[e]; kp[e] = k4[e] * (1.f + (a4[e] - 1.f) * c_ka[e]); cs += r4[e] * kp[e] * c_rk[e]; }
      ssq = red16(ssq); cs = red16(cs); const float inv = 1.f / fmaxf(sqrtf(ssq), 1e-12f);
      const f32x4 kk = kkr * inv;
      *(LAS f32x4*)(PW + tt * PS + 4 * q) = dec; *(LAS f32x4*)(PA + tt * PS + 4 * q) = -kk; *(LAS f32x4*)(PG + tt * PS + 4 * q) = kk * a4; *(LAS f32x4*)(XK + tt * PS + 4 * q) = kp;
      const size_t off = ((size_t)b * T_ + t0 + tt) * 512 + c0; *(f32x4*)(G + off) = gl; *(f32x4*)(BON + off) = v4 * cs; }
    __syncthreads();
    unsigned char* rec0 = REC + (size_t)(bh * 128 + c32 * 2) * RC_BYTES;
    { const int s1 = wid >> 2, arr = wid & 3, k = lane; float Dc = 1.f; LAS float* dst = arr == 0 ? PA : (arr == 1 ? PG : (arr == 2 ? XK : XR));
      float wv[16], xv[16];
#pragma unroll
      for (int t = 0; t < 16; ++t) { const int o = (s1 * 16 + t) * PS + k; wv[t] = PW[o]; xv[t] = dst[o]; }
#pragma unroll
      for (int t = 0; t < 16; ++t) { const int o = (s1 * 16 + t) * PS + k; const float Dp = Dc; Dc *= wv[t];
          float f; if (arr == 0) f = Dp; else if (arr == 3) f = Dc; else f = __builtin_amdgcn_rcpf(Dc);
          dst[o] = xv[t] * f; }
      if (arr == 0) *(float*)(rec0 + (size_t)s1 * RC_BYTES + RC_DC + 4 * k) = Dc; }
    __syncthreads();
    const int s = wid >> 2;
    unsigned char* rec = rec0 + (size_t)s * RC_BYTES;
    { const int which = wid & 3; const LAS float* X = (which < 2) ? PA : XR; const LAS float* Yv = (which & 1) ? XK : PG;
      f32x4 acc = (f32x4){0.f, 0.f, 0.f, 0.f};
#pragma unroll
      for (int m = 0; m < 4; ++m) { const f32x4 xa = *(const LAS f32x4*)(X + (s * 16 + fr) * PS + 16 * m + 4 * fq), yb = *(const LAS f32x4*)(Yv + (s * 16 + fr) * PS + 16 * m + 4 * fq);
#pragma unroll
          for (int j = 0; j < 4; ++j) acc = __builtin_amdgcn_mfma_f32_16x16x4f32(xa[j], yb[j], acc, 0, 0, 0); }
#pragma unroll
      for (int e = 0; e < 4; ++e) { const int t = 4 * fq + e; const bool keep = (which < 2) ? (fr < t) : (fr <= t); GM[((s * 4 + which) * 16 + t) * 20 + fr] = keep ? acc[e] : 0.f; } }
    __syncthreads();
    if (tid >= 256) { const int u = tid - 256; const int ss = u >> 7, k = (u >> 1) & 63, half = u & 1; const LAS float* src = half ? XK : PG; unsigned char* rr = rec0 + (size_t)ss * RC_BYTES + RC_BK + k * 64;
#pragma unroll
        for (int c = 0; c < 2; ++c) { u32x4 o; const LAS float* p = src + (ss * 16 + 8 * c) * PS + k;
            o.x = pk2(p[0], p[PS]); o.y = pk2(p[2 * PS], p[3 * PS]); o.z = pk2(p[4 * PS], p[5 * PS]); o.w = pk2(p[6 * PS], p[7 * PS]);
            *(u32x4*)(rr + (((half * 2 + c) ^ ((k >> 2) & 3)) << 4)) = o; } }
    else if (tid >= 128) { const int ss = (tid - 128) >> 6, v = tid & 63; unsigned char* rr = rec0 + (size_t)ss * RC_BYTES + RC_VT + v * 32;
#pragma unroll
        for (int c = 0; c < 2; ++c) { u32x4 o; const LAS float* p = XV + (ss * 16 + 8 * c) * PS + v;
            o.x = pk2(p[0], p[PS]); o.y = pk2(p[2 * PS], p[3 * PS]); o.z = pk2(p[4 * PS], p[5 * PS]); o.w = pk2(p[6 * PS], p[7 * PS]);
            *(u32x4*)(rr + c * 16) = o; } }
    if (wid == 0 && lane < 32) { const int ss = lane >> 4, j = lane & 15; float x[16];
#pragma unroll
        for (int t = 0; t < 16; ++t) { float sum = (t == j) ? 1.f : 0.f; const LAS float* Lr = GM + ((ss * 4 + 0) * 16 + t) * 20;
#pragma unroll
            for (int i = 0; i < t; ++i) sum += Lr[i] * x[i];
            x[t] = sum; TM[(ss * 16 + t) * 20 + j] = sum;
            if ((t & 3) == 3) asm volatile("" ::: "memory"); } }
    __syncthreads();
    { const f32x4 ta = *(const LAS f32x4*)(TM + (s * 16 + fr) * 20 + 4 * fq); f32x4 acc = (f32x4){0.f, 0.f, 0.f, 0.f};
#pragma unroll
      for (int j = 0; j < 4; ++j) acc = __builtin_amdgcn_mfma_f32_16x16x4f32(ta[j], PA[(s * 16 + 4 * fq + j) * PS + ntile * 16 + fr], acc, 0, 0, 0);
#pragma unroll
      for (int e = 0; e < 4; ++e) { const int t = 4 * fq + e, k = ntile * 16 + fr; PP[(s * 16 + t) * PS + k] = acc[e];
          *(bf16_t*)(rec + RC_P + t * 128 + ((((k >> 3) ^ ((t >> 1) & 7))) << 4) + (k & 7) * 2) = (bf16_t)f2bf(acc[e]); }
      if (ntile == 0) { f32x4 aq = (f32x4){0.f, 0.f, 0.f, 0.f};
#pragma unroll
          for (int j = 0; j < 4; ++j) aq = __builtin_amdgcn_mfma_f32_16x16x4f32(ta[j], GM[((s * 4 + 1) * 16 + 4 * fq + j) * 20 + fr], aq, 0, 0, 0);
#pragma unroll
          for (int e = 0; e < 4; ++e) { const int t = 4 * fq + e; QQ[(s * 16 + t) * 20 + fr] = aq[e];
              *(bf16_t*)(rec + RC_Q + t * 64 + ((((fr >> 3)) ^ ((t >> 2) & 3)) << 4) + (fr & 7) * 2) = (bf16_t)f2bf(aq[e]);
              *(bf16_t*)(rec + RC_Q + t * 64 + (((2 + (fr >> 3)) ^ ((t >> 2) & 3)) << 4) + (fr & 7) * 2) = (bf16_t)0; } } }
    __syncthreads();
    { const f32x4 ma = *(const LAS f32x4*)(GM + ((s * 4 + 2) * 16 + fr) * 20 + 4 * fq); f32x4 acc;
#pragma unroll
      for (int e = 0; e < 4; ++e) acc[e] = XR[(s * 16 + 4 * fq + e) * PS + ntile * 16 + fr];
#pragma unroll
      for (int j = 0; j < 4; ++j) acc = __builtin_amdgcn_mfma_f32_16x16x4f32(ma[j], PP[(s * 16 + 4 * fq + j) * PS + ntile * 16 + fr], acc, 0, 0, 0);
#pragma unroll
      for (int e = 0; e < 4; ++e) { const int t = 4 * fq + e, k = ntile * 16 + fr; *(bf16_t*)(rec + RC_P2 + t * 128 + ((((k >> 3) ^ ((t >> 1) & 7))) << 4) + (k & 7) * 2) = (bf16_t)f2bf(acc[e]); }
      if (ntile == 0) { f32x4 aq;
#pragma unroll
          for (int e = 0; e < 4; ++e) aq[e] = GM[((s * 4 + 3) * 16 + 4 * fq + e) * 20 + fr];
#pragma unroll
          for (int j = 0; j < 4; ++j) aq = __builtin_amdgcn_mfma_f32_16x16x4f32(ma[j], QQ[(s * 16 + 4 * fq + j) * 20 + fr], aq, 0, 0, 0);
#pragma unroll
          for (int e = 0; e < 4; ++e) { const int t = 4 * fq + e;
              *(bf16_t*)(rec + RC_Q2 + t * 64 + ((((fr >> 3)) ^ ((t >> 2) & 3)) << 4) + (fr & 7) * 2) = (bf16_t)f2bf(aq[e]);
              *(bf16_t*)(rec + RC_Q2 + t * 64 + (((2 + (fr >> 3)) ^ ((t >> 2) & 3)) << 4) + (fr & 7) * 2) = (bf16_t)0; } } }
    __syncthreads();
}

struct Ops { bf16x8 P0, P1, P20, P21, Q, Q2, VT, BK0, BK1, BK2, BK3; f32x4 DC0, DC1, DC2, DC3; };
__device__ __forceinline__ void load_ops(Ops& o, const unsigned char* rec, int fr, int fq, int v0) {
    const int sw8 = (fr >> 1) & 7, sw4 = (fr >> 2) & 3;
    o.P0 = *(const bf16x8*)(rec + RC_P + fr * 128 + ((fq ^ sw8) << 4)); o.P1 = *(const bf16x8*)(rec + RC_P + fr * 128 + (((4 + fq) ^ sw8) << 4));
    o.P20 = *(const bf16x8*)(rec + RC_P2 + fr * 128 + ((fq ^ sw8) << 4)); o.P21 = *(const bf16x8*)(rec + RC_P2 + fr * 128 + (((4 + fq) ^ sw8) << 4));
    o.Q = *(const bf16x8*)(rec + RC_Q + fr * 64 + ((fq ^ sw4) << 4)); o.Q2 = *(const bf16x8*)(rec + RC_Q2 + fr * 64 + ((fq ^ sw4) << 4));
    o.VT = *(const bf16x8*)(rec + RC_VT + (v0 + fr) * 32 + (fq & 1) * 16);
    o.BK0 = *(const bf16x8*)(rec + RC_BK + (fr) * 64 + ((fq ^ sw4) << 4)); o.BK1 = *(const bf16x8*)(rec + RC_BK + (16 + fr) * 64 + ((fq ^ sw4) << 4));
    o.BK2 = *(const bf16x8*)(rec + RC_BK + (32 + fr) * 64 + ((fq ^ sw4) << 4)); o.BK3 = *(const bf16x8*)(rec + RC_BK + (48 + fr) * 64 + ((fq ^ sw4) << 4));
    o.DC0 = *(const f32x4*)(rec + RC_DC + (4 * fq) * 4); o.DC1 = *(const f32x4*)(rec + RC_DC + (16 + 4 * fq) * 4); o.DC2 = *(const f32x4*)(rec + RC_DC + (32 + 4 * fq) * 4); o.DC3 = *(const f32x4*)(rec + RC_DC + (48 + 4 * fq) * 4);
}
__device__ __forceinline__ void hilo_store(LAS unsigned char* Shi, LAS unsigned char* Slo, int fr, int fq, int mt, f32x4 sv) {
    u32x2 hi, lo; hi.x = pk2(sv[0], sv[1]); hi.y = pk2(sv[2], sv[3]);
    const float r0 = sv[0] - __builtin_bit_cast(float, hi.x << 16), r1 = sv[1] - __builtin_bit_cast(float, hi.x & 0xffff0000u), r2 = sv[2] - __builtin_bit_cast(float, hi.y << 16), r3 = sv[3] - __builtin_bit_cast(float, hi.y & 0xffff0000u);
    lo.x = pk2(r0, r1); lo.y = pk2(r2, r3);
    *(LAS u32x2*)(Shi + fr * 144 + (16 * mt + 4 * fq) * 2) = hi; *(LAS u32x2*)(Slo + fr * 144 + (16 * mt + 4 * fq) * 2) = lo;
}
__device__ __forceinline__ void seq_step(const Ops& o, f32x4 (&st)[4], LAS unsigned char* Shi, LAS unsigned char* Slo, LAS unsigned char* Ul, int fr, int fq, float* yrow) {
    hilo_store(Shi, Slo, fr, fq, 0, st[0]); hilo_store(Shi, Slo, fr, fq, 1, st[1]); hilo_store(Shi, Slo, fr, fq, 2, st[2]); hilo_store(Shi, Slo, fr, fq, 3, st[3]);
    asm volatile("s_waitcnt lgkmcnt(0)" ::: "memory");
    const bf16x8 sh0 = *(const LAS bf16x8*)(Shi + fr * 144 + 16 * fq), sh1 = *(const LAS bf16x8*)(Shi + fr * 144 + 64 + 16 * fq), sl0 = *(const LAS bf16x8*)(Slo + fr * 144 + 16 * fq), sl1 = *(const LAS bf16x8*)(Slo + fr * 144 + 64 + 16 * fq);
    const bf16x8 zero8 = (bf16x8){0, 0, 0, 0, 0, 0, 0, 0}; const bf16x8 vq = (fq < 2) ? o.VT : zero8;
    f32x4 ut = (f32x4){0.f, 0.f, 0.f, 0.f}, yt = ut;
    ut = __builtin_amdgcn_mfma_f32_16x16x32_bf16(o.P0, sh0, ut, 0, 0, 0); yt = __builtin_amdgcn_mfma_f32_16x16x32_bf16(o.P20, sh0, yt, 0, 0, 0);
    ut = __builtin_amdgcn_mfma_f32_16x16x32_bf16(o.P1, sh1, ut, 0, 0, 0); yt = __builtin_amdgcn_mfma_f32_16x16x32_bf16(o.P21, sh1, yt, 0, 0, 0);
    ut = __builtin_amdgcn_mfma_f32_16x16x32_bf16(o.P0, sl0, ut, 0, 0, 0); yt = __builtin_amdgcn_mfma_f32_16x16x32_bf16(o.P20, sl0, yt, 0, 0, 0);
    ut = __builtin_amdgcn_mfma_f32_16x16x32_bf16(o.P1, sl1, ut, 0, 0, 0); yt = __builtin_amdgcn_mfma_f32_16x16x32_bf16(o.P21, sl1, yt, 0, 0, 0);
    ut = __builtin_amdgcn_mfma_f32_16x16x32_bf16(o.Q, vq, ut, 0, 0, 0); yt = __builtin_amdgcn_mfma_f32_16x16x32_bf16(o.Q2, vq, yt, 0, 0, 0);
    { u32x2 uu; uu.x = pk2(ut[0], ut[1]); uu.y = pk2(ut[2], ut[3]); *(LAS u32x2*)(Ul + fr * 48 + 8 * fq) = uu; }
#pragma unroll
    for (int e = 0; e < 4; ++e) yrow[(size_t)(4 * fq + e) * 512] = yt[e];
    asm volatile("s_waitcnt lgkmcnt(0)" ::: "memory");
    const bf16x8 uf = *(const LAS bf16x8*)(Ul + fr * 48 + 16 * (fq & 1)); const bf16x8 uv = (fq < 2) ? uf : o.VT;
    st[0] = __builtin_amdgcn_mfma_f32_16x16x32_bf16(o.BK0, uv, st[0], 0, 0, 0); st[1] = __builtin_amdgcn_mfma_f32_16x16x32_bf16(o.BK1, uv, st[1], 0, 0, 0);
    st[2] = __builtin_amdgcn_mfma_f32_16x16x32_bf16(o.BK2, uv, st[2], 0, 0, 0); st[3] = __builtin_amdgcn_mfma_f32_16x16x32_bf16(o.BK3, uv, st[3], 0, 0, 0);
    st[0] = st[0] * o.DC0; st[1] = st[1] * o.DC1; st[2] = st[2] * o.DC2; st[3] = st[3] * o.DC3;
}
__device__ __forceinline__ void seq_warm(int bh, int wv, const unsigned char* REC, volatile LAS int* prog) {
    const int lane = threadIdx.x & 63; const unsigned char* rec = REC + (size_t)bh * 128 * RC_BYTES;
    for (int c = wv; c < 128; c += 4) {
        for (int spin = 0; spin < 4096 && *prog + 10 < c; ++spin) __builtin_amdgcn_s_sleep(8);
        const unsigned char* p = rec + (size_t)c * RC_BYTES + lane * 64; unsigned acc = 0u;
#pragma unroll
        for (int i = 0; i < 3; ++i) { const unsigned v = *(const volatile unsigned*)(p + i * 4096); acc += v; }
        if (lane < 4) { const unsigned v = *(const volatile unsigned*)(p + 3 * 4096); acc += v; }
        asm volatile("" :: "v"(acc));
    }
}
__device__ __forceinline__ void seq_unit(LAS unsigned char* lds, int bh, int wv, const unsigned char* REC, float* Y, float* out, volatile LAS int* prog) {
    const int lane = threadIdx.x & 63, fr = lane & 15, fq = lane >> 4, v0 = wv * 16, b = bh >> 3, h = bh & 7;
    LAS unsigned char* Shi = lds + wv * 5376; LAS unsigned char* Slo = Shi + 2304; LAS unsigned char* Ul = Slo + 2304;
    f32x4 st[4];
#pragma unroll
    for (int i = 0; i < 4; ++i) st[i] = (f32x4){0.f, 0.f, 0.f, 0.f};
    const unsigned char* rec = REC + (size_t)bh * 128 * RC_BYTES;
    float* ybase = Y + (size_t)b * T_ * 512 + h * 64 + v0 + fr;
    Ops A, B; load_ops(A, rec, fr, fq, v0);
    for (int c = 0; c < 128; c += 2) {
        load_ops(B, rec + (size_t)(c + 1) * RC_BYTES, fr, fq, v0);
        seq_step(A, st, Shi, Slo, Ul, fr, fq, ybase + (size_t)(c * 16) * 512);
        if (c + 2 < 128) load_ops(A, rec + (size_t)(c + 2) * RC_BYTES, fr, fq, v0);
        seq_step(B, st, Shi, Slo, Ul, fr, fq, ybase + (size_t)((c + 1) * 16) * 512);
        if (wv == 0 && lane == 0) *prog = c + 2;
    }
    if (wv == 0 && lane == 0) *prog = 1000;
#pragma unroll
    for (int mt = 0; mt < 4; ++mt) *(f32x4*)(out + O_WKVP + ((size_t)(b * 8 + h) * 64 + v0 + fr) * 64 + 16 * mt + 4 * fq) = st[mt];
}

struct Args { const float* in[28]; float* out; unsigned char* ws; int ph_lo, ph_hi; };
constexpr int N_PH = 10;

__global__ void __launch_bounds__(512, 2) fwd_kernel(Args args) {
    extern __shared__ __attribute__((aligned(16))) unsigned char lds_raw[];
    LAS unsigned char* lds = (LAS unsigned char*)lds_raw;
    const int tid = threadIdx.x, lane = tid & 63, wid = __builtin_amdgcn_readfirstlane(tid >> 6);
    const int G = gridDim.x, bx = blockIdx.x;
    const int gw = bx * 8 + wid, NGW = G * 8;
    unsigned char* ws = args.ws; float* out = args.out;
    const float* x = args.in[0]; const float* xs = args.in[1];
    unsigned* ctl = (unsigned*)(ws + WS_CTL);
    float* SS1 = (float*)(ws + CTL_SS1); float* SS1S = (float*)(ws + CTL_SS1S); float* SS2 = (float*)(ws + CTL_SS2); float* SS2S = (float*)(ws + CTL_SS2S);
    bf16_t* WinT = (bf16_t*)(ws + WS_WIN); bf16_t* WaT = (bf16_t*)(ws + WS_WA); bf16_t* WbT = (bf16_t*)(ws + WS_WB); bf16_t* WoT = (bf16_t*)(ws + WS_WO); bf16_t* WupT = (bf16_t*)(ws + WS_WUP); bf16_t* WdnT = (bf16_t*)(ws + WS_WDN);
    bf16_t* WlT = (bf16_t*)(ws + WS_WL); bf16_t* AlT = (bf16_t*)(ws + WS_AL); bf16_t* GlT = (bf16_t*)(ws + WS_GL);
    unsigned char* sm = ws + WS_SMALL;
    bf16_t* H1S = (bf16_t*)(sm + SM_H1S); float* ZS = (float*)(sm + SM_ZS); bf16_t* ATTS = (bf16_t*)(sm + SM_ATTS); bf16_t* RWS = (bf16_t*)(sm + SM_RWS); bf16_t* MGS = (bf16_t*)(sm + SM_MGS); bf16_t* X1GS = (bf16_t*)(sm + SM_X1GS); bf16_t* US = (bf16_t*)(sm + SM_US);
    bf16_t* H1 = (bf16_t*)(ws + WS_H1); bf16_t* QKV = (bf16_t*)(ws + WS_QKV); bf16_t* ZB = (bf16_t*)(ws + WS_ZB); bf16_t* U = (bf16_t*)(ws + WS_U); bf16_t* GATE = (bf16_t*)(ws + WS_GATE);
    bf16_t* OG = (bf16_t*)(ws + WS_OG); float* LSE = (float*)(ws + WS_LSE); bf16_t* ATT = (bf16_t*)(ws + WS_ATT); bf16_t* RW = (bf16_t*)(ws + WS_RW); bf16_t* MG = (bf16_t*)(ws + WS_MG);
    float* Yb = (float*)(ws + WS_Y); float* Gb = (float*)(ws + WS_G); float* BON = (float*)(ws + WS_BON); float* TMP = (float*)(ws + WS_TMP);
    SP sp; sp.ZS = ZS; sp.b_gate = args.in[9]; sp.out = out; sp.xs = xs; sp.g2 = args.in[24]; sp.MGS = MGS; sp.X1GS = X1GS; sp.US = US; sp.SS1S = SS1S; sp.SS2S = SS2S;
    const int lo = args.ph_lo, hi = args.ph_hi;
    if (tid < 32) ((volatile LAS unsigned*)(lds + MISC_OFF))[tid] = 0u;
    __syncthreads();
    if (lo < 0) cg::this_grid().sync();
    XcdBarrier xbar = xcd_barrier_post((unsigned*)(ws + CTL_BAR), (volatile LAS unsigned*)(lds + MISC_OFF) + 8);
#ifndef MK_ONLY
#define MK_ONLY -1
#endif
#define IN(k) ((MK_ONLY < 0 || MK_ONLY == (k)) && lo <= (k) && (k) < hi)
#define SEAM(k) do { if (IN(k) && IN((k) + 1)) { xcd_barrier(xbar); } } while (0)

    if (IN(0)) {
        LAS float* scr = (LAS float*)(lds + wid * 16384);
        constexpr int I_IN = 16 * 192, I_A = 4 * 32, I_B = 8 * 32, I_O = 16 * 32, I_UP = 16 * 128, I_DN = 64 * 32, I_WL = 16, I_AL = 16, I_GL = 32;
        constexpr int NITEMS = I_IN + I_A + I_B + I_O + I_UP + I_DN + I_WL + I_AL + I_GL;
        for (int it = gw; it < NITEMS; it += NGW) {
            int r = it;
            if (r < I_IN) { p0_transpose_item(args.in[8], 1024, 6144, WinT, scr, r, lane); continue; } r -= I_IN;
            if (r < I_A) { p0_transpose_item(args.in[21], 256, 1024, WaT, scr, r, lane); continue; } r -= I_A;
            if (r < I_B) { p0_transpose_item(args.in[22], 512, 1024, WbT, scr, r, lane); continue; } r -= I_B;
            if (r < I_O) { p0_transpose_item(args.in[23], 1024, 1024, WoT, scr, r, lane); continue; } r -= I_O;
            if (r < I_UP) { p0_transpose_item(args.in[25], 1024, 4096, WupT, scr, r, lane); continue; } r -= I_UP;
            if (r < I_DN) { p0_transpose_item(args.in[26], 4096, 1024, WdnT, scr, r, lane); continue; } r -= I_DN;
            if (r < I_WL) { p0_transpose_item(args.in[12], 64, 512, WlT, scr, r, lane); continue; } r -= I_WL;
            if (r < I_AL) { p0_transpose_item(args.in[14], 64, 512, AlT, scr, r, lane); continue; } r -= I_AL;
            p0_transpose_item(args.in[15], 128, 512, GlT, scr, r, lane);
        }
        for (int m0 = gw * 2; m0 < M_ + MS_; m0 += NGW * 2) {
            const float* xr0 = (m0 < M_) ? (x + (size_t)m0 * D_) : (xs + (size_t)(m0 - M_) * D_); const float* xr1 = (m0 + 1 < M_) ? (x + (size_t)(m0 + 1) * D_) : (xs + (size_t)(m0 + 1 - M_) * D_);
            bf16_t* o0 = (m0 < M_) ? (H1 + (size_t)m0 * D_) : (H1S + (size_t)(m0 - M_) * D_); bf16_t* o1 = (m0 + 1 < M_) ? (H1 + (size_t)(m0 + 1) * D_) : (H1S + (size_t)(m0 + 1 - M_) * D_);
            rms_row2_to_bf16(xr0, xr1, args.in[7], o0, o1, lane); }
        __syncthreads();
    }
    SEAM(0);
    if (IN(1)) {
        pg8::Gemm g{H1, WinT, M_, NIN_, D_}; pg8::StaticOrder S; S.init(M_, NIN_, G, bx);
        EpiZ E{QKV, ZB, GATE, args.in[9], out};
        pg8::gemm_phase<EpiZ, pg8::StaticOrder, true, true>(lds, g, S, E);
        sample_gemm<0>(lds, H1S, D_, WinT, nullptr, 0, nullptr, NIN_, sp);
    }
    SEAM(1);
    RwW w; w.mu = args.in[10]; w.w0 = args.in[11]; w.wl = args.in[12]; w.a0 = args.in[13]; w.al = args.in[14]; w.gl = args.in[15]; w.k_k = args.in[16]; w.k_a = args.in[17]; w.r_k = args.in[18]; w.gn_g = args.in[19]; w.gn_b = args.in[20];
    unsigned char* REC = ws + WS_REC;
    if (IN(2)) {
        for (int rep = 0; rep < PROBE_PREP; ++rep)
        { PrepLd ld; prep_load(ld, bx, ZB);
          for (int it = bx; it < 4096; it += G) prep_item(lds, it, (it + G < 4096) ? it + G : -1, ld, ZB, w, WlT, AlT, GlT, Gb, BON, REC); }
    }
    SEAM(2);
    if (IN(3)) {
        for (int rep = 0; rep < PROBE_SEQ; ++rep)
        { volatile LAS int* prog = (volatile LAS int*)(lds + MISC_OFF) + 4;
          if (tid == 0) *prog = 0;
          __syncthreads();
          if (bx < 64 && wid < 4) seq_unit(lds, bx, wid, REC, Yb, out, prog); }
        __syncthreads();
        volatile LAS int* qslot = (volatile LAS int*)(lds + MISC_OFF);
        for (;;) {
            if (tid == 0) *qslot = (int)atomicAdd(ctl, 1u);
            __syncthreads(); const int item = *qslot; __syncthreads();
            if (item >= 288 * PROBE_ATTN) break;
            if ((item % 288) < 32) sample_attn(lds, item % 288, ZS, args.in[2], args.in[3], args.in[4], ATTS);
            else sample_rwkv(lds, (item % 288) - 32, ZS, args.in[5], args.in[6], w, out, RWS);
        }
        {
            constexpr int NA = 1536 * PROBE_ATTN;
            if (tid == 0) { qslot[0] = (int)atomicAdd(ctl + 1, 1u); qslot[1] = (int)atomicAdd(ctl + 1, 1u); }
            __syncthreads(); int cur = qslot[0], nxt = qslot[1]; __syncthreads();
            AttnLd L;
            if (cur < NA) attn_load(L, cur % 1536, QKV);
            while (cur < NA) {
                int tk = 0; if (tid == 0) tk = (int)atomicAdd(ctl + 1, 1u);
                attn_unit(lds, cur % 1536, (nxt < NA) ? (nxt % 1536) : -1, L, QKV, OG, LSE, qslot, tk);
                const int nn = *qslot;
                cur = nxt; nxt = nn;
            }
        }
    }
    SEAM(3);
    if (IN(4)) {
        const float* gn_g = args.in[19]; const float* gn_b = args.in[20];
        for (int m0 = gw * 2; m0 < M_; m0 += NGW * 2) {
            f32x4 o0[2], o1[2], o2[2], y0[2], y1[2], bo0[2], bo1[2], gg0[2], gg1[2]; float l0[2], l1[2], l2[2];
            const int hs = lane >> 4;
#pragma unroll
            for (int u = 0; u < 2; ++u) { const size_t m = (size_t)(m0 + u); l0[u] = LSE[m * 12 + hs]; l1[u] = LSE[m * 12 + 4 + hs]; l2[u] = LSE[m * 12 + 8 + hs];
                o0[u] = load4bf(OG + m * 768 + 4 * lane); o1[u] = load4bf(OG + m * 768 + 256 + 4 * lane); o2[u] = load4bf(OG + m * 768 + 512 + 4 * lane);
                const size_t off = m * 512 + 8 * lane; y0[u] = *(const f32x4*)(Yb + off); y1[u] = *(const f32x4*)(Yb + off + 4); bo0[u] = *(const f32x4*)(BON + off); bo1[u] = *(const f32x4*)(BON + off + 4); gg0[u] = *(const f32x4*)(Gb + off); gg1[u] = *(const f32x4*)(Gb + off + 4); }
            const f32x4 g0 = *(const f32x4*)(gn_g + 8 * lane), g1 = *(const f32x4*)(gn_g + 8 * lane + 4), b0 = *(const f32x4*)(gn_b + 8 * lane), b1 = *(const f32x4*)(gn_b + 8 * lane + 4);
#pragma unroll
            for (int u = 0; u < 2; ++u) { const size_t m = (size_t)(m0 + u);
                const float mm = fmaxf(l0[u], fmaxf(l1[u], l2[u])); const float w0 = __expf(l0[u] - mm), w1 = __expf(l1[u] - mm), w2 = __expf(l2[u] - mm); const float inv = 1.f / (w0 + w1 + w2);
                store4bf(ATT + m * 256 + 4 * lane, (o0[u] * w0 + o1[u] * w1 + o2[u] * w2) * inv);
                const float mu = red8((y0[u][0] + y0[u][1]) + (y0[u][2] + y0[u][3]) + (y1[u][0] + y1[u][1]) + (y1[u][2] + y1[u][3])) * (1.f / 64.f); const f32x4 d0 = y0[u] - mu, d1 = y1[u] - mu;
                const float var = red8((d0[0] * d0[0] + d0[1] * d0[1]) + (d0[2] * d0[2] + d0[3] * d0[3]) + (d1[0] * d1[0] + d1[1] * d1[1]) + (d1[2] * d1[2] + d1[3] * d1[3])) * (1.f / 64.f); const float rstd = rsqrtf(var + GN_EPS);
                store8bf(RW + m * 512 + 8 * lane, (d0 * rstd * g0 + b0 + bo0[u]) * gg0[u], (d1 * rstd * g1 + b1 + bo1[u]) * gg1[u]); }
        }
    }
    SEAM(4);
    if (IN(5)) {
        pg8::StaticOrder S; S.init(M_, D_, G, bx);
        int ka = 256, kb = 512; asm volatile("" : "+s"(ka), "+s"(kb));
        { pg8::Gemm g{ATT, WaT, M_, D_, ka}; EpiPA E{GATE, TMP}; pg8::gemm_phase<EpiPA, pg8::StaticOrder, true, true>(lds, g, S, E); }
        { pg8::Gemm g{RW, WbT, M_, D_, kb}; EpiPB E{GATE, TMP, MG}; pg8::gemm_phase<EpiPB, pg8::StaticOrder, true, true>(lds, g, S, E); }
        sample_gemm<1>(lds, ATTS, 256, WaT, RWS, 512, WbT, D_, sp);
    }
    SEAM(5);
    if (IN(6)) {
        pg8::Gemm g{MG, WoT, M_, D_, D_}; pg8::StaticOrder S; S.init(M_, D_, G, bx);
        EpiRes<true> E{x, out + O_Y, H1, args.in[24], SS1};
        pg8::gemm_phase<EpiRes<true>, pg8::StaticOrder, true, true>(lds, g, S, E);
        sample_gemm<2>(lds, MGS, D_, WoT, nullptr, 0, nullptr, D_, sp);
    }
    SEAM(6);
    if (IN(7)) {
        pg8::Gemm g{H1, WupT, M_, FF_, D_}; pg8::StaticOrder S; S.init(M_, FF_, G, bx);
        EpiUp E{SS1, U};
        pg8::gemm_phase<EpiUp, pg8::StaticOrder, true, true>(lds, g, S, E);
        sample_gemm<3>(lds, X1GS, D_, WupT, nullptr, 0, nullptr, FF_, sp);
    }
    SEAM(7);
    if (IN(8)) {
        pg8::Gemm g{U, WdnT, M_, D_, FF_}; pg8::StaticOrder S; S.init(M_, D_, G, bx);
        EpiRes<false> E{out + O_Y, out + O_Y, nullptr, nullptr, SS2};
        pg8::gemm_phase<EpiRes<false>, pg8::StaticOrder, true, true>(lds, g, S, E);
        sample_gemm<4>(lds, US, FF_, WdnT, nullptr, 0, nullptr, D_, sp);
    }
    SEAM(8);
    if (IN(9)) {
        const float* gf = args.in[27];
        for (int m0 = gw * 4; m0 < M_ + MS_; m0 += NGW * 4) {
            float* rowp[4]; float rs[4]; f32x4 v[4][4];
#pragma unroll
            for (int u = 0; u < 4; ++u) { const int m = m0 + u; rowp[u] = (m < M_) ? (out + O_Y + (size_t)m * D_) : (out + O_YS + (size_t)(m - M_) * D_); const float ss = (m < M_) ? SS2[m] : SS2S[m - M_]; rs[u] = rsqrtf(ss * (1.f / D_) + NORM_EPS); }
#pragma unroll
            for (int u = 0; u < 4; ++u)
#pragma unroll
                for (int j = 0; j < 4; ++j) v[u][j] = *((const f32x4*)rowp[u] + lane + 64 * j);
#pragma unroll
            for (int j = 0; j < 4; ++j) { const f32x4 gg = *((const f32x4*)gf + lane + 64 * j);
#pragma unroll
                for (int u = 0; u < 4; ++u) *((f32x4*)rowp[u] + lane + 64 * j) = v[u][j] * rs[u] * gg; }
        }
    }
#undef IN
#undef SEAM
}
}

#ifndef MK_N_LAUNCHES
#define MK_N_LAUNCHES 1
#endif
extern "C" void kernel_launch(void* const* d_in, const int* in_sizes, int n_in, void* d_out, int out_size, void* d_ws, size_t ws_size, hipStream_t stream) {
    static int grid = 0;
    if (grid == 0) {
        if (n_in != 28 || (size_t)out_size != mk::O_END || ws_size < mk::WS_END) { fprintf(stderr, "kernel_launch: unexpected shapes: n_in %d out %d ws %zu\n", n_in, out_size, ws_size); grid = -1; return; }
        int dev = 0, cus = 0, per_cu = 0;
        if (hipGetDevice(&dev) != hipSuccess || hipDeviceGetAttribute(&cus, hipDeviceAttributeMultiprocessorCount, dev) != hipSuccess) { grid = -1; return; }
        if (hipFuncSetAttribute((const void*)mk::fwd_kernel, hipFuncAttributeMaxDynamicSharedMemorySize, mk::LDS_BYTES) != hipSuccess) { fprintf(stderr, "kernel_launch: hipFuncSetAttribute failed\n"); grid = -1; return; }
        if (hipOccupancyMaxActiveBlocksPerMultiprocessor(&per_cu, (const void*)mk::fwd_kernel, 512, mk::LDS_BYTES) != hipSuccess || per_cu < 1) { fprintf(stderr, "kernel_launch: occupancy query says %d\n", per_cu); }
        (void)hipGetLastError();
        grid = cus;
    }
    if (grid < 0) return;
    (void)hipMemsetAsync((char*)d_ws + mk::WS_CTL, 0, mk::CTL_ZERO_BYTES, stream);
    mk::Args a{};
    for (int i = 0; i < 28; ++i) a.in[i] = (const float*)d_in[i];
    a.out = (float*)d_out; a.ws = (unsigned char*)d_ws;
    if (MK_N_LAUNCHES == 1) {
        a.ph_lo = 0; a.ph_hi = mk::N_PH;
        void* params[] = {&a};
        hipError_t e = hipLaunchCooperativeKernel((const void*)mk::fwd_kernel, dim3(grid), dim3(512), params, mk::LDS_BYTES, stream);
        if (e != hipSuccess) fprintf(stderr, "cooperative launch failed: %s (grid %d)\n", hipGetErrorString(e), grid);
    } else {
        for (int ph = 0; ph < mk::N_PH; ++ph) { a.ph_lo = ph; a.ph_hi = ph + 1; hipLaunchKernelGGL(mk::fwd_kernel, dim3(grid), dim3(512), mk::LDS_BYTES, stream, a); }
    }
}
```

```cpp
#include <hip/hip_runtime.h>
#include <hip/hip_cooperative_groups.h>
#include <cstdio>
#include <cstdint>
namespace cg = cooperative_groups;
namespace pg8 {
#define PG8_LAS __attribute__((address_space(3)))
typedef unsigned short bf16_t;
typedef short bf16x8 __attribute__((ext_vector_type(8)));
typedef float f32x4 __attribute__((ext_vector_type(4)));
typedef unsigned u32x4 __attribute__((ext_vector_type(4)));
constexpr int BM = 256, BK = 64, HALF = 128, HTB = HALF * BK * 2  , STAGE_BYTES = 8 * HTB, NXCD = 8, WGM = 8;

__host__ __device__ __forceinline__ int lds_byte(int r, int c) { const int st = (r >> 4) * 2 + (c >> 5), rr = r & 15, cc = c & 31, ob = rr * 64 + cc * 2; return st * 1024 + (ob ^ (((ob >> 9) & 1) << 5)); }
__host__ __device__ __forceinline__ void stage_rc(int b, int& R, int& C) { const int st = b / 1024, sb = b % 1024, swz = sb ^ (((sb >> 9) & 1) << 5); R = (st >> 1) * 16 + swz / 64; C = (st & 1) * 32 + (swz % 64) / 2; }
__host__ __device__ __forceinline__ int perm32(int rho) { const int n = rho >> 4, i = rho & 15; return 8 * (i >> 2) + 4 * n + (i & 3); }

struct Unit { int pm, pn; };
struct Gemm { const bf16_t* A; const bf16_t* Bt; int M, N, K; };

struct StaticOrder {
    int nM, nN, nwg, G, c;
    __host__ __device__ void init(int M, int N, int G_, int c_) { nM = M / BM; nN = N / BM; nwg = nM * nN; G = G_; c = c_; }
    __host__ __device__ bool next(int i, Unit& u) const {
        const long L = (long)i * G + c; if (L >= nwg) return false;
        int wgid = (int)L; { const int q = nwg / NXCD, r = nwg % NXCD, xcd = wgid % NXCD, off = wgid / NXCD; wgid = (xcd < r ? xcd * (q + 1) : r * (q + 1) + (xcd - r) * q) + off; }
        const int nig = WGM * nN, gid = wgid / nig, fm = gid * WGM, gsz = (nM - fm) < WGM ? (nM - fm) : WGM;
        u.pm = fm + ((wgid % nig) % gsz); u.pn = (wgid % nig) / gsz; return true;
    }
    __device__ __forceinline__ void a_ready(const Unit&) const {}
    __device__ __forceinline__ void done(const Unit&) const {}
};

__device__ __forceinline__ unsigned cvt_pk_bf16(float lo, float hi) { unsigned r; asm volatile("v_cvt_pk_bf16_f32 %0, %1, %2" : "=v"(r) : "v"(lo), "v"(hi)); return r; }
template <class Epi, class Sched, bool ALIGN_EPI = false, bool SP2 = false>
__device__ __forceinline__ void gemm_phase(PG8_LAS unsigned char* lds, const Gemm g, const Sched& S, const Epi& E) {
    const int tid = threadIdx.x, wid = __builtin_amdgcn_readfirstlane(tid >> 6), lane = tid & 63, wr = wid >> 2, wc = wid & 3, fr = lane & 15, fq = lane >> 4;
    const int K = g.K, nt = K / BK;
    unsigned voffA[2], voffB[2];
#pragma unroll
    for (int i = 0; i < 2; ++i) { int R, C; stage_rc(tid * 16 + i * 8192, R, C); const int Rb = Epi::PERM ? ((R & ~31) + perm32(R & 31)) : R;
        voffA[i] = (unsigned)(R * K + C) * 2u; voffB[i] = (unsigned)(Rb * K + C) * 2u; }
    const size_t kstep = (size_t)(BK * 2);
    const size_t hstep = (size_t)HALF * K * 2;
    const size_t tstep = 2 * hstep;
    const unsigned ldsw = (unsigned)wid * 1024u;
    const int aoff = lds_byte(wr * 64 + fr, fq * 8), boff = lds_byte(wc * 32 + fr, fq * 8);
#define PG8_SA(b, h) (((b) * 2 + (h)) * HTB)
#define PG8_SB(b, h) ((4 + (b) * 2 + (h)) * HTB)
#define PG8_STAGE(bufoff, gbase, voff) do { _Pragma("unroll") for (int _i = 0; _i < 2; ++_i) \
        __builtin_amdgcn_global_load_lds((const unsigned*)((const char*)(gbase) + (voff)[_i]), (PG8_LAS unsigned*)(lds + (bufoff) + ldsw + _i * 8192), 16, 0, 0); } while (0)
#define PG8_LDA(dst, b, h) do { _Pragma("unroll") for (int m = 0; m < 4; ++m) _Pragma("unroll") for (int k = 0; k < 2; ++k) dst[m][k] = *(const PG8_LAS bf16x8*)(lds + PG8_SA(b, h) + aoff + m * 2048 + k * 1024); } while (0)
#define PG8_LDB(dst, b, h) do { _Pragma("unroll") for (int n = 0; n < 2; ++n) _Pragma("unroll") for (int k = 0; k < 2; ++k) dst[n][k] = *(const PG8_LAS bf16x8*)(lds + PG8_SB(b, h) + boff + n * 2048 + k * 1024); } while (0)
#define PG8_MMA(ai, bj, At, Bt) do { __builtin_amdgcn_s_setprio(1); _Pragma("unroll") for (int m = 0; m < 4; ++m) _Pragma("unroll") for (int n = 0; n < 2; ++n) _Pragma("unroll") for (int k = 0; k < 2; ++k) \
        acc[ai][bj][m][n] = __builtin_amdgcn_mfma_f32_16x16x32_bf16(Bt[n][k], At[m][k], acc[ai][bj][m][n], 0, 0, 0); __builtin_amdgcn_s_setprio(0); } while (0)
#define PG8_WAIT_V(n) asm volatile("s_waitcnt vmcnt(" #n ")" ::: "memory")
#define PG8_WAIT_L(n) asm volatile("s_waitcnt lgkmcnt(" #n ")" ::: "memory")
#define PG8_BAR __builtin_amdgcn_s_barrier()
#define PG8_SCHED __builtin_amdgcn_sched_barrier(0)
    Unit cur, nxt; int ui = 0;
    if (!S.next(0, cur)) return;
    f32x4 acc[2][2][4][2];
#pragma unroll
    for (int a = 0; a < 2; ++a)
#pragma unroll
        for (int b = 0; b < 2; ++b)
#pragma unroll
            for (int m = 0; m < 4; ++m)
#pragma unroll
                for (int n = 0; n < 2; ++n) acc[a][b][m][n] = (f32x4){0.f, 0.f, 0.f, 0.f};
    bf16x8 At[4][2], B0[2][2], B1[2][2];
    const char* cA = (const char*)g.A + (size_t)cur.pm * tstep; const char* cB = (const char*)g.Bt + (size_t)cur.pn * tstep;
    S.a_ready(cur);
    if constexpr (SP2) {
        PG8_STAGE(PG8_SB(0, 0), cB, voffB); PG8_STAGE(PG8_SB(0, 1), cB + hstep, voffB); PG8_STAGE(PG8_SA(0, 0), cA, voffA); PG8_STAGE(PG8_SA(0, 1), cA + hstep, voffA);
        if (wr == 1) PG8_BAR;
        PG8_WAIT_V(2); PG8_BAR;
        PG8_STAGE(PG8_SB(1, 0), cB + kstep, voffB); PG8_STAGE(PG8_SA(1, 0), cA + kstep, voffA); PG8_STAGE(PG8_SB(1, 1), cB + hstep + kstep, voffB);
        PG8_WAIT_V(6); PG8_BAR;
    } else {
        PG8_STAGE(PG8_SB(0, 0), cB, voffB); PG8_STAGE(PG8_SA(0, 0), cA, voffA); PG8_STAGE(PG8_SB(0, 1), cB + hstep, voffB); PG8_STAGE(PG8_SA(0, 1), cA + hstep, voffA);
        if (wr == 1) PG8_BAR;
        PG8_WAIT_V(4); PG8_BAR;
        PG8_STAGE(PG8_SB(1, 0), cB + kstep, voffB); PG8_STAGE(PG8_SA(1, 0), cA + kstep, voffA); PG8_STAGE(PG8_SB(1, 1), cB + hstep + kstep, voffB);
        PG8_WAIT_V(6); PG8_BAR;
    }
    for (;;) {
        const bool has_next = S.next(ui + 1, nxt);
        const char* nA = has_next ? (const char*)g.A + (size_t)nxt.pm * tstep : cA; const char* nB = has_next ? (const char*)g.Bt + (size_t)nxt.pn * tstep : cB;
        for (int t = 0; t < nt; t += 2) {
            const bool last = (t == nt - 2);
            const char* a1 = cA + (size_t)(t + 1) * kstep;
            const char* a2 = last ? nA : cA + (size_t)(t + 2) * kstep; const char* b2 = last ? nB : cB + (size_t)(t + 2) * kstep;
            const char* a3 = a2 + kstep; const char* b3 = b2 + kstep;
            if (last && has_next) S.a_ready(nxt);
            if constexpr (SP2) {
            PG8_LDB(B0, 0, 0); PG8_LDB(B1, 0, 1); PG8_SCHED; PG8_LDA(At, 0, 0); PG8_STAGE(PG8_SA(1, 1), a1 + hstep, voffA);
            PG8_WAIT_V(8); PG8_WAIT_L(0); PG8_BAR; PG8_MMA(0, 0, At, B0); PG8_MMA(0, 1, At, B1); PG8_BAR; PG8_SCHED;
            PG8_LDA(At, 0, 1); PG8_STAGE(PG8_SB(0, 0), b2, voffB); PG8_STAGE(PG8_SB(0, 1), b2 + hstep, voffB); PG8_STAGE(PG8_SA(0, 0), a2, voffA);
            PG8_WAIT_V(8); PG8_WAIT_L(0); PG8_BAR; PG8_MMA(1, 0, At, B0); PG8_MMA(1, 1, At, B1); PG8_BAR; PG8_SCHED;
            PG8_LDB(B0, 1, 0); PG8_LDB(B1, 1, 1); PG8_SCHED; PG8_LDA(At, 1, 0); PG8_STAGE(PG8_SA(0, 1), a2 + hstep, voffA);
            PG8_WAIT_V(8); PG8_WAIT_L(0); PG8_BAR; PG8_MMA(0, 0, At, B0); PG8_MMA(0, 1, At, B1); PG8_BAR; PG8_SCHED;
            PG8_LDA(At, 1, 1); PG8_STAGE(PG8_SB(1, 0), b3, voffB); PG8_STAGE(PG8_SB(1, 1), b3 + hstep, voffB); PG8_STAGE(PG8_SA(1, 0), a3, voffA);
            PG8_WAIT_V(8); PG8_WAIT_L(0); PG8_BAR; PG8_MMA(1, 0, At, B0); PG8_MMA(1, 1, At, B1); PG8_BAR; PG8_SCHED;
            } else {
            PG8_LDB(B0, 0, 0); PG8_SCHED; PG8_LDA(At, 0, 0); PG8_STAGE(PG8_SA(1, 1), a1 + hstep, voffA);
            PG8_WAIT_L(8); PG8_BAR; PG8_WAIT_L(0); PG8_MMA(0, 0, At, B0); PG8_BAR; PG8_SCHED;
            PG8_LDB(B1, 0, 1); PG8_STAGE(PG8_SB(0, 0), b2, voffB);
            PG8_BAR; PG8_WAIT_L(0); PG8_MMA(0, 1, At, B1); PG8_BAR;
            PG8_LDA(At, 0, 1); PG8_STAGE(PG8_SA(0, 0), a2, voffA);
            PG8_BAR; PG8_WAIT_L(0); PG8_MMA(1, 0, At, B0); PG8_BAR; PG8_SCHED;
            PG8_STAGE(PG8_SB(0, 1), b2 + hstep, voffB);
            PG8_WAIT_V(6); PG8_BAR; PG8_MMA(1, 1, At, B1); PG8_BAR;
            PG8_LDB(B0, 1, 0); PG8_SCHED; PG8_LDA(At, 1, 0); PG8_STAGE(PG8_SA(0, 1), a2 + hstep, voffA);
            PG8_WAIT_L(8); PG8_BAR; PG8_WAIT_L(0); PG8_MMA(0, 0, At, B0); PG8_BAR; PG8_SCHED;
            PG8_LDB(B1, 1, 1); PG8_STAGE(PG8_SB(1, 0), b3, voffB);
            PG8_BAR; PG8_WAIT_L(0); PG8_MMA(0, 1, At, B1); PG8_BAR;
            PG8_LDA(At, 1, 1); PG8_STAGE(PG8_SA(1, 0), a3, voffA);
            PG8_BAR; PG8_WAIT_L(0); PG8_MMA(1, 0, At, B0); PG8_BAR; PG8_SCHED;
            PG8_STAGE(PG8_SB(1, 1), b3 + hstep, voffB);
            PG8_WAIT_V(6); PG8_BAR; PG8_MMA(1, 1, At, B1); PG8_BAR;
            }
        }
        if constexpr (ALIGN_EPI) { if (wr == 0) PG8_BAR; }
        if constexpr (!Epi::AFTER_DRAIN) { E(acc, cur, wr, wc, fr, fq); S.done(cur); }
        if (!has_next) break;
#pragma unroll
        for (int a = 0; a < 2; ++a)
#pragma unroll
            for (int b = 0; b < 2; ++b)
#pragma unroll
                for (int m = 0; m < 4; ++m)
#pragma unroll
                    for (int n = 0; n < 2; ++n) acc[a][b][m][n] = (f32x4){0.f, 0.f, 0.f, 0.f};
        cur = nxt; cA = nA; cB = nB; ++ui;
        if constexpr (ALIGN_EPI) { if (wr == 1) PG8_BAR; }
    }
    PG8_WAIT_V(0);
    if constexpr (!ALIGN_EPI) { if (wr == 0) PG8_BAR; }
    PG8_BAR;
    if constexpr (Epi::AFTER_DRAIN) { E.fused(acc, cur, wr, wc, fr, fq, lds, wid, lane); S.done(cur); }
#undef PG8_SA
#undef PG8_SB
#undef PG8_STAGE
#undef PG8_LDA
#undef PG8_LDB
#undef PG8_MMA
#undef PG8_WAIT_V
#undef PG8_WAIT_L
#undef PG8_BAR
#undef PG8_SCHED
}
}

#ifndef PROBE_PREP
#define PROBE_PREP 1
#endif
#ifndef PROBE_SEQ
#define PROBE_SEQ 1
#endif
#ifndef PROBE_ATTN
#define PROBE_ATTN 1
#endif
#ifndef MK_USE_CG
#define MK_USE_CG 1
#endif
namespace mk {
using pg8::bf16_t; using pg8::bf16x8; using pg8::f32x4; using pg8::u32x4; using pg8::Unit; using pg8::cvt_pk_bf16;
typedef unsigned u32x2 __attribute__((ext_vector_type(2)));
typedef float f32x16 __attribute__((ext_vector_type(16)));
#define LAS __attribute__((address_space(3)))

constexpr int T_ = 2048, NB_ = 8, M_ = NB_ * T_, MS_ = 32, D_ = 1024, NIN_ = 6144, FF_ = 4096;
constexpr int QKVW = 2304, ZBW = 1792, GTW = 2048;
constexpr float NORM_EPS = 1e-6f, GN_EPS = 64e-5f;
constexpr size_t O_Y = 0, O_YS = O_Y + (size_t)M_ * D_, O_KV128P = O_YS + (size_t)MS_ * D_, O_KV512P = O_KV128P + (size_t)NB_ * 128 * 512,
                 O_KV2048P = O_KV512P + (size_t)NB_ * 512 * 512, O_WKVP = O_KV2048P + (size_t)NB_ * 2048 * 512, O_SHIFTP = O_WKVP + (size_t)NB_ * 8 * 4096,
                 O_KV128S = O_SHIFTP + (size_t)NB_ * ZBW, O_KV512S = O_KV128S + (size_t)MS_ * 512, O_KV2048S = O_KV512S + (size_t)MS_ * 512,
                 O_WKVS = O_KV2048S + (size_t)MS_ * 512, O_SHIFTS = O_WKVS + (size_t)MS_ * 8 * 4096, O_END = O_SHIFTS + (size_t)MS_ * ZBW;
constexpr size_t MiB = 1u << 20, KiB = 1u << 10;
constexpr size_t WS_CTL = 0, CTL_ZERO_BYTES = 1 * MiB;
constexpr size_t CTL_SS1 = 64 * KiB, CTL_SS1S = 128 * KiB, CTL_SS2 = 192 * KiB, CTL_SS2S = 256 * KiB, CTL_BAR = 512 * KiB;
constexpr size_t WS_WIN = 2 * MiB, WS_WA = 14 * MiB, WS_WB = 14 * MiB + 512 * KiB, WS_WO = 16 * MiB, WS_WUP = 18 * MiB, WS_WDN = 26 * MiB;
constexpr size_t WS_WL = 34 * MiB, WS_AL = WS_WL + 64 * KiB, WS_GL = WS_WL + 128 * KiB;
constexpr size_t WS_SMALL = 35 * MiB;
constexpr size_t SM_H1S = 0, SM_ZS = 64 * KiB, SM_ATTS = 832 * KiB, SM_RWS = 848 * KiB, SM_MGS = 880 * KiB, SM_X1GS = 944 * KiB, SM_US = 1024 * KiB;
constexpr size_t WS_H1 = 38 * MiB, WS_QKV = 70 * MiB, WS_ZB = 142 * MiB, WS_U = 70 * MiB, WS_GATE = 198 * MiB, WS_OG = 262 * MiB, WS_LSE = 286 * MiB,
                 WS_Y = 287 * MiB, WS_G = 319 * MiB, WS_BON = 351 * MiB, WS_TMP = 287 * MiB, WS_REC = 383 * MiB, WS_ATT = 383 * MiB, WS_RW = 391 * MiB, WS_MG = 407 * MiB, WS_END = 481 * MiB;
constexpr int RING_BYTES = 131072, MISC_OFF = RING_BYTES + 320, LDS_BYTES = 147456;

__device__ __forceinline__ float bf2f(unsigned short h) { return __builtin_bit_cast(float, (unsigned)h << 16); }
__device__ __forceinline__ unsigned pk2(float lo, float hi);
__device__ __forceinline__ unsigned f2bf(float f) { return pk2(f, 0.f) & 0xffffu; }
typedef float f32x2_t __attribute__((ext_vector_type(2))); typedef __bf16 bf16x2_t __attribute__((ext_vector_type(2)));
__device__ __forceinline__ unsigned pk2(float lo, float hi) { const f32x2_t v = {lo, hi}; const bf16x2_t b = __builtin_convertvector(v, bf16x2_t); return __builtin_bit_cast(unsigned, b); }
__device__ __forceinline__ float sigm(float x) { return __builtin_amdgcn_rcpf(1.f + __expf(-x)); }
__device__ __forceinline__ float tanh_fast(float x) { return 1.f - 2.f * __builtin_amdgcn_rcpf(1.f + __expf(2.f * x)); }
__device__ __forceinline__ void store8bf(bf16_t* p, f32x4 v0, f32x4 v1) { u32x4 w; w.x = pk2(v0[0], v0[1]); w.y = pk2(v0[2], v0[3]); w.z = pk2(v1[0], v1[1]); w.w = pk2(v1[2], v1[3]); *(u32x4*)p = w; }
__device__ __forceinline__ void store4bf(bf16_t* p, f32x4 v) { u32x2 w; w.x = pk2(v[0], v[1]); w.y = pk2(v[2], v[3]); *(u32x2*)p = w; }
__device__ __forceinline__ f32x4 load4bf(const bf16_t* p) { const u32x2 w = *(const u32x2*)p; f32x4 r; r[0] = __builtin_bit_cast(float, w.x << 16); r[1] = __builtin_bit_cast(float, w.x & 0xffff0000u); r[2] = __builtin_bit_cast(float, w.y << 16); r[3] = __builtin_bit_cast(float, w.y & 0xffff0000u); return r; }
template <int CTRL> __device__ __forceinline__ float dppf(float v) { return __builtin_bit_cast(float, __builtin_amdgcn_update_dpp(0, __builtin_bit_cast(int, v), CTRL, 0xF, 0xF, true)); }
__device__ __forceinline__ float red16(float v) { v += dppf<0xB1>(v); v += dppf<0x4E>(v); v += dppf<0x141>(v); v += dppf<0x140>(v); return v; }
__device__ __forceinline__ float red8(float v) { v += dppf<0xB1>(v); v += dppf<0x4E>(v); v += dppf<0x141>(v); return v; }
__device__ __forceinline__ float wave_sum(float v) {
#pragma unroll
    for (int o = 1; o < 64; o <<= 1) v += __shfl_xor(v, o);
    return v;
}
__device__ __forceinline__ float wave_max(float v) {
#pragma unroll
    for (int o = 1; o < 64; o <<= 1) v = fmaxf(v, __shfl_xor(v, o));
    return v;
}

#define XB_TMO      128
#define XB_XCNT(j)  (256  + 64 * (j))
#define XB_XSUB(j)  (1280 + 64 * (j))
#define XB_XGEN(j)  (2304 + 64 * (j))
#define XB_TOP      3328
#define XB_TOPGEN   3392
#define XCD_BAR_WORDS 3456
#define XB_SPIN_CAP (1u << 18)

__device__ __forceinline__ unsigned xb_ld(unsigned* p)              { return __hip_atomic_load(p, __ATOMIC_RELAXED, __HIP_MEMORY_SCOPE_AGENT); }
__device__ __forceinline__ unsigned xb_add(unsigned* p, unsigned v) { return __hip_atomic_fetch_add(p, v, __ATOMIC_RELAXED, __HIP_MEMORY_SCOPE_AGENT); }
__device__ __forceinline__ unsigned xb_xcc_id() { return (unsigned)__builtin_amdgcn_s_getreg((3 << 11) | 20) & 0xFu; }
#define XB_SPIN(cond, bar) do { unsigned _sp = 0; while (cond) { __builtin_amdgcn_s_sleep(1); \
    if ((++_sp & 255u) == 0u) { if (xb_ld(&(bar)[XB_TMO])) break; if (_sp > XB_SPIN_CAP) { atomicAdd(&(bar)[XB_TMO], 1u); break; } } } } while (0)

struct XcdBarrier {
    unsigned* bar; unsigned x;
    volatile LAS unsigned* st;
};

__device__ __forceinline__ XcdBarrier xcd_barrier_post(unsigned* bar, volatile LAS unsigned* st) {
    XcdBarrier b; b.bar = bar; b.x = xb_xcc_id(); b.st = st;
    if (threadIdx.x == 0) (void)xb_add(&bar[XB_XCNT(b.x)], 1u);
    return b;
}
__device__ __forceinline__ void xcd_barrier_complete(unsigned* bar, unsigned x, unsigned& nloc, unsigned& nx) {
    const unsigned G = gridDim.x * gridDim.y * gridDim.z;
    unsigned sum, cnt, mine, sp = 0u;
    for (;;) {
        sum = 0u; cnt = 0u; mine = 0u;
#pragma unroll
        for (unsigned j = 0; j < 16; ++j) { const unsigned c = xb_ld(&bar[XB_XCNT(j)]); sum += c; cnt += (c > 0u) ? 1u : 0u; mine = (j == x) ? c : mine; }
        if (sum == G) break;
        __builtin_amdgcn_s_sleep(1);
        if ((++sp & 255u) == 0u) { if (xb_ld(&bar[XB_TMO])) break; if (sp > XB_SPIN_CAP) { atomicAdd(&bar[XB_TMO], 1u); break; } }
    }
    nloc = mine > 0u ? mine : 1u; nx = cnt > 0u ? cnt : 1u;
}

__device__ __forceinline__ void xcd_barrier(const XcdBarrier& b) {
    asm volatile("s_waitcnt vmcnt(0)" ::: "memory");
    __syncthreads();
    if (threadIdx.x == 0) {
        unsigned* bar = b.bar;
        __builtin_amdgcn_s_waitcnt(0);
        unsigned nloc = b.st[0], nx = b.st[1];
        if (nloc == 0u) { xcd_barrier_complete(bar, b.x, nloc, nx); b.st[0] = nloc; b.st[1] = nx; }
        const unsigned old = xb_add(&bar[XB_XSUB(b.x)], 1u);
        const unsigned gen = old / nloc;
        if (old + 1u == (gen + 1u) * nloc) {
            __builtin_amdgcn_fence(__ATOMIC_RELEASE, "agent");
            asm volatile("s_waitcnt vmcnt(0)" ::: "memory");
            const unsigned og = xb_add(&bar[XB_TOP], 1u);
            const unsigned tg = og / nx;
            if (og + 1u == (tg + 1u) * nx) xb_add(&bar[XB_TOPGEN], 1u);
            else XB_SPIN(xb_ld(&bar[XB_TOPGEN]) == tg, bar);
            __builtin_amdgcn_fence(__ATOMIC_ACQUIRE, "agent");
            xb_add(&bar[XB_XGEN(b.x)], 1u);
            asm volatile("s_waitcnt vmcnt(0)" ::: "memory");
        } else {
            XB_SPIN(xb_ld(&bar[XB_XGEN(b.x)]) == gen, bar);
            __builtin_amdgcn_fence(__ATOMIC_ACQUIRE, "agent");
            asm volatile("s_waitcnt vmcnt(0)" ::: "memory");
        }
    }
    __syncthreads();
}

struct EpiZ {
    static constexpr bool PERM = true, AFTER_DRAIN = false;
    bf16_t* QKV; bf16_t* ZB; bf16_t* GATE; const float* b_gate; float* out;
    __device__ __forceinline__ void operator()(const f32x4 (&acc)[2][2][4][2], const Unit& u, int wr, int wc, int fr, int fq) const {
        const int pn = u.pn;
#pragma unroll
        for (int ai = 0; ai < 2; ++ai)
#pragma unroll
            for (int m = 0; m < 4; ++m) {
                const int row = u.pm * 256 + ai * 128 + wr * 64 + m * 16 + fr; const int b = row >> 11, t = row & 2047;
#pragma unroll
                for (int bj = 0; bj < 2; ++bj) {
                    const int col = pn * 256 + bj * 128 + wc * 32 + 8 * fq;
                    const f32x4 v0 = acc[ai][bj][m][0], v1 = acc[ai][bj][m][1];
                    if (pn < 9) {
                        { const int sel = col / 768, cq = col - sel * 768, hd = cq >> 6, dsh_ = 2 * (hd >> 2);
                          const int pos = ((t & ((1 << dsh_) - 1)) << (11 - dsh_)) + (t >> dsh_);
                          store8bf(QKV + ((((size_t)sel * NB_ + b) * 12 + hd) * T_ + pos) * 64 + (cq & 63), v0, v1); }
                        if (col >= 768) {
                            const int kvsel = col >= 1536 ? 1 : 0; const int cc = col - 768 - kvsel * 768; const int head = cc >> 6, g = head >> 2, hs = head & 3, d = cc & 63;
                            const int rows_g = 128 << (2 * g); const int j = t - (T_ - rows_g);
                            if (j >= 0) { float* dst = out + (g == 0 ? O_KV128P : (g == 1 ? O_KV512P : O_KV2048P)) + ((size_t)(b * rows_g + j) * 2 + kvsel) * 256 + hs * 64 + d; *(f32x4*)dst = v0; *(f32x4*)(dst + 4) = v1; }
                        }
                    } else if (pn < 16) {
                        const int c = col - QKVW; store8bf(ZB + (size_t)row * ZBW + c, v0, v1);
                        if (t == T_ - 1) { float* dst = out + O_SHIFTP + (size_t)b * ZBW + c; *(f32x4*)dst = v0; *(f32x4*)(dst + 4) = v1; }
                    } else {
                        const int c = col - 4096; const f32x4 b0 = *(const f32x4*)(b_gate + c), b1 = *(const f32x4*)(b_gate + c + 4); f32x4 g0, g1;
#pragma unroll
                        for (int e = 0; e < 4; ++e) { g0[e] = sigm(v0[e] + b0[e]); g1[e] = sigm(v1[e] + b1[e]); }
                        store8bf(GATE + (size_t)row * GTW + c, g0, g1);
                    }
                }
            }
    }
};
struct EpiPA {
    static constexpr bool PERM = false, AFTER_DRAIN = false;
    const bf16_t* GATE; float* TMP;
    __device__ __forceinline__ void operator()(const f32x4 (&acc)[2][2][4][2], const Unit& u, int wr, int wc, int fr, int fq) const {
#pragma unroll
        for (int ai = 0; ai < 2; ++ai)
#pragma unroll
            for (int m = 0; m < 4; ++m) { const int row = u.pm * 256 + ai * 128 + wr * 64 + m * 16 + fr;
#pragma unroll
                for (int bj = 0; bj < 2; ++bj)
#pragma unroll
                    for (int n = 0; n < 2; ++n) { const int col = u.pn * 256 + bj * 128 + wc * 32 + 16 * n + 4 * fq;
                        const f32x4 ga = load4bf(GATE + (size_t)row * GTW + col); *(f32x4*)(TMP + (size_t)row * D_ + col) = ga * acc[ai][bj][m][n]; }
                asm volatile("" ::: "memory"); }
    }
};
struct EpiPB {
    static constexpr bool PERM = false, AFTER_DRAIN = false;
    const bf16_t* GATE; const float* TMP; bf16_t* MG;
    __device__ __forceinline__ void operator()(const f32x4 (&acc)[2][2][4][2], const Unit& u, int wr, int wc, int fr, int fq) const {
#pragma unroll
        for (int ai = 0; ai < 2; ++ai)
#pragma unroll
            for (int m = 0; m < 4; ++m) { const int row = u.pm * 256 + ai * 128 + wr * 64 + m * 16 + fr;
#pragma unroll
                for (int bj = 0; bj < 2; ++bj)
#pragma unroll
                    for (int n = 0; n < 2; ++n) { const int col = u.pn * 256 + bj * 128 + wc * 32 + 16 * n + 4 * fq;
                        const f32x4 gb = load4bf(GATE + (size_t)row * GTW + D_ + col); const f32x4 t = *(const f32x4*)(TMP + (size_t)row * D_ + col);
                        store4bf(MG + (size_t)row * D_ + col, t + gb * acc[ai][bj][m][n]); }
                asm volatile("" ::: "memory"); }
    }
};
template <bool WRITE_XG> struct EpiRes {
    static constexpr bool PERM = false, AFTER_DRAIN = false;
    const float* xin; float* xo; bf16_t* XG; const float* g; float* SS;
    __device__ __forceinline__ void operator()(const f32x4 (&acc)[2][2][4][2], const Unit& u, int wr, int wc, int fr, int fq) const {
#pragma unroll
        for (int ai = 0; ai < 2; ++ai)
#pragma unroll
            for (int m = 0; m < 4; ++m) { const int row = u.pm * 256 + ai * 128 + wr * 64 + m * 16 + fr; float ss = 0.f;
#pragma unroll
                for (int bj = 0; bj < 2; ++bj)
#pragma unroll
                    for (int n = 0; n < 2; ++n) { const int col = u.pn * 256 + bj * 128 + wc * 32 + 16 * n + 4 * fq;
                        const f32x4 x1 = *(const f32x4*)(xin + (size_t)row * D_ + col) + acc[ai][bj][m][n];
                        *(f32x4*)(xo + (size_t)row * D_ + col) = x1; ss += (x1[0] * x1[0] + x1[1] * x1[1]) + (x1[2] * x1[2] + x1[3] * x1[3]);
                        if (WRITE_XG) { const f32x4 gg = *(const f32x4*)(g + col); store4bf(XG + (size_t)row * D_ + col, x1 * gg); } }
                ss += __shfl_xor(ss, 16); ss += __shfl_xor(ss, 32);
                if (fq == 0) atomicAdd(SS + row, ss);
                asm volatile("" ::: "memory"); }
    }
};
struct EpiUp {
    static constexpr bool PERM = true, AFTER_DRAIN = false;
    const float* SS; bf16_t* U;
    __device__ __forceinline__ void operator()(const f32x4 (&acc)[2][2][4][2], const Unit& u, int wr, int wc, int fr, int fq) const {
#pragma unroll
        for (int ai = 0; ai < 2; ++ai)
#pragma unroll
            for (int m = 0; m < 4; ++m) { const int row = u.pm * 256 + ai * 128 + wr * 64 + m * 16 + fr; const float rs = rsqrtf(SS[row] * (1.f / D_) + NORM_EPS);
#pragma unroll
                for (int bj = 0; bj < 2; ++bj) { const int col = u.pn * 256 + bj * 128 + wc * 32 + 8 * fq; f32x4 v0 = acc[ai][bj][m][0] * rs, v1 = acc[ai][bj][m][1] * rs;
#pragma unroll
                    for (int e = 0; e < 4; ++e) { const float a = fmaxf(v0[e], 0.f), b = fmaxf(v1[e], 0.f); v0[e] = a * a; v1[e] = b * b; }
                    store8bf(U + (size_t)row * FF_ + col, v0, v1); } }
    }
};

struct SP { float* ZS; const float* b_gate; float* out; const float* xs; const float* g2; bf16_t* MGS; bf16_t* X1GS; bf16_t* US; float* SS1S; float* SS2S; };
template <int MODE> __device__ __forceinline__ void sample_gemm(LAS unsigned char* lds, const bf16_t* A1, int K1, const bf16_t* B1, const bf16_t* A2, int K2, const bf16_t* B2, int N, const SP p) {
    const int tid = threadIdx.x, wid = tid >> 6, lane = tid & 63, r = lane & 31, hh = lane >> 5;
    LAS float* P = (LAS float*)lds;
    for (int tile = blockIdx.x; tile < N / 32; tile += gridDim.x) {
        const int n0 = tile * 32;
        f32x16 acc1, acc2;
#pragma unroll
        for (int i = 0; i < 16; ++i) { acc1[i] = 0.f; acc2[i] = 0.f; }
        { const int kw = K1 / 8; const bf16_t* ap = A1 + (size_t)r * K1 + wid * kw + 8 * hh; const bf16_t* bp = B1 + (size_t)(n0 + r) * K1 + wid * kw + 8 * hh;
#pragma unroll 4
          for (int k = 0; k < kw; k += 16) { const bf16x8 a = *(const bf16x8*)(ap + k), b = *(const bf16x8*)(bp + k); acc1 = __builtin_amdgcn_mfma_f32_32x32x16_bf16(a, b, acc1, 0, 0, 0); } }
        if (K2 > 0) { const int kw = K2 / 8; const bf16_t* ap = A2 + (size_t)r * K2 + wid * kw + 8 * hh; const bf16_t* bp = B2 + (size_t)(n0 + r) * K2 + wid * kw + 8 * hh;
#pragma unroll 4
          for (int k = 0; k < kw; k += 16) { const bf16x8 a = *(const bf16x8*)(ap + k), b = *(const bf16x8*)(bp + k); acc2 = __builtin_amdgcn_mfma_f32_32x32x16_bf16(a, b, acc2, 0, 0, 0); } }
#pragma unroll
        for (int reg = 0; reg < 16; ++reg) { const int row = (reg & 3) + 8 * (reg >> 2) + 4 * hh; P[wid * 1024 + row * 32 + r] = acc1[reg]; if (K2 > 0) P[8192 + wid * 1024 + row * 32 + r] = acc2[reg]; }
        __syncthreads();
        const int row = tid >> 4, c2 = (tid & 15) * 2, col = n0 + c2;
        float s1a = 0.f, s1b = 0.f, s2a = 0.f, s2b = 0.f;
#pragma unroll
        for (int w = 0; w < 8; ++w) { s1a += P[w * 1024 + row * 32 + c2]; s1b += P[w * 1024 + row * 32 + c2 + 1]; if (K2 > 0) { s2a += P[8192 + w * 1024 + row * 32 + c2]; s2b += P[8192 + w * 1024 + row * 32 + c2 + 1]; } }
        if (MODE == 0) {
            p.ZS[(size_t)row * NIN_ + col] = s1a; p.ZS[(size_t)row * NIN_ + col + 1] = s1b;
            if (col >= 768 && col < QKVW) { const int kvsel = col >= 1536 ? 1 : 0; const int cc = col - 768 - kvsel * 768; const int head = cc >> 6, g = head >> 2, hs = head & 3, d = cc & 63;
                float* dst = p.out + (g == 0 ? O_KV128S : (g == 1 ? O_KV512S : O_KV2048S)) + ((size_t)row * 2 + kvsel) * 256 + hs * 64 + d; dst[0] = s1a; dst[1] = s1b; }
            else if (col >= QKVW && col < 4096) { float* dst = p.out + O_SHIFTS + (size_t)row * ZBW + (col - QKVW); dst[0] = s1a; dst[1] = s1b; }
        } else if (MODE == 1) {
            const float* zg = p.ZS + (size_t)row * NIN_ + 4096;
            const float ga0 = sigm(zg[col] + p.b_gate[col]), ga1 = sigm(zg[col + 1] + p.b_gate[col + 1]), gb0 = sigm(zg[D_ + col] + p.b_gate[D_ + col]), gb1 = sigm(zg[D_ + col + 1] + p.b_gate[D_ + col + 1]);
            *(unsigned*)(p.MGS + (size_t)row * D_ + col) = pk2(ga0 * s1a + gb0 * s2a, ga1 * s1b + gb1 * s2b);
        } else if (MODE == 2 || MODE == 4) {
            const float* xin = (MODE == 2) ? p.xs : (p.out + O_YS); float* xo = p.out + O_YS;
            const float x0 = xin[(size_t)row * D_ + col] + s1a, x1 = xin[(size_t)row * D_ + col + 1] + s1b;
            xo[(size_t)row * D_ + col] = x0; xo[(size_t)row * D_ + col + 1] = x1;
            if (MODE == 2) *(unsigned*)(p.X1GS + (size_t)row * D_ + col) = pk2(x0 * p.g2[col], x1 * p.g2[col + 1]);
            float ss = x0 * x0 + x1 * x1; ss = red16(ss);
            if ((tid & 15) == 0) atomicAdd((MODE == 2 ? p.SS1S : p.SS2S) + row, ss);
        } else if (MODE == 3) {
            const float rs = rsqrtf(p.SS1S[row] * (1.f / D_) + NORM_EPS); const float a = fmaxf(rs * s1a, 0.f), b = fmaxf(rs * s1b, 0.f);
            *(unsigned*)(p.US + (size_t)row * FF_ + col) = pk2(a * a, b * b);
        }
        __syncthreads();
    }
}

__device__ __forceinline__ void p0_transpose_item(const float* W, int K, int N, bf16_t* WT, LAS float* scr, int item, int lane) {
    const int nblk = N / 32, kb = item / nblk, nb = item % nblk, k0 = 64 * kb, n0 = 32 * nb;
#pragma unroll 8
    for (int i = 0; i < 32; ++i) { const int kk = 2 * i + (lane >> 5); scr[kk * 33 + (lane & 31)] = W[(size_t)(k0 + kk) * N + n0 + (lane & 31)]; }
    asm volatile("s_waitcnt lgkmcnt(0)" ::: "memory");
    const int c = lane & 7;
#pragma unroll
    for (int j = 0; j < 4; ++j) { const int n = (lane >> 3) + 8 * j; const LAS float* s = scr + (8 * c) * 33 + n;
        u32x4 o; o.x = pk2(s[0 * 33], s[1 * 33]); o.y = pk2(s[2 * 33], s[3 * 33]); o.z = pk2(s[4 * 33], s[5 * 33]); o.w = pk2(s[6 * 33], s[7 * 33]);
        *(u32x4*)(WT + (size_t)(n0 + n) * K + k0 + 8 * c) = o; }
    asm volatile("s_waitcnt lgkmcnt(0)" ::: "memory");
}
__device__ __forceinline__ void rms_row_to_bf16(const float* xrow, const float* g, bf16_t* orow, int lane) {
    f32x4 v[4]; float s = 0.f;
#pragma unroll
    for (int j = 0; j < 4; ++j) { v[j] = *((const f32x4*)xrow + lane + 64 * j); s += (v[j][0] * v[j][0] + v[j][1] * v[j][1]) + (v[j][2] * v[j][2] + v[j][3] * v[j][3]); }
    const float rs = rsqrtf(wave_sum(s) * (1.f / D_) + NORM_EPS);
#pragma unroll
    for (int j = 0; j < 4; ++j) { const f32x4 gg = *((const f32x4*)g + lane + 64 * j); store4bf(orow + 4 * (lane + 64 * j), v[j] * rs * gg); }
}

__device__ __forceinline__ void rms_row2_to_bf16(const float* x0, const float* x1, const float* g, bf16_t* o0, bf16_t* o1, int lane) {
    f32x4 a[4], b[4]; float sa = 0.f, sb = 0.f;
#pragma unroll
    for (int j = 0; j < 4; ++j) { a[j] = *((const f32x4*)x0 + lane + 64 * j); b[j] = *((const f32x4*)x1 + lane + 64 * j); }
#pragma unroll
    for (int j = 0; j < 4; ++j) { sa += (a[j][0] * a[j][0] + a[j][1] * a[j][1]) + (a[j][2] * a[j][2] + a[j][3] * a[j][3]); sb += (b[j][0] * b[j][0] + b[j][1] * b[j][1]) + (b[j][2] * b[j][2] + b[j][3] * b[j][3]); }
#pragma unroll
    for (int o = 1; o < 64; o <<= 1) { sa += __shfl_xor(sa, o); sb += __shfl_xor(sb, o); }
    const float ra = rsqrtf(sa * (1.f / D_) + NORM_EPS), rb = rsqrtf(sb * (1.f / D_) + NORM_EPS);
#pragma unroll
    for (int j = 0; j < 4; ++j) { const f32x4 gg = *((const f32x4*)g + lane + 64 * j); store4bf(o0 + 4 * (lane + 64 * j), a[j] * ra * gg); store4bf(o1 + 4 * (lane + 64 * j), b[j] * rb * gg); }
}
constexpr int AT_KS = 0, AT_VT = 36864, AT_PS = 72704;
struct AttnLd { u32x4 k[4], v[4]; bf16x8 q0, q1; };
__device__ __forceinline__ void attn_load(AttnLd& L, int item, const bf16_t* QKV) {
    int tid_ = threadIdx.x; asm volatile("" : "+v"(tid_));
    const int tid = tid_, wid = tid >> 6, lane = tid & 63, fr = lane & 15, fq = lane >> 4;
    const int blk = item & 15, hs = (item >> 4) & 3, g = (item >> 6) % 3, b = item / 192;
    const int dsh = 2 * g, nbk = 16 >> dsh, r = blk / nbk, n = blk % nbk, h = g * 4 + hs;
    const int Lr = T_ >> dsh;
    const bf16_t* qb = QKV + (((size_t)(0 * NB_ + b) * 12 + h) * T_ + (size_t)r * Lr) * 64;
    const bf16_t* kb = QKV + (((size_t)(1 * NB_ + b) * 12 + h) * T_ + (size_t)r * Lr) * 64;
    const bf16_t* vb = QKV + (((size_t)(2 * NB_ + b) * 12 + h) * T_ + (size_t)r * Lr) * 64;
#pragma unroll
    for (int i = 0; i < 4; ++i) { const int c = tid + 512 * i, row = c >> 3, part = c & 7; const int e = (n - 1) * 128 + row;
        L.k[i] = (u32x4){0u, 0u, 0u, 0u}; if (e >= 0) L.k[i] = *(const u32x4*)(kb + (size_t)e * 64 + part * 8); }
#pragma unroll
    for (int i = 0; i < 4; ++i) { const int key = tid & 255, part = (tid >> 8) + 2 * i; const int e = (n - 1) * 128 + key;
        L.v[i] = (u32x4){0u, 0u, 0u, 0u}; if (e >= 0) L.v[i] = *(const u32x4*)(vb + (size_t)e * 64 + part * 8); }
    const int qi = 16 * wid + fr; const int eq = n * 128 + qi;
    L.q0 = *(const bf16x8*)(qb + (size_t)eq * 64 + 8 * fq); L.q1 = *(const bf16x8*)(qb + (size_t)eq * 64 + 32 + 8 * fq);
}
__device__ __forceinline__ void attn_unit(LAS unsigned char* lds, int item, int next_item, AttnLd& L, const bf16_t* QKV, bf16_t* OG, float* LSE, volatile LAS int* qslot, int tk_pub) {
    int tid_ = threadIdx.x; asm volatile("" : "+v"(tid_));
    const int tid = tid_, wid = __builtin_amdgcn_readfirstlane(tid >> 6), lane = tid & 63, fr = lane & 15, fq = lane >> 4;
    const int blk = item & 15, hs = (item >> 4) & 3, g = (item >> 6) % 3, b = item / 192;
    const int dsh = 2 * g, nbk = 16 >> dsh, r = blk / nbk, n = blk % nbk, h = g * 4 + hs;
    const float slope = exp2f(-8.0f * (float)(h + 1) / 12.0f);
    LAS unsigned char* Ks = lds + AT_KS; LAS unsigned char* Vt = lds + AT_VT;
#pragma unroll
    for (int i = 0; i < 4; ++i) { const int c = tid + 512 * i, row = c >> 3, part = c & 7; *(LAS u32x4*)(Ks + row * 144 + part * 16) = L.k[i]; }
#pragma unroll
    for (int i = 0; i < 4; ++i) { const int key = tid & 255, part = (tid >> 8) + 2 * i; const u32x4 v = L.v[i];
        LAS unsigned short* dst = (LAS unsigned short*)(Vt + (part * 8) * 560 + key * 2);
        dst[0 * 280] = (unsigned short)(v.x & 0xffff); dst[1 * 280] = (unsigned short)(v.x >> 16); dst[2 * 280] = (unsigned short)(v.y & 0xffff); dst[3 * 280] = (unsigned short)(v.y >> 16);
        dst[4 * 280] = (unsigned short)(v.z & 0xffff); dst[5 * 280] = (unsigned short)(v.z >> 16); dst[6 * 280] = (unsigned short)(v.w & 0xffff); dst[7 * 280] = (unsigned short)(v.w >> 16); }
    if (tid < 64) { const u32x4 z4 = (u32x4){0u, 0u, 0u, 0u}; *(LAS u32x4*)(Vt + tid * 560 + 512) = z4; *(LAS u32x4*)(Vt + tid * 560 + 528) = z4; *(LAS u32x4*)(Vt + tid * 560 + 544) = z4; }
    const bf16x8 qa0 = L.q0, qa1 = L.q1;
    __syncthreads();
    if (next_item >= 0) attn_load(L, next_item, QKV);
    f32x4 s[10];
    float mx = -3.0e38f;
    const int i = 16 * wid + fr;
#pragma unroll
    for (int jt = 0; jt < 10; ++jt) {
        const int jtile = wid + jt; f32x4 a = (f32x4){0.f, 0.f, 0.f, 0.f};
        if (jtile < 16) {
            const bf16x8 k0 = *(const LAS bf16x8*)(Ks + (jtile * 16 + fr) * 144 + fq * 16), k1 = *(const LAS bf16x8*)(Ks + (jtile * 16 + fr) * 144 + 64 + fq * 16);
            a = __builtin_amdgcn_mfma_f32_16x16x32_bf16(k0, qa0, a, 0, 0, 0); a = __builtin_amdgcn_mfma_f32_16x16x32_bf16(k1, qa1, a, 0, 0, 0);
        }
#pragma unroll
        for (int e = 0; e < 4; ++e) { const int j = jtile * 16 + 4 * fq + e; const int delta = 128 + i - j;
            const bool valid = (jtile < 16) && (delta >= 0) && (delta <= 128) && (n > 0 || j >= 128);
            const float sc = valid ? (a[e] * 0.125f - slope * (float)(delta << dsh)) : -1.0e30f; a[e] = sc; mx = fmaxf(mx, sc); }
        s[jt] = a;
    }
    mx = fmaxf(mx, __shfl_xor(mx, 16)); mx = fmaxf(mx, __shfl_xor(mx, 32));
    float lsum = 0.f;
#pragma unroll
    for (int jt = 0; jt < 10; ++jt)
#pragma unroll
        for (int e = 0; e < 4; ++e) { const float p = __expf(s[jt][e] - mx); lsum += p; s[jt][e] = p; }
    lsum += __shfl_xor(lsum, 16); lsum += __shfl_xor(lsum, 32);
    f32x4 o[4];
#pragma unroll
    for (int nt = 0; nt < 4; ++nt) o[nt] = (f32x4){0.f, 0.f, 0.f, 0.f};
#pragma unroll
    for (int u = 0; u < 5; ++u) {
        u32x4 pw; pw.x = pk2(s[2 * u][0], s[2 * u][1]); pw.y = pk2(s[2 * u][2], s[2 * u][3]); pw.z = pk2(s[2 * u + 1][0], s[2 * u + 1][1]); pw.w = pk2(s[2 * u + 1][2], s[2 * u + 1][3]);
        const bf16x8 pb = __builtin_bit_cast(bf16x8, pw);
#pragma unroll
        for (int nt = 0; nt < 4; ++nt) { const LAS unsigned char* vp = Vt + (nt * 16 + fr) * 560 + (16 * wid + 32 * u + 4 * fq) * 2;
            const u32x2 v0 = *(const LAS u32x2*)vp, v1 = *(const LAS u32x2*)(vp + 32); u32x4 vw; vw.x = v0.x; vw.y = v0.y; vw.z = v1.x; vw.w = v1.y;
            o[nt] = __builtin_amdgcn_mfma_f32_16x16x32_bf16(__builtin_bit_cast(bf16x8, vw), pb, o[nt], 0, 0, 0); }
    }
    { const int t = ((n * 128 + i) << dsh) + r; const size_t row = (size_t)b * T_ + t; const float inv = 1.f / lsum;
#pragma unroll
      for (int nt = 0; nt < 4; ++nt) store4bf(OG + row * 768 + h * 64 + nt * 16 + 4 * fq, o[nt] * inv);
      if (fq == 0) LSE[row * 12 + h] = mx + __logf(lsum); }
    if (tid == 0) *qslot = tk_pub;
    __syncthreads();
}

__device__ __forceinline__ void sample_attn(LAS unsigned char* lds, int b, const float* ZS, const float* c128, const float* c512, const float* c2048, bf16_t* ATTS) {
    const int tid = threadIdx.x, wid = tid >> 6, lane = tid & 63;
    LAS float* qs = (LAS float*)lds;
    LAS float* sc = qs + 256;
    LAS float* og = sc + 4 * 132;
    LAS float* ls = og + 768;
    LAS float* lsm = ls + 12;
    const float* z = ZS + (size_t)b * NIN_;
    for (int g = 0; g < 3; ++g) {
        const int dsh = 2 * g, Lb = 128 << dsh; const float* cache = g == 0 ? c128 : (g == 1 ? c512 : c2048);
        const float* cb = cache + (size_t)b * Lb * 512;
        if (tid < 256) qs[tid] = z[g * 256 + tid];
        __syncthreads();
        { const int hs = tid >> 7, mi = tid & 127, m = mi + 1; const float slope = exp2f(-8.0f * (float)(g * 4 + hs + 1) / 12.0f);
          const float* kr = cb + (size_t)(Lb - (m << dsh)) * 512 + hs * 64; float d = 0.f; f32x4 kv[16];
#pragma unroll
          for (int i = 0; i < 16; ++i) kv[i] = *(const f32x4*)(kr + 4 * i);
#pragma unroll
          for (int i = 0; i < 16; ++i) { const f32x4 qv = *(const LAS f32x4*)(qs + hs * 64 + 4 * i); d += (kv[i][0] * qv[0] + kv[i][1] * qv[1]) + (kv[i][2] * qv[2] + kv[i][3] * qv[3]); }
          sc[hs * 132 + m] = d * 0.125f - slope * (float)(m << dsh);
          if (mi == 0) { const float* kn = z + 768 + (g * 4 + hs) * 64; float d0 = 0.f;
#pragma unroll
              for (int i = 0; i < 16; ++i) { const f32x4 kq = *(const f32x4*)(kn + 4 * i); const f32x4 qv = *(const LAS f32x4*)(qs + hs * 64 + 4 * i); d0 += (kq[0] * qv[0] + kq[1] * qv[1]) + (kq[2] * qv[2] + kq[3] * qv[3]); }
              sc[hs * 132] = d0 * 0.125f; } }
        __syncthreads();
        if (wid < 4) { const int hs = wid; float v0 = sc[hs * 132 + lane], v1 = sc[hs * 132 + 64 + lane], v2 = lane == 0 ? sc[hs * 132 + 128] : -3.0e38f;
            const float mxx = wave_max(fmaxf(fmaxf(v0, v1), v2)); const float p0 = __expf(v0 - mxx), p1 = __expf(v1 - mxx), p2 = lane == 0 ? __expf(v2 - mxx) : 0.f;
            const float l = wave_sum(p0 + p1 + p2); sc[hs * 132 + lane] = p0; sc[hs * 132 + 64 + lane] = p1; if (lane == 0) { sc[hs * 132 + 128] = p2; ls[g * 4 + hs] = mxx + __logf(l); lsm[hs] = l; } }
        __syncthreads();
        { const int hs = tid >> 7, d4 = (tid >> 3) & 15, mp = tid & 7; f32x4 vv[17];
#pragma unroll
          for (int i = 0; i < 17; ++i) { const int m = mp * 17 + i; const float* vp = (m == 0) ? (z + 1536 + (g * 4 + hs) * 64 + 4 * d4) : (cb + (size_t)(Lb - ((m < 129 ? m : 128) << dsh)) * 512 + 256 + hs * 64 + 4 * d4); vv[i] = *(const f32x4*)vp; }
          f32x4 acc = (f32x4){0.f, 0.f, 0.f, 0.f};
#pragma unroll
          for (int i = 0; i < 17; ++i) { const int m = mp * 17 + i; const float p = (m < 129) ? sc[hs * 132 + (m < 129 ? m : 0)] : 0.f; acc = acc + vv[i] * p; }
          acc[0] = red8(acc[0]); acc[1] = red8(acc[1]); acc[2] = red8(acc[2]); acc[3] = red8(acc[3]);
          if (mp == 0) { const float inv = 1.f / lsm[hs]; *(LAS f32x4*)(og + (g * 4 + hs) * 64 + 4 * d4) = acc * inv; } }
        __syncthreads();
    }
    if (tid < 256) { const int hs = tid >> 6, d = tid & 63; const float l0 = ls[hs], l1 = ls[4 + hs], l2 = ls[8 + hs]; const float mm = fmaxf(l0, fmaxf(l1, l2));
        const float w0 = __expf(l0 - mm), w1 = __expf(l1 - mm), w2 = __expf(l2 - mm); const float inv = 1.f / (w0 + w1 + w2);
        ATTS[(size_t)b * 256 + tid] = (bf16_t)f2bf((w0 * og[hs * 64 + d] + w1 * og[(4 + hs) * 64 + d] + w2 * og[(8 + hs) * 64 + d]) * inv); }
    __syncthreads();
}

struct RwW { const float *mu, *w0, *a0, *k_k, *k_a, *r_k, *gn_g, *gn_b, *wl, *al, *gl; };
__device__ __forceinline__ float decay_of(float w0c, float wl) { const float x = -(w0c + wl); const float sp = fmaxf(x, 0.f) + __logf(1.f + __expf(-fabsf(x))); return __expf(-__expf(-sp - 0.5f)); }

__device__ __forceinline__ void sample_rwkv(LAS unsigned char* lds, int item, const float* ZS, const float* state_wkv, const float* state_shift, const RwW w, float* out, bf16_t* RWS) {
    const int tid = threadIdx.x, wid = tid >> 6, lane = tid & 63; const int b = item >> 3, h = item & 7;
    LAS float* xr = (LAS float*)lds; LAS float* xk = xr + 64; LAS float* xv = xk + 64; LAS float* lw = xv + 64; LAS float* la = lw + 64; LAS float* lg = la + 64;
    LAS float* pw = lg + 128; LAS float* pa = pw + 64; LAS float* pg = pa + 64;
    LAS float* sR = pg + 64; LAS float* sW = sR + 64; LAS float* sK = sW + 64; LAS float* sV = sK + 64; LAS float* sA = sV + 64; LAS float* sB = sA + 64; LAS float* sG = sB + 64; LAS float* sY = sG + 64; LAS float* sC = sY + 64;
    const float* zb = ZS + (size_t)b * NIN_ + QKVW; const float* pv = state_shift + (size_t)b * ZBW;
    if (tid < 448) { int col; if (tid < 192) col = (tid >> 6) * 512 + h * 64 + (tid & 63); else col = 1536 + (tid - 192);
        const float cur = zb[col], prv = pv[col]; const float mx = cur + (prv - cur) * w.mu[col];
        if (tid < 64) xr[tid] = mx; else if (tid < 128) xk[tid - 64] = mx; else if (tid < 192) xv[tid - 128] = mx; else if (tid < 256) lw[tid - 192] = tanhf(mx); else if (tid < 320) la[tid - 256] = mx; else lg[tid - 320] = sigm(mx); }
    __syncthreads();
    if (tid < 192) { const int which = tid >> 6, nn = tid & 63, c = h * 64 + nn; float acc = 0.f;
        if (which == 0) {
#pragma unroll 16
            for (int j = 0; j < 64; ++j) acc += lw[j] * w.wl[j * 512 + c]; pw[nn] = acc; }
        else if (which == 1) {
#pragma unroll 16
            for (int j = 0; j < 64; ++j) acc += la[j] * w.al[j * 512 + c]; pa[nn] = acc; }
        else {
#pragma unroll 16
            for (int j = 0; j < 128; ++j) acc += lg[j] * w.gl[j * 512 + c]; pg[nn] = acc; } }
    __syncthreads();
    if (wid == 0) { const int c = h * 64 + lane; const float r = xr[lane], k = xk[lane], v = xv[lane];
        const float dec = decay_of(w.w0[c], pw[lane]); const float a = sigm(w.a0[c] + pa[lane]);
        const float kkr = k * w.k_k[c]; const float nrm = fmaxf(sqrtf(wave_sum(kkr * kkr)), 1e-12f); const float kk = kkr / nrm;
        const float kp = k * (1.f + (a - 1.f) * w.k_a[c]); const float cs = wave_sum(r * kp * w.r_k[c]);
        sR[lane] = r; sW[lane] = dec; sK[lane] = kp; sV[lane] = v; sA[lane] = -kk; sB[lane] = kk * a; sG[lane] = pg[lane]; if (lane == 0) sC[0] = cs; }
    __syncthreads();
    { const int row = tid >> 3, kq = tid & 7; const float* S0 = state_wkv + ((size_t)(b * 8 + h) * 64 + row) * 64 + 8 * kq; float s[8];
      const f32x4 s0 = *(const f32x4*)S0, s1 = *(const f32x4*)(S0 + 4); s[0] = s0[0]; s[1] = s0[1]; s[2] = s0[2]; s[3] = s0[3]; s[4] = s1[0]; s[5] = s1[1]; s[6] = s1[2]; s[7] = s1[3];
      float dot = 0.f;
#pragma unroll
      for (int i = 0; i < 8; ++i) dot += s[i] * sA[8 * kq + i];
      const float sa = red8(dot); const float vv = sV[row]; float yp = 0.f;
#pragma unroll
      for (int i = 0; i < 8; ++i) { s[i] = s[i] * sW[8 * kq + i] + sa * sB[8 * kq + i] + vv * sK[8 * kq + i]; yp += s[i] * sR[8 * kq + i]; }
      const float y = red8(yp); float* So = out + O_WKVS + ((size_t)(b * 8 + h) * 64 + row) * 64 + 8 * kq;
      *(f32x4*)So = (f32x4){s[0], s[1], s[2], s[3]}; *(f32x4*)(So + 4) = (f32x4){s[4], s[5], s[6], s[7]};
      if (kq == 0) sY[row] = y; }
    __syncthreads();
    if (wid == 0) { const int c = h * 64 + lane; const float y = sY[lane]; const float mu = wave_sum(y) * (1.f / 64.f); const float dv = y - mu; const float var = wave_sum(dv * dv) * (1.f / 64.f);
        const float yn = dv * rsqrtf(var + GN_EPS) * w.gn_g[c] + w.gn_b[c]; RWS[(size_t)b * 512 + c] = (bf16_t)f2bf((yn + sC[0] * sV[lane]) * sG[lane]); }
    __syncthreads();
}

constexpr int RC_P = 0, RC_P2 = 2048, RC_Q = 4096, RC_Q2 = 5120, RC_BK = 6144, RC_VT = 10240, RC_DC = 12288, RC_BYTES = 12544;
constexpr int PS = 68;
constexpr int PR_XR = 0, PR_XK = 8704, PR_XV = 17408, PR_PW = 26112, PR_PA = 34816, PR_PG = 43520, PR_LW = 52224, PR_LA = 56832, PR_LG = 61440, PR_GM = 70144, PR_TM = 80384, PR_PP = 82944, PR_QQ = 91648;
struct PrepLd { u32x2 c[7], p[7]; };
__device__ __forceinline__ f32x4 ub4(u32x2 w) { f32x4 r; r[0] = __builtin_bit_cast(float, w.x << 16); r[1] = __builtin_bit_cast(float, w.x & 0xffff0000u); r[2] = __builtin_bit_cast(float, w.y << 16); r[3] = __builtin_bit_cast(float, w.y & 0xffff0000u); return r; }
__device__ __forceinline__ void prep_load(PrepLd& ld, int item, const bf16_t* ZB) {
    const int tid = threadIdx.x, tt = tid >> 4, q = tid & 15; const int bh = item >> 6, c32 = item & 63, b = bh >> 3, h = bh & 7, t = c32 * 32 + tt, c0 = h * 64 + 4 * q;
    const bf16_t* cur = ZB + ((size_t)b * T_ + t) * ZBW; const bf16_t* prv = cur - ZBW; const bool hp = t > 0; const u32x2 z = (u32x2){0u, 0u};
    ld.c[0] = *(const u32x2*)(cur + c0); ld.c[1] = *(const u32x2*)(cur + 512 + c0); ld.c[2] = *(const u32x2*)(cur + 1024 + c0); ld.c[3] = *(const u32x2*)(cur + 1536 + 4 * q); ld.c[4] = *(const u32x2*)(cur + 1600 + 4 * q); ld.c[5] = *(const u32x2*)(cur + 1664 + 8 * q); ld.c[6] = *(const u32x2*)(cur + 1668 + 8 * q);
    ld.p[0] = hp ? *(const u32x2*)(prv + c0) : z; ld.p[1] = hp ? *(const u32x2*)(prv + 512 + c0) : z; ld.p[2] = hp ? *(const u32x2*)(prv + 1024 + c0) : z; ld.p[3] = hp ? *(const u32x2*)(prv + 1536 + 4 * q) : z; ld.p[4] = hp ? *(const u32x2*)(prv + 1600 + 4 * q) : z;
    ld.p[5] = hp ? *(const u32x2*)(prv + 1664 + 8 * q) : z; ld.p[6] = hp ? *(const u32x2*)(prv + 1668 + 8 * q) : z;
}
__device__ __forceinline__ void prep_item(LAS unsigned char* lds, int item, int next_item, PrepLd& ld, const bf16_t* ZB, const RwW w, const bf16x8 (&Bw)[2], const bf16x8 (&Ba)[2], const bf16x8 (&Bg)[4], bf16_t* G, bf16_t* BON, unsigned char* REC) {
    int tid_ = threadIdx.x; asm volatile("" : "+v"(tid_));
    const int tid = tid_, wid = __builtin_amdgcn_readfirstlane(tid >> 6), lane = tid & 63, fr = lane & 15, fq = lane >> 4;
    const int bh = item >> 6, c32 = item & 63, b = bh >> 3, h = bh & 7, t0 = c32 * 32;
    LAS float* XR = (LAS float*)(lds + PR_XR); LAS float* XK = (LAS float*)(lds + PR_XK); LAS float* XV = (LAS float*)(lds + PR_XV);
    LAS float* PW = (LAS float*)(lds + PR_PW); LAS float* PA = (LAS float*)(lds + PR_PA); LAS float* PG = (LAS float*)(lds + PR_PG);
    LAS unsigned char* LW = lds + PR_LW; LAS unsigned char* LA = lds + PR_LA; LAS unsigned char* LG = lds + PR_LG;
    LAS float* GM = (LAS float*)(lds + PR_GM); LAS float* TM = (LAS float*)(lds + PR_TM); LAS float* PP = (LAS float*)(lds + PR_PP); LAS float* QQ = (LAS float*)(lds + PR_QQ);
    const int ttile = wid >> 2, ntile = wid & 3;
    const int tt = tid >> 4, q = tid & 15, c0 = h * 64 + 4 * q;
    { const f32x4 mu_r = *(const f32x4*)(w.mu + c0), mu_k = *(const f32x4*)(w.mu + 512 + c0), mu_v = *(const f32x4*)(w.mu + 1024 + c0);
      const f32x4 mu_w = *(const f32x4*)(w.mu + 1536 + 4 * q), mu_a = *(const f32x4*)(w.mu + 1600 + 4 * q), mu_g0 = *(const f32x4*)(w.mu + 1664 + 8 * q), mu_g1 = *(const f32x4*)(w.mu + 1668 + 8 * q);
      f32x4 cr = ub4(ld.c[0]), ck = ub4(ld.c[1]), cv = ub4(ld.c[2]), cw = ub4(ld.c[3]), ca = ub4(ld.c[4]), cg0 = ub4(ld.c[5]), cg1 = ub4(ld.c[6]);
      const f32x4 pr = ub4(ld.p[0]), pk = ub4(ld.p[1]), pv = ub4(ld.p[2]), pw = ub4(ld.p[3]), pa = ub4(ld.p[4]), pg0 = ub4(ld.p[5]), pg1 = ub4(ld.p[6]);
      cr = cr + (pr - cr) * mu_r; ck = ck + (pk - ck) * mu_k; cv = cv + (pv - cv) * mu_v; cw = cw + (pw - cw) * mu_w; ca = ca + (pa - ca) * mu_a; cg0 = cg0 + (pg0 - cg0) * mu_g0; cg1 = cg1 + (pg1 - cg1) * mu_g1;
      *(LAS f32x4*)(XR + tt * PS + 4 * q) = cr; *(LAS f32x4*)(XK + tt * PS + 4 * q) = ck; *(LAS f32x4*)(XV + tt * PS + 4 * q) = cv;
      u32x2 o; o.x = pk2(tanh_fast(cw[0]), tanh_fast(cw[1])); o.y = pk2(tanh_fast(cw[2]), tanh_fast(cw[3])); *(LAS u32x2*)(LW + tt * 144 + 8 * q) = o;
      o.x = pk2(ca[0], ca[1]); o.y = pk2(ca[2], ca[3]); *(LAS u32x2*)(LA + tt * 144 + 8 * q) = o;
      u32x4 o4; o4.x = pk2(sigm(cg0[0]), sigm(cg0[1])); o4.y = pk2(sigm(cg0[2]), sigm(cg0[3])); o4.z = pk2(sigm(cg1[0]), sigm(cg1[1])); o4.w = pk2(sigm(cg1[2]), sigm(cg1[3])); *(LAS u32x4*)(LG + tt * 272 + 16 * q) = o4; }
    __syncthreads();
    if (next_item >= 0) prep_load(ld, next_item, ZB);
    { f32x4 wl = (f32x4){0.f, 0.f, 0.f, 0.f}, al = wl, gl = wl;
#pragma unroll
      for (int ks = 0; ks < 2; ++ks) { const bf16x8 aw = *(const LAS bf16x8*)(LW + (ttile * 16 + fr) * 144 + 64 * ks + 16 * fq), aa = *(const LAS bf16x8*)(LA + (ttile * 16 + fr) * 144 + 64 * ks + 16 * fq);
          wl = __builtin_amdgcn_mfma_f32_16x16x32_bf16(aw, Bw[ks], wl, 0, 0, 0); al = __builtin_amdgcn_mfma_f32_16x16x32_bf16(aa, Ba[ks], al, 0, 0, 0); }
#pragma unroll
      for (int ks = 0; ks < 4; ++ks) { const bf16x8 ag = *(const LAS bf16x8*)(LG + (ttile * 16 + fr) * 272 + 64 * ks + 16 * fq);
          gl = __builtin_amdgcn_mfma_f32_16x16x32_bf16(ag, Bg[ks], gl, 0, 0, 0); }
#pragma unroll
      for (int e = 0; e < 4; ++e) { const int tr = ttile * 16 + 4 * fq + e, nc = ntile * 16 + fr; PW[tr * PS + nc] = wl[e]; PA[tr * PS + nc] = al[e]; PG[tr * PS + nc] = gl[e]; } }
    __syncthreads();
    { const f32x4 c_w0 = *(const f32x4*)(w.w0 + c0), c_a0 = *(const f32x4*)(w.a0 + c0), c_kk = *(const f32x4*)(w.k_k + c0), c_ka = *(const f32x4*)(w.k_a + c0), c_rk = *(const f32x4*)(w.r_k + c0);
      const f32x4 wl = *(LAS f32x4*)(PW + tt * PS + 4 * q), al = *(LAS f32x4*)(PA + tt * PS + 4 * q), gl = *(LAS f32x4*)(PG + tt * PS + 4 * q);
      const f32x4 r4 = *(LAS f32x4*)(XR + tt * PS + 4 * q), k4 = *(LAS f32x4*)(XK + tt * PS + 4 * q), v4 = *(LAS f32x4*)(XV + tt * PS + 4 * q);
      f32x4 dec, a4, kkr, kp; float ssq = 0.f, cs = 0.f;
#pragma unroll
      for (int e = 0; e < 4; ++e) { dec[e] = decay_of(c_w0[e], wl[e]); a4[e] = sigm(c_a0[e] + al[e]); kkr[e] = k4[e] * c_kk[e]; ssq += kkr[e] * kkr[e]; kp[e] = k4[e] * (1.f + (a4[e] - 1.f) * c_ka[e]); cs += r4[e] * kp[e] * c_rk[e]; }
      ssq = red16(ssq); cs = red16(cs); const float inv = 1.f / fmaxf(sqrtf(ssq), 1e-12f);
      const f32x4 kk = kkr * inv;
      *(LAS f32x4*)(PW + tt * PS + 4 * q) = dec; *(LAS f32x4*)(PA + tt * PS + 4 * q) = -kk; *(LAS f32x4*)(PG + tt * PS + 4 * q) = kk * a4; *(LAS f32x4*)(XK + tt * PS + 4 * q) = kp;
      const size_t off = ((size_t)b * T_ + t0 + tt) * 512 + c0; store4bf(G + off, gl); store4bf(BON + off, v4 * cs); }
    __syncthreads();
    unsigned char* rec0 = REC + (size_t)(bh * 128 + c32 * 2) * RC_BYTES;
    { const int s1 = wid >> 2, arr = wid & 3, k = lane; float Dc = 1.f; LAS float* dst = arr == 0 ? PA : (arr == 1 ? PG : (arr == 2 ? XK : XR));
      float wv[16], xv[16];
#pragma unroll
      for (int t = 0; t < 16; ++t) { const int o = (s1 * 16 + t) * PS + k; wv[t] = PW[o]; xv[t] = dst[o]; }
#pragma unroll
      for (int t = 0; t < 16; ++t) { const int o = (s1 * 16 + t) * PS + k; const float Dp = Dc; Dc *= wv[t];
          float f; if (arr == 0) f = Dp; else if (arr == 3) f = Dc; else f = __builtin_amdgcn_rcpf(Dc);
          dst[o] = xv[t] * f; }
      if (arr == 0) *(float*)(rec0 + (size_t)s1 * RC_BYTES + RC_DC + 4 * k) = Dc; }
    __syncthreads();
    const int s = wid >> 2;
    unsigned char* rec = rec0 + (size_t)s * RC_BYTES;
    { const int which = wid & 3; const LAS float* X = (which < 2) ? PA : XR; const LAS float* Yv = (which & 1) ? XK : PG;
      f32x4 acc = (f32x4){0.f, 0.f, 0.f, 0.f};
#pragma unroll
      for (int m = 0; m < 4; ++m) { const f32x4 xa = *(const LAS f32x4*)(X + (s * 16 + fr) * PS + 16 * m + 4 * fq), yb = *(const LAS f32x4*)(Yv + (s * 16 + fr) * PS + 16 * m + 4 * fq);
#pragma unroll
          for (int j = 0; j < 4; ++j) acc = __builtin_amdgcn_mfma_f32_16x16x4f32(xa[j], yb[j], acc, 0, 0, 0); }
#pragma unroll
      for (int e = 0; e < 4; ++e) { const int t = 4 * fq + e; const bool keep = (which < 2) ? (fr < t) : (fr <= t); GM[((s * 4 + which) * 16 + t) * 20 + fr] = keep ? acc[e] : 0.f; } }
    __syncthreads();
    if (tid >= 256) { const int u = tid - 256; const int ss = u >> 7, k = (u >> 1) & 63, half = u & 1; const LAS float* src = half ? XK : PG; unsigned char* rr = rec0 + (size_t)ss * RC_BYTES + RC_BK + k * 64;
#pragma unroll
        for (int c = 0; c < 2; ++c) { u32x4 o; const LAS float* p = src + (ss * 16 + 8 * c) * PS + k;
            o.x = pk2(p[0], p[PS]); o.y = pk2(p[2 * PS], p[3 * PS]); o.z = pk2(p[4 * PS], p[5 * PS]); o.w = pk2(p[6 * PS], p[7 * PS]);
            *(u32x4*)(rr + (((half * 2 + c) ^ ((k >> 2) & 3)) << 4)) = o; } }
    else if (tid >= 128) { const int ss = (tid - 128) >> 6, v = tid & 63; unsigned char* rr = rec0 + (size_t)ss * RC_BYTES + RC_VT + v * 32;
#pragma unroll
        for (int c = 0; c < 2; ++c) { u32x4 o; const LAS float* p = XV + (ss * 16 + 8 * c) * PS + v;
            o.x = pk2(p[0], p[PS]); o.y = pk2(p[2 * PS], p[3 * PS]); o.z = pk2(p[4 * PS], p[5 * PS]); o.w = pk2(p[6 * PS], p[7 * PS]);
            *(u32x4*)(rr + c * 16) = o; } }
    if (wid == 0 && lane < 32) { const int ss = lane >> 4, j = lane & 15; float x[16];
#pragma unroll
        for (int t = 0; t < 16; ++t) { float sum = (t == j) ? 1.f : 0.f; const LAS float* Lr = GM + ((ss * 4 + 0) * 16 + t) * 20;
#pragma unroll
            for (int i = 0; i < t; ++i) sum += Lr[i] * x[i];
            x[t] = sum; TM[(ss * 16 + t) * 20 + j] = sum;
            if ((t & 3) == 3) asm volatile("" ::: "memory"); } }
    __syncthreads();
    { const f32x4 ta = *(const LAS f32x4*)(TM + (s * 16 + fr) * 20 + 4 * fq); f32x4 acc = (f32x4){0.f, 0.f, 0.f, 0.f};
#pragma unroll
      for (int j = 0; j < 4; ++j) acc = __builtin_amdgcn_mfma_f32_16x16x4f32(ta[j], PA[(s * 16 + 4 * fq + j) * PS + ntile * 16 + fr], acc, 0, 0, 0);
#pragma unroll
      for (int e = 0; e < 4; ++e) { const int t = 4 * fq + e, k = ntile * 16 + fr; PP[(s * 16 + t) * PS + k] = acc[e];
          *(bf16_t*)(rec + RC_P + t * 128 + ((((k >> 3) ^ ((t >> 1) & 7))) << 4) + (k & 7) * 2) = (bf16_t)f2bf(acc[e]); }
      if (ntile == 0) { f32x4 aq = (f32x4){0.f, 0.f, 0.f, 0.f};
#pragma unroll
          for (int j = 0; j < 4; ++j) aq = __builtin_amdgcn_mfma_f32_16x16x4f32(ta[j], GM[((s * 4 + 1) * 16 + 4 * fq + j) * 20 + fr], aq, 0, 0, 0);
#pragma unroll
          for (int e = 0; e < 4; ++e) { const int t = 4 * fq + e; QQ[(s * 16 + t) * 20 + fr] = aq[e];
              *(bf16_t*)(rec + RC_Q + t * 64 + ((((fr >> 3)) ^ ((t >> 2) & 3)) << 4) + (fr & 7) * 2) = (bf16_t)f2bf(aq[e]);
              *(bf16_t*)(rec + RC_Q + t * 64 + (((2 + (fr >> 3)) ^ ((t >> 2) & 3)) << 4) + (fr & 7) * 2) = (bf16_t)0; } } }
    __syncthreads();
    { const f32x4 ma = *(const LAS f32x4*)(GM + ((s * 4 + 2) * 16 + fr) * 20 + 4 * fq); f32x4 acc;
#pragma unroll
      for (int e = 0; e < 4; ++e) acc[e] = XR[(s * 16 + 4 * fq + e) * PS + ntile * 16 + fr];
#pragma unroll
      for (int j = 0; j < 4; ++j) acc = __builtin_amdgcn_mfma_f32_16x16x4f32(ma[j], PP[(s * 16 + 4 * fq + j) * PS + ntile * 16 + fr], acc, 0, 0, 0);
#pragma unroll
      for (int e = 0; e < 4; ++e) { const int t = 4 * fq + e, k = ntile * 16 + fr; *(bf16_t*)(rec + RC_P2 + t * 128 + ((((k >> 3) ^ ((t >> 1) & 7))) << 4) + (k & 7) * 2) = (bf16_t)f2bf(acc[e]); }
      if (ntile == 0) { f32x4 aq;
#pragma unroll
          for (int e = 0; e < 4; ++e) aq[e] = GM[((s * 4 + 3) * 16 + 4 * fq + e) * 20 + fr];
#pragma unroll
          for (int j = 0; j < 4; ++j) aq = __builtin_amdgcn_mfma_f32_16x16x4f32(ma[j], QQ[(s * 16 + 4 * fq + j) * 20 + fr], aq, 0, 0, 0);
#pragma unroll
          for (int e = 0; e < 4; ++e) { const int t = 4 * fq + e;
              *(bf16_t*)(rec + RC_Q2 + t * 64 + ((((fr >> 3)) ^ ((t >> 2) & 3)) << 4) + (fr & 7) * 2) = (bf16_t)f2bf(aq[e]);
              *(bf16_t*)(rec + RC_Q2 + t * 64 + (((2 + (fr >> 3)) ^ ((t >> 2) & 3)) << 4) + (fr & 7) * 2) = (bf16_t)0; } } }
    __syncthreads();
}

struct Ops { bf16x8 P0, P1, P20, P21, Q, Q2, VT, BK0, BK1, BK2, BK3; f32x4 DC0, DC1, DC2, DC3; };
__device__ __forceinline__ void load_ops(Ops& o, const unsigned char* rec, int fr, int fq, int v0) {
    const int sw8 = (fr >> 1) & 7, sw4 = (fr >> 2) & 3;
    o.P0 = *(const bf16x8*)(rec + RC_P + fr * 128 + ((fq ^ sw8) << 4)); o.P1 = *(const bf16x8*)(rec + RC_P + fr * 128 + (((4 + fq) ^ sw8) << 4));
    o.P20 = *(const bf16x8*)(rec + RC_P2 + fr * 128 + ((fq ^ sw8) << 4)); o.P21 = *(const bf16x8*)(rec + RC_P2 + fr * 128 + (((4 + fq) ^ sw8) << 4));
    o.Q = *(const bf16x8*)(rec + RC_Q + fr * 64 + ((fq ^ sw4) << 4)); o.Q2 = *(const bf16x8*)(rec + RC_Q2 + fr * 64 + ((fq ^ sw4) << 4));
    o.VT = *(const bf16x8*)(rec + RC_VT + (v0 + fr) * 32 + (fq & 1) * 16);
    o.BK0 = *(const bf16x8*)(rec + RC_BK + (fr) * 64 + ((fq ^ sw4) << 4)); o.BK1 = *(const bf16x8*)(rec + RC_BK + (16 + fr) * 64 + ((fq ^ sw4) << 4));
    o.BK2 = *(const bf16x8*)(rec + RC_BK + (32 + fr) * 64 + ((fq ^ sw4) << 4)); o.BK3 = *(const bf16x8*)(rec + RC_BK + (48 + fr) * 64 + ((fq ^ sw4) << 4));
    o.DC0 = *(const f32x4*)(rec + RC_DC + (4 * fq) * 4); o.DC1 = *(const f32x4*)(rec + RC_DC + (16 + 4 * fq) * 4); o.DC2 = *(const f32x4*)(rec + RC_DC + (32 + 4 * fq) * 4); o.DC3 = *(const f32x4*)(rec + RC_DC + (48 + 4 * fq) * 4);
}
__device__ __forceinline__ void hilo_store(LAS unsigned char* Shi, LAS unsigned char* Slo, int fr, int fq, int mt, f32x4 sv) {
    u32x2 hi, lo; hi.x = pk2(sv[0], sv[1]); hi.y = pk2(sv[2], sv[3]);
    const float r0 = sv[0] - __builtin_bit_cast(float, hi.x << 16), r1 = sv[1] - __builtin_bit_cast(float, hi.x & 0xffff0000u), r2 = sv[2] - __builtin_bit_cast(float, hi.y << 16), r3 = sv[3] - __builtin_bit_cast(float, hi.y & 0xffff0000u);
    lo.x = pk2(r0, r1); lo.y = pk2(r2, r3);
    *(LAS u32x2*)(Shi + fr * 144 + (16 * mt + 4 * fq) * 2) = hi; *(LAS u32x2*)(Slo + fr * 144 + (16 * mt + 4 * fq) * 2) = lo;
}
__device__ __forceinline__ void seq_step(const Ops& o, f32x4 (&st)[4], LAS unsigned char* Shi, LAS unsigned char* Slo, LAS unsigned char* Ul, int fr, int fq, float* yrow) {
    hilo_store(Shi, Slo, fr, fq, 0, st[0]); hilo_store(Shi, Slo, fr, fq, 1, st[1]); hilo_store(Shi, Slo, fr, fq, 2, st[2]); hilo_store(Shi, Slo, fr, fq, 3, st[3]);
    asm volatile("s_waitcnt lgkmcnt(0)" ::: "memory");
    const bf16x8 sh0 = *(const LAS bf16x8*)(Shi + fr * 144 + 16 * fq), sh1 = *(const LAS bf16x8*)(Shi + fr * 144 + 64 + 16 * fq), sl0 = *(const LAS bf16x8*)(Slo + fr * 144 + 16 * fq), sl1 = *(const LAS bf16x8*)(Slo + fr * 144 + 64 + 16 * fq);
    const bf16x8 zero8 = (bf16x8){0, 0, 0, 0, 0, 0, 0, 0}; const bf16x8 vq = (fq < 2) ? o.VT : zero8;
    f32x4 ut = (f32x4){0.f, 0.f, 0.f, 0.f}, yt = ut;
    ut = __builtin_amdgcn_mfma_f32_16x16x32_bf16(o.P0, sh0, ut, 0, 0, 0); yt = __builtin_amdgcn_mfma_f32_16x16x32_bf16(o.P20, sh0, yt, 0, 0, 0);
    ut = __builtin_amdgcn_mfma_f32_16x16x32_bf16(o.P1, sh1, ut, 0, 0, 0); yt = __builtin_amdgcn_mfma_f32_16x16x32_bf16(o.P21, sh1, yt, 0, 0, 0);
    ut = __builtin_amdgcn_mfma_f32_16x16x32_bf16(o.P0, sl0, ut, 0, 0, 0); yt = __builtin_amdgcn_mfma_f32_16x16x32_bf16(o.P20, sl0, yt, 0, 0, 0);
    ut = __builtin_amdgcn_mfma_f32_16x16x32_bf16(o.P1, sl1, ut, 0, 0, 0); yt = __builtin_amdgcn_mfma_f32_16x16x32_bf16(o.P21, sl1, yt, 0, 0, 0);
    ut = __builtin_amdgcn_mfma_f32_16x16x32_bf16(o.Q, vq, ut, 0, 0, 0); yt = __builtin_amdgcn_mfma_f32_16x16x32_bf16(o.Q2, vq, yt, 0, 0, 0);
    { u32x2 uu; uu.x = pk2(ut[0], ut[1]); uu.y = pk2(ut[2], ut[3]); *(LAS u32x2*)(Ul + fr * 48 + 8 * fq) = uu; }
#pragma unroll
    for (int e = 0; e < 4; ++e) yrow[(size_t)(4 * fq + e) * 512] = yt[e];
    asm volatile("s_waitcnt lgkmcnt(0)" ::: "memory");
    const bf16x8 uf = *(const LAS bf16x8*)(Ul + fr * 48 + 16 * (fq & 1)); const bf16x8 uv = (fq < 2) ? uf : o.VT;
    st[0] = __builtin_amdgcn_mfma_f32_16x16x32_bf16(o.BK0, uv, st[0], 0, 0, 0); st[1] = __builtin_amdgcn_mfma_f32_16x16x32_bf16(o.BK1, uv, st[1], 0, 0, 0);
    st[2] = __builtin_amdgcn_mfma_f32_16x16x32_bf16(o.BK2, uv, st[2], 0, 0, 0); st[3] = __builtin_amdgcn_mfma_f32_16x16x32_bf16(o.BK3, uv, st[3], 0, 0, 0);
    st[0] = st[0] * o.DC0; st[1] = st[1] * o.DC1; st[2] = st[2] * o.DC2; st[3] = st[3] * o.DC3;
}
__device__ __forceinline__ void seq_warm(int bh, int wv, const unsigned char* REC, volatile LAS int* prog) {
    const int lane = threadIdx.x & 63; const unsigned char* rec = REC + (size_t)bh * 128 * RC_BYTES;
    for (int c = wv; c < 128; c += 4) {
        for (int spin = 0; spin < 4096 && *prog + 10 < c; ++spin) __builtin_amdgcn_s_sleep(8);
        const unsigned char* p = rec + (size_t)c * RC_BYTES + lane * 64; unsigned acc = 0u;
#pragma unroll
        for (int i = 0; i < 3; ++i) { const unsigned v = *(const volatile unsigned*)(p + i * 4096); acc += v; }
        if (lane < 4) { const unsigned v = *(const volatile unsigned*)(p + 3 * 4096); acc += v; }
        asm volatile("" :: "v"(acc));
    }
}
__device__ __forceinline__ void seq_unit(LAS unsigned char* lds, int bh, int wv, const unsigned char* REC, float* Y, float* out, volatile LAS int* prog) {
    const int lane = threadIdx.x & 63, fr = lane & 15, fq = lane >> 4, v0 = wv * 16, b = bh >> 3, h = bh & 7;
    LAS unsigned char* Shi = lds + wv * 5376; LAS unsigned char* Slo = Shi + 2304; LAS unsigned char* Ul = Slo + 2304;
    f32x4 st[4];
#pragma unroll
    for (int i = 0; i < 4; ++i) st[i] = (f32x4){0.f, 0.f, 0.f, 0.f};
    const unsigned char* rec = REC + (size_t)bh * 128 * RC_BYTES;
    float* ybase = Y + (size_t)b * T_ * 512 + h * 64 + v0 + fr;
    Ops A, B; load_ops(A, rec, fr, fq, v0);
    for (int c = 0; c < 128; c += 2) {
        load_ops(B, rec + (size_t)(c + 1) * RC_BYTES, fr, fq, v0);
        seq_step(A, st, Shi, Slo, Ul, fr, fq, ybase + (size_t)(c * 16) * 512);
        if (c + 2 < 128) load_ops(A, rec + (size_t)(c + 2) * RC_BYTES, fr, fq, v0);
        seq_step(B, st, Shi, Slo, Ul, fr, fq, ybase + (size_t)((c + 1) * 16) * 512);
        if (wv == 0 && lane == 0) *prog = c + 2;
    }
    if (wv == 0 && lane == 0) *prog = 1000;
#pragma unroll
    for (int mt = 0; mt < 4; ++mt) *(f32x4*)(out + O_WKVP + ((size_t)(b * 8 + h) * 64 + v0 + fr) * 64 + 16 * mt + 4 * fq) = st[mt];
}

struct Args { const float* in[28]; float* out; unsigned char* ws; int ph_lo, ph_hi; };
constexpr int N_PH = 10;

__global__ void __launch_bounds__(512, 2) fwd_kernel(Args args) {
    extern __shared__ __attribute__((aligned(16))) unsigned char lds_raw[];
    LAS unsigned char* lds = (LAS unsigned char*)lds_raw;
    const int tid = threadIdx.x, lane = tid & 63, wid = __builtin_amdgcn_readfirstlane(tid >> 6);
    const int G = gridDim.x, bx = blockIdx.x;
    const int gw = bx * 8 + wid, NGW = G * 8;
    unsigned char* ws = args.ws; float* out = args.out;
    const float* x = args.in[0]; const float* xs = args.in[1];
    unsigned* ctl = (unsigned*)(ws + WS_CTL);
    float* SS1 = (float*)(ws + CTL_SS1); float* SS1S = (float*)(ws + CTL_SS1S); float* SS2 = (float*)(ws + CTL_SS2); float* SS2S = (float*)(ws + CTL_SS2S);
    bf16_t* WinT = (bf16_t*)(ws + WS_WIN); bf16_t* WaT = (bf16_t*)(ws + WS_WA); bf16_t* WbT = (bf16_t*)(ws + WS_WB); bf16_t* WoT = (bf16_t*)(ws + WS_WO); bf16_t* WupT = (bf16_t*)(ws + WS_WUP); bf16_t* WdnT = (bf16_t*)(ws + WS_WDN);
    bf16_t* WlT = (bf16_t*)(ws + WS_WL); bf16_t* AlT = (bf16_t*)(ws + WS_AL); bf16_t* GlT = (bf16_t*)(ws + WS_GL);
    unsigned char* sm = ws + WS_SMALL;
    bf16_t* H1S = (bf16_t*)(sm + SM_H1S); float* ZS = (float*)(sm + SM_ZS); bf16_t* ATTS = (bf16_t*)(sm + SM_ATTS); bf16_t* RWS = (bf16_t*)(sm + SM_RWS); bf16_t* MGS = (bf16_t*)(sm + SM_MGS); bf16_t* X1GS = (bf16_t*)(sm + SM_X1GS); bf16_t* US = (bf16_t*)(sm + SM_US);
    bf16_t* H1 = (bf16_t*)(ws + WS_H1); bf16_t* QKV = (bf16_t*)(ws + WS_QKV); bf16_t* ZB = (bf16_t*)(ws + WS_ZB); bf16_t* U = (bf16_t*)(ws + WS_U); bf16_t* GATE = (bf16_t*)(ws + WS_GATE);
    bf16_t* OG = (bf16_t*)(ws + WS_OG); float* LSE = (float*)(ws + WS_LSE); bf16_t* ATT = (bf16_t*)(ws + WS_ATT); bf16_t* RW = (bf16_t*)(ws + WS_RW); bf16_t* MG = (bf16_t*)(ws + WS_MG);
    float* Yb = (float*)(ws + WS_Y); bf16_t* Gb = (bf16_t*)(ws + WS_G); bf16_t* BON = (bf16_t*)(ws + WS_BON); float* TMP = (float*)(ws + WS_TMP);
    SP sp; sp.ZS = ZS; sp.b_gate = args.in[9]; sp.out = out; sp.xs = xs; sp.g2 = args.in[24]; sp.MGS = MGS; sp.X1GS = X1GS; sp.US = US; sp.SS1S = SS1S; sp.SS2S = SS2S;
    const int lo = args.ph_lo, hi = args.ph_hi;
    if (tid < 32) ((volatile LAS unsigned*)(lds + MISC_OFF))[tid] = 0u;
    __syncthreads();
    if (lo < 0) cg::this_grid().sync();
    XcdBarrier xbar = xcd_barrier_post((unsigned*)(ws + CTL_BAR), (volatile LAS unsigned*)(lds + MISC_OFF) + 8);
#ifndef MK_ONLY
#define MK_ONLY -1
#endif
#define IN(k) ((MK_ONLY < 0 || MK_ONLY == (k)) && lo <= (k) && (k) < hi)
#define SEAM(k) do { if (IN(k) && IN((k) + 1)) { xcd_barrier(xbar); } } while (0)

    if (IN(0)) {
        LAS float* scr = (LAS float*)(lds + wid * 16384);
        constexpr int I_IN = 16 * 192, I_A = 4 * 32, I_B = 8 * 32, I_O = 16 * 32, I_UP = 16 * 128, I_DN = 64 * 32, I_WL = 16, I_AL = 16, I_GL = 32;
        constexpr int NITEMS = I_IN + I_A + I_B + I_O + I_UP + I_DN + I_WL + I_AL + I_GL;
        for (int it = gw; it < NITEMS; it += NGW) {
            int r = it;
            if (r < I_IN) { p0_transpose_item(args.in[8], 1024, 6144, WinT, scr, r, lane); continue; } r -= I_IN;
            if (r < I_A) { p0_transpose_item(args.in[21], 256, 1024, WaT, scr, r, lane); continue; } r -= I_A;
            if (r < I_B) { p0_transpose_item(args.in[22], 512, 1024, WbT, scr, r, lane); continue; } r -= I_B;
            if (r < I_O) { p0_transpose_item(args.in[23], 1024, 1024, WoT, scr, r, lane); continue; } r -= I_O;
            if (r < I_UP) { p0_transpose_item(args.in[25], 1024, 4096, WupT, scr, r, lane); continue; } r -= I_UP;
            if (r < I_DN) { p0_transpose_item(args.in[26], 4096, 1024, WdnT, scr, r, lane); continue; } r -= I_DN;
            if (r < I_WL) { p0_transpose_item(args.in[12], 64, 512, WlT, scr, r, lane); continue; } r -= I_WL;
            if (r < I_AL) { p0_transpose_item(args.in[14], 64, 512, AlT, scr, r, lane); continue; } r -= I_AL;
            p0_transpose_item(args.in[15], 128, 512, GlT, scr, r, lane);
        }
        for (int m0 = gw * 2; m0 < M_ + MS_; m0 += NGW * 2) {
            const float* xr0 = (m0 < M_) ? (x + (size_t)m0 * D_) : (xs + (size_t)(m0 - M_) * D_); const float* xr1 = (m0 + 1 < M_) ? (x + (size_t)(m0 + 1) * D_) : (xs + (size_t)(m0 + 1 - M_) * D_);
            bf16_t* o0 = (m0 < M_) ? (H1 + (size_t)m0 * D_) : (H1S + (size_t)(m0 - M_) * D_); bf16_t* o1 = (m0 + 1 < M_) ? (H1 + (size_t)(m0 + 1) * D_) : (H1S + (size_t)(m0 + 1 - M_) * D_);
            rms_row2_to_bf16(xr0, xr1, args.in[7], o0, o1, lane); }
        __syncthreads();
    }
    SEAM(0);
    if (IN(1)) {
        pg8::Gemm g{H1, WinT, M_, NIN_, D_}; pg8::StaticOrder S; S.init(M_, NIN_, G, bx);
        EpiZ E{QKV, ZB, GATE, args.in[9], out};
        pg8::gemm_phase<EpiZ, pg8::StaticOrder, true, true>(lds, g, S, E);
        sample_gemm<0>(lds, H1S, D_, WinT, nullptr, 0, nullptr, NIN_, sp);
    }
    SEAM(1);
    RwW w; w.mu = args.in[10]; w.w0 = args.in[11]; w.wl = args.in[12]; w.a0 = args.in[13]; w.al = args.in[14]; w.gl = args.in[15]; w.k_k = args.in[16]; w.k_a = args.in[17]; w.r_k = args.in[18]; w.gn_g = args.in[19]; w.gn_b = args.in[20];
    unsigned char* REC = ws + WS_REC;
    if (IN(2)) {
        for (int rep = 0; rep < PROBE_PREP; ++rep)
        if ((G & 7) == 0) {
            const int h = bx & 7, j0 = bx >> 3; const int fr_ = lane & 15, fq_ = lane >> 4, ncol = h * 64 + (wid & 3) * 16 + fr_;
            bf16x8 Bw[2], Ba[2], Bg[4];
#pragma unroll
            for (int ks = 0; ks < 2; ++ks) { Bw[ks] = *(const bf16x8*)(WlT + (size_t)ncol * 64 + 32 * ks + 8 * fq_); Ba[ks] = *(const bf16x8*)(AlT + (size_t)ncol * 64 + 32 * ks + 8 * fq_); }
#pragma unroll
            for (int ks = 0; ks < 4; ++ks) Bg[ks] = *(const bf16x8*)(GlT + (size_t)ncol * 128 + 32 * ks + 8 * fq_);
            const int jstep = G >> 3;
            PrepLd ld; if (j0 < 512) prep_load(ld, (((j0 >> 6) * 8 + h) << 6) | (j0 & 63), ZB);
            for (int j = j0; j < 512; j += jstep) { const int jn = j + jstep; const int it = (((j >> 6) * 8 + h) << 6) | (j & 63); const int nx = (jn < 512) ? ((((jn >> 6) * 8 + h) << 6) | (jn & 63)) : -1;
                prep_item(lds, it, nx, ld, ZB, w, Bw, Ba, Bg, Gb, BON, REC); }
        }
    }
    SEAM(2);
    if (IN(3)) {
        for (int rep = 0; rep < PROBE_SEQ; ++rep)
        { volatile LAS int* prog = (volatile LAS int*)(lds + MISC_OFF) + 4;
          if (tid == 0) *prog = 0;
          __syncthreads();
          if (bx < 64 && wid < 4) seq_unit(lds, bx, wid, REC, Yb, out, prog); }
        __syncthreads();
        volatile LAS int* qslot = (volatile LAS int*)(lds + MISC_OFF);
        for (;;) {
            if (tid == 0) *qslot = (int)atomicAdd(ctl, 1u);
            __syncthreads(); const int item = *qslot; __syncthreads();
            if (item >= 288 * PROBE_ATTN) break;
            if ((item % 288) < 32) sample_attn(lds, item % 288, ZS, args.in[2], args.in[3], args.in[4], ATTS);
            else sample_rwkv(lds, (item % 288) - 32, ZS, args.in[5], args.in[6], w, out, RWS);
        }
        {
            constexpr int NA = 1536 * PROBE_ATTN;
            if (tid == 0) { qslot[0] = (int)atomicAdd(ctl + 1, 1u); qslot[1] = (int)atomicAdd(ctl + 1, 1u); }
            __syncthreads(); int cur = qslot[0], nxt = qslot[1]; __syncthreads();
            AttnLd L;
            if (cur < NA) attn_load(L, cur % 1536, QKV);
            while (cur < NA) {
                int tk = 0; if (tid == 0) tk = (int)atomicAdd(ctl + 1, 1u);
                attn_unit(lds, cur % 1536, (nxt < NA) ? (nxt % 1536) : -1, L, QKV, OG, LSE, qslot, tk);
                const int nn = *qslot;
                cur = nxt; nxt = nn;
            }
        }
    }
    SEAM(3);
    if (IN(4)) {
        const float* gn_g = args.in[19]; const float* gn_b = args.in[20];
        for (int m0 = gw * 2; m0 < M_; m0 += NGW * 2) {
            f32x4 o0[2], o1[2], o2[2], y0[2], y1[2], bo0[2], bo1[2], gg0[2], gg1[2]; float l0[2], l1[2], l2[2];
            const int hs = lane >> 4;
#pragma unroll
            for (int u = 0; u < 2; ++u) { const size_t m = (size_t)(m0 + u); l0[u] = LSE[m * 12 + hs]; l1[u] = LSE[m * 12 + 4 + hs]; l2[u] = LSE[m * 12 + 8 + hs];
                o0[u] = load4bf(OG + m * 768 + 4 * lane); o1[u] = load4bf(OG + m * 768 + 256 + 4 * lane); o2[u] = load4bf(OG + m * 768 + 512 + 4 * lane);
                const size_t off = m * 512 + 8 * lane; y0[u] = *(const f32x4*)(Yb + off); y1[u] = *(const f32x4*)(Yb + off + 4); bo0[u] = load4bf(BON + off); bo1[u] = load4bf(BON + off + 4); gg0[u] = load4bf(Gb + off); gg1[u] = load4bf(Gb + off + 4); }
            const f32x4 g0 = *(const f32x4*)(gn_g + 8 * lane), g1 = *(const f32x4*)(gn_g + 8 * lane + 4), b0 = *(const f32x4*)(gn_b + 8 * lane), b1 = *(const f32x4*)(gn_b + 8 * lane + 4);
#pragma unroll
            for (int u = 0; u < 2; ++u) { const size_t m = (size_t)(m0 + u);
                const float mm = fmaxf(l0[u], fmaxf(l1[u], l2[u])); const float w0 = __expf(l0[u] - mm), w1 = __expf(l1[u] - mm), w2 = __expf(l2[u] - mm); const float inv = 1.f / (w0 + w1 + w2);
                store4bf(ATT + m * 256 + 4 * lane, (o0[u] * w0 + o1[u] * w1 + o2[u] * w2) * inv);
                const float mu = red8((y0[u][0] + y0[u][1]) + (y0[u][2] + y0[u][3]) + (y1[u][0] + y1[u][1]) + (y1[u][2] + y1[u][3])) * (1.f / 64.f); const f32x4 d0 = y0[u] - mu, d1 = y1[u] - mu;
                const float var = red8((d0[0] * d0[0] + d0[1] * d0[1]) + (d0[2] * d0[2] + d0[3] * d0[3]) + (d1[0] * d1[0] + d1[1] * d1[1]) + (d1[2] * d1[2] + d1[3] * d1[3])) * (1.f / 64.f); const float rstd = rsqrtf(var + GN_EPS);
                store8bf(RW + m * 512 + 8 * lane, (d0 * rstd * g0 + b0 + bo0[u]) * gg0[u], (d1 * rstd * g1 + b1 + bo1[u]) * gg1[u]); }
        }
    }
    SEAM(4);
    if (IN(5)) {
        pg8::StaticOrder S; S.init(M_, D_, G, bx);
        int ka = 256, kb = 512; asm volatile("" : "+s"(ka), "+s"(kb));
        { pg8::Gemm g{ATT, WaT, M_, D_, ka}; EpiPA E{GATE, TMP}; pg8::gemm_phase<EpiPA, pg8::StaticOrder, true, true>(lds, g, S, E); }
        { pg8::Gemm g{RW, WbT, M_, D_, kb}; EpiPB E{GATE, TMP, MG}; pg8::gemm_phase<EpiPB, pg8::StaticOrder, true, true>(lds, g, S, E); }
        sample_gemm<1>(lds, ATTS, 256, WaT, RWS, 512, WbT, D_, sp);
    }
    SEAM(5);
    if (IN(6)) {
        pg8::Gemm g{MG, WoT, M_, D_, D_}; pg8::StaticOrder S; S.init(M_, D_, G, bx);
        EpiRes<true> E{x, out + O_Y, H1, args.in[24], SS1};
        pg8::gemm_phase<EpiRes<true>, pg8::StaticOrder, true, true>(lds, g, S, E);
        sample_gemm<2>(lds, MGS, D_, WoT, nullptr, 0, nullptr, D_, sp);
    }
    SEAM(6);
    if (IN(7)) {
        pg8::Gemm g{H1, WupT, M_, FF_, D_}; pg8::StaticOrder S; S.init(M_, FF_, G, bx);
        EpiUp E{SS1, U};
        pg8::gemm_phase<EpiUp, pg8::StaticOrder, true, true>(lds, g, S, E);
        sample_gemm<3>(lds, X1GS, D_, WupT, nullptr, 0, nullptr, FF_, sp);
    }
    SEAM(7);
    if (IN(8)) {
        pg8::Gemm g{U, WdnT, M_, D_, FF_}; pg8::StaticOrder S; S.init(M_, D_, G, bx);
        EpiRes<false> E{out + O_Y, out + O_Y, nullptr, nullptr, SS2};
        pg8::gemm_phase<EpiRes<false>, pg8::StaticOrder, true, true>(lds, g, S, E);
        sample_gemm<4>(lds, US, FF_, WdnT, nullptr, 0, nullptr, D_, sp);
    }
    SEAM(8);
    if (IN(9)) {
        const float* gf = args.in[27];
        for (int m0 = gw * 4; m0 < M_ + MS_; m0 += NGW * 4) {
            float* rowp[4]; float rs[4]; f32x4 v[4][4];
#pragma unroll
            for (int u = 0; u < 4; ++u) { const int m = m0 + u; rowp[u] = (m < M_) ? (out + O_Y + (size_t)m * D_) : (out + O_YS + (size_t)(m - M_) * D_); const float ss = (m < M_) ? SS2[m] : SS2S[m - M_]; rs[u] = rsqrtf(ss * (1.f / D_) + NORM_EPS); }
#pragma unroll
            for (int u = 0; u < 4; ++u)
#pragma unroll
                for (int j = 0; j < 4; ++j) v[u][j] = *((const f32x4*)rowp[u] + lane + 64 * j);
#pragma unroll
            for (int j = 0; j < 4; ++j) { const f32x4 gg = *((const f32x4*)gf + lane + 64 * j);
#pragma unroll
                for (int u = 0; u < 4; ++u) *((f32x4*)rowp[u] + lane + 64 * j) = v[u][j] * rs[u] * gg; }
        }
    }
#undef IN
#undef SEAM
}
}

#ifndef MK_N_LAUNCHES
#define MK_N_LAUNCHES 1
#endif
extern "C" void kernel_launch(void* const* d_in, const int* in_sizes, int n_in, void* d_out, int out_size, void* d_ws, size_t ws_size, hipStream_t stream) {
    static int grid = 0;
    if (grid == 0) {
        if (n_in != 28 || (size_t)out_size != mk::O_END || ws_size < mk::WS_END) { fprintf(stderr, "kernel_launch: unexpected shapes: n_in %d out %d ws %zu\n", n_in, out_size, ws_size); grid = -1; return; }
        int dev = 0, cus = 0, per_cu = 0;
        if (hipGetDevice(&dev) != hipSuccess || hipDeviceGetAttribute(&cus, hipDeviceAttributeMultiprocessorCount, dev) != hipSuccess) { grid = -1; return; }
        if (hipFuncSetAttribute((const void*)mk::fwd_kernel, hipFuncAttributeMaxDynamicSharedMemorySize, mk::LDS_BYTES) != hipSuccess) { fprintf(stderr, "kernel_launch: hipFuncSetAttribute failed\n"); grid = -1; return; }
        if (hipOccupancyMaxActiveBlocksPerMultiprocessor(&per_cu, (const void*)mk::fwd_kernel, 512, mk::LDS_BYTES) != hipSuccess || per_cu < 1) { fprintf(stderr, "kernel_launch: occupancy query says %d\n", per_cu); }
        (void)hipGetLastError();
        grid = cus;
    }
    if (grid < 0) return;
    (void)hipMemsetAsync((char*)d_ws + mk::WS_CTL, 0, mk::CTL_ZERO_BYTES, stream);
    mk::Args a{};
    for (int i = 0; i < 28; ++i) a.in[i] = (const float*)d_in[i];
    a.out = (float*)d_out; a.ws = (unsigned char*)d_ws;
    if (MK_N_LAUNCHES == 1) {
        a.ph_lo = 0; a.ph_hi = mk::N_PH;
        void* params[] = {&a};
        hipError_t e = hipLaunchCooperativeKernel((const void*)mk::fwd_kernel, dim3(grid), dim3(512), params, mk::LDS_BYTES, stream);
        if (e != hipSuccess) fprintf(stderr, "cooperative launch failed: %s (grid %d)\n", hipGetErrorString(e), grid);
    } else {
        for (int ph = 0; ph < mk::N_PH; ++ph) { a.ph_lo = ph; a.ph_hi = ph + 1; hipLaunchKernelGGL(mk::fwd_kernel, dim3(grid), dim3(512), mk::LDS_BYTES, stream, a); }
    }
}
```
